# Optimizing an MI355X kernel written in HIP

```python
import math
import jax, jax.numpy as jnp
from jax import lax
import numpy as np

D_MODEL = 2048
BATCH = 1
SEQ = 8192
DEPTH = 2

MIX_WIDTH = D_MODEL
ATT_WIDTH = MIX_WIDTH // 2
SSM_WIDTH = MIX_WIDTH - ATT_WIDTH
DIFF_HEAD_DIM = 64
V_HEAD_DIM = 2 * DIFF_HEAD_DIM
N_ATT_HEADS = ATT_WIDTH // V_HEAD_DIM
SSM_GROUP = 16
N_SSM_GROUPS = SSM_WIDTH // SSM_GROUP
SSM_STATE = 64
IN_WIDTH = 3 * ATT_WIDTH + SSM_WIDTH
D_FF = 256 * ((8 * D_MODEL // 3 + 255) // 256)
N_BUCKETS = 32
MAX_DISTANCE = 128
Q_BLOCK = 128
N_COND = 9
NORM_EPS = 1e-6
SUBLN_EPS = 1e-5
NEG_INF = -1e30

kernel_name = 'hybrid_diffattn_s5_macaron_block'


def rms_norm(x, g, eps=NORM_EPS):
    xf = x.astype(jnp.float32)
    y = xf * lax.rsqrt(jnp.mean(xf * xf, axis=-1, keepdims=True) + eps)
    return (y * g.astype(jnp.float32)).astype(x.dtype)


def modulate(h, shift, scale):
    return h * (1.0 + scale[:, None, :]) + shift[:, None, :]


def swiglu(h, w_gate, w_up, w_down):
    return (jax.nn.silu(h @ w_gate) * (h @ w_up)) @ w_down


def t5_causal_buckets(dist):
    max_exact = N_BUCKETS // 2
    d = jnp.maximum(dist, 1).astype(jnp.float32)
    large = max_exact + (jnp.log(d / max_exact) / math.log(MAX_DISTANCE / max_exact)
                         * (N_BUCKETS - max_exact)).astype(jnp.int32)
    large = jnp.minimum(large, N_BUCKETS - 1)
    return jnp.where(dist < max_exact, dist, large)


def diff_attention(q, k, v, bias_dist, lam):
    b, L = q.shape[0], q.shape[1]
    nb = L // Q_BLOCK
    scale = DIFF_HEAD_DIM ** -0.5
    k_pos = jnp.arange(L)
    q_blocks = q.reshape(b, nb, Q_BLOCK, N_ATT_HEADS, 2, DIFF_HEAD_DIM).transpose(1, 0, 2, 3, 4, 5)

    def one_block(args):
        q_blk, idx = args
        q_pos = idx * Q_BLOCK + jnp.arange(Q_BLOCK)
        dist = q_pos[:, None] - k_pos[None, :]
        s = jnp.einsum('bqhme,bkhme->bhmqk', q_blk, k).astype(jnp.float32) * scale
        bias = bias_dist[jnp.clip(dist, 0, L - 1)].transpose(2, 0, 1)
        s = jnp.where(dist >= 0, s + bias[None, :, None], NEG_INF)
        p = jax.nn.softmax(s, axis=-1)
        a = p[:, :, 0] - lam * p[:, :, 1]
        return jnp.einsum('bhqk,bkhd->bqhd', a.astype(v.dtype), v)

    o = lax.map(one_block, (q_blocks, jnp.arange(nb)))
    return o.transpose(1, 0, 2, 3, 4).reshape(b, L, N_ATT_HEADS, V_HEAD_DIM)


def ssm_combine(e1, e2):
    a1, b1 = e1
    a2, b2 = e2
    return a1 * a2, a2 * b1 + b2


def s5_ssm(u, lam_re, lam_im, log_step, b_re, b_im, c_re, c_im, d):
    f32 = jnp.float32
    uf = u.astype(f32)
    lam = lax.complex(jnp.minimum(lam_re.astype(f32), -1e-4), lam_im.astype(f32))
    step = jnp.exp(log_step.astype(f32))[:, None]
    lam_bar = jnp.exp(lam * step)
    b_bar = ((lam_bar - 1.0) / lam)[:, :, None] * lax.complex(b_re.astype(f32), b_im.astype(f32))
    bu = jnp.einsum('blgh,gph->blgp', uf.astype(jnp.complex64), b_bar)
    a = jnp.broadcast_to(lam_bar, bu.shape)
    _, states = lax.associative_scan(ssm_combine, (a, bu), axis=1)
    cm = lax.complex(c_re.astype(f32), c_im.astype(f32))
    y = jnp.einsum('blgp,ghp->blgh', states, cm).real + d.astype(f32) * uf
    return y.astype(u.dtype)


def hybrid_mixer(h, bias_dist, layer_idx, w_in, w_out, q_norm_g, k_norm_g,
                 lq1, lk1, lq2, lk2, subln_g,
                 lam_re, lam_im, log_step, b_re, b_im, c_re, c_im, d, glu_w, glu_b):
    b, L = h.shape[0], h.shape[1]
    proj = h @ w_in
    q, k, v, u = jnp.split(proj, [ATT_WIDTH, 2 * ATT_WIDTH, 3 * ATT_WIDTH], axis=-1)
    q = rms_norm(q.reshape(b, L, N_ATT_HEADS, 2, DIFF_HEAD_DIM), q_norm_g)
    k = rms_norm(k.reshape(b, L, N_ATT_HEADS, 2, DIFF_HEAD_DIM), k_norm_g)
    v = v.reshape(b, L, N_ATT_HEADS, V_HEAD_DIM)
    lam_init = 0.8 - 0.6 * math.exp(-0.3 * layer_idx)
    f32 = jnp.float32
    lam = (jnp.exp(jnp.sum(lq1.astype(f32) * lk1.astype(f32)))
           - jnp.exp(jnp.sum(lq2.astype(f32) * lk2.astype(f32))) + lam_init)
    att = diff_attention(q, k, v, bias_dist, lam)
    att = (rms_norm(att, subln_g, SUBLN_EPS) * (1.0 - lam_init)).reshape(b, L, ATT_WIDTH)
    y = s5_ssm(u.reshape(b, L, N_SSM_GROUPS, SSM_GROUP), lam_re, lam_im, log_step,
               b_re, b_im, c_re, c_im, d)
    y = jax.nn.gelu(y.reshape(b, L, SSM_WIDTH))
    y = y * jax.nn.sigmoid(y @ glu_w + glu_b)
    return jnp.concatenate([att, y], axis=-1) @ w_out


def setup_inputs(seed: int = 0) -> dict:
    key = jax.random.key(seed)
    ks = jax.random.split(key, 32)
    f32 = jnp.float32

    def nrm(k, shape, scale):
        return jax.random.normal(k, shape, f32) * scale

    P, G, Hc = SSM_STATE, N_SSM_GROUPS, SSM_GROUP
    lam_im0 = math.pi * jnp.arange(P, dtype=f32)
    return {
        'x': nrm(ks[0], (BATCH, SEQ, D_MODEL), 1.0),
        'c': nrm(ks[1], (BATCH, D_MODEL), 1.0),
        'rel_bias': nrm(ks[2], (N_BUCKETS, N_ATT_HEADS), 0.5),
        'ada_w': nrm(ks[3], (DEPTH, D_MODEL, N_COND * D_MODEL), D_MODEL ** -0.5),
        'ada_b': nrm(ks[4], (DEPTH, N_COND * D_MODEL), 0.02),
        'norm_g': 1.0 + nrm(ks[5], (DEPTH, 3, D_MODEL), 0.02),
        'ffn1_w_gate': nrm(ks[6], (DEPTH, D_MODEL, D_FF), D_MODEL ** -0.5),
        'ffn1_w_up': nrm(ks[7], (DEPTH, D_MODEL, D_FF), D_MODEL ** -0.5),
        'ffn1_w_down': nrm(ks[8], (DEPTH, D_FF, D_MODEL), D_FF ** -0.5),
        'ffn2_w_gate': nrm(ks[9], (DEPTH, D_MODEL, D_FF), D_MODEL ** -0.5),
        'ffn2_w_up': nrm(ks[10], (DEPTH, D_MODEL, D_FF), D_MODEL ** -0.5),
        'ffn2_w_down': nrm(ks[11], (DEPTH, D_FF, D_MODEL), D_FF ** -0.5),
        'w_in': nrm(ks[12], (DEPTH, D_MODEL, IN_WIDTH), D_MODEL ** -0.5),
        'w_out': nrm(ks[13], (DEPTH, MIX_WIDTH, D_MODEL), MIX_WIDTH ** -0.5),
        'q_norm_g': 1.0 + nrm(ks[14], (DEPTH, DIFF_HEAD_DIM), 0.02),
        'k_norm_g': 1.0 + nrm(ks[15], (DEPTH, DIFF_HEAD_DIM), 0.02),
        'lambda_q1': nrm(ks[16], (DEPTH, DIFF_HEAD_DIM), 0.1),
        'lambda_k1': nrm(ks[17], (DEPTH, DIFF_HEAD_DIM), 0.1),
        'lambda_q2': nrm(ks[18], (DEPTH, DIFF_HEAD_DIM), 0.1),
        'lambda_k2': nrm(ks[19], (DEPTH, DIFF_HEAD_DIM), 0.1),
        'subln_g': 1.0 + nrm(ks[20], (DEPTH, V_HEAD_DIM), 0.02),
        'ssm_lambda_re': -0.5 + nrm(ks[21], (DEPTH, G, P), 0.01),
        'ssm_lambda_im': lam_im0 + nrm(ks[22], (DEPTH, G, P), 0.01),
        'ssm_log_step': jax.random.uniform(ks[23], (DEPTH, G), f32,
                                           math.log(1e-3), math.log(1e-1)),
        'ssm_b_re': nrm(ks[24], (DEPTH, G, P, Hc), (2.0 * Hc) ** -0.5),
        'ssm_b_im': nrm(ks[25], (DEPTH, G, P, Hc), (2.0 * Hc) ** -0.5),
        'ssm_c_re': nrm(ks[26], (DEPTH, G, Hc, P), (2.0 * P) ** -0.5),
        'ssm_c_im': nrm(ks[27], (DEPTH, G, Hc, P), (2.0 * P) ** -0.5),
        'ssm_d': nrm(ks[28], (DEPTH, G, Hc), 1.0),
        'ssm_glu_w': nrm(ks[29], (DEPTH, SSM_WIDTH, SSM_WIDTH), SSM_WIDTH ** -0.5),
        'ssm_glu_b': nrm(ks[30], (DEPTH, SSM_WIDTH), 0.02),
    }


def reference(x, c, rel_bias, ada_w, ada_b, norm_g,
              ffn1_w_gate, ffn1_w_up, ffn1_w_down, ffn2_w_gate, ffn2_w_up, ffn2_w_down,
              w_in, w_out, q_norm_g, k_norm_g, lambda_q1, lambda_k1, lambda_q2, lambda_k2,
              subln_g, ssm_lambda_re, ssm_lambda_im, ssm_log_step,
              ssm_b_re, ssm_b_im, ssm_c_re, ssm_c_im, ssm_d, ssm_glu_w, ssm_glu_b):
    L = x.shape[1]
    bias_dist = rel_bias.astype(jnp.float32)[t5_causal_buckets(jnp.arange(L, dtype=jnp.int32))]
    cond = jax.nn.silu(c)
    for i in range(DEPTH):
        mod = cond @ ada_w[i] + ada_b[i]
        sh1, sc1, g1, sh2, sc2, g2, sh3, sc3, g3 = jnp.split(mod, N_COND, axis=-1)
        h = modulate(rms_norm(x, norm_g[i, 0]), sh1, sc1)
        x = x + 0.5 * g1[:, None, :] * swiglu(h, ffn1_w_gate[i], ffn1_w_up[i], ffn1_w_down[i])
        h = modulate(rms_norm(x, norm_g[i, 1]), sh2, sc2)
        m = hybrid_mixer(h, bias_dist, i, w_in[i], w_out[i], q_norm_g[i], k_norm_g[i],
                         lambda_q1[i], lambda_k1[i], lambda_q2[i], lambda_k2[i], subln_g[i],
                         ssm_lambda_re[i], ssm_lambda_im[i], ssm_log_step[i],
                         ssm_b_re[i], ssm_b_im[i], ssm_c_re[i], ssm_c_im[i], ssm_d[i],
                         ssm_glu_w[i], ssm_glu_b[i])
        x = x + g2[:, None, :] * m
        h = modulate(rms_norm(x, norm_g[i, 2]), sh3, sc3)
        x = x + 0.5 * g3[:, None, :] * swiglu(h, ffn2_w_gate[i], ffn2_w_up[i], ffn2_w_down[i])
    return x
```

```cpp
#include <hip/hip_runtime.h>
#include <hip/hip_cooperative_groups.h>
#include <cstdio>
#include <cstdint>
namespace cg = cooperative_groups;
#ifndef MK_ONE_LAUNCH
#define MK_ONE_LAUNCH 0
#endif
namespace pg8 {
#define PG8_LAS __attribute__((address_space(3)))
typedef unsigned short bf16_t;
typedef short bf16x8 __attribute__((ext_vector_type(8)));
typedef float f32x4 __attribute__((ext_vector_type(4)));
typedef unsigned u32x4 __attribute__((ext_vector_type(4)));
constexpr int BM = 256, BK = 64, HALF = 128, HTB = HALF * BK * 2  , STAGE_BYTES = 8 * HTB, NXCD = 8, WGM = 8;

__host__ __device__ __forceinline__ int lds_byte(int r, int c) { const int st = (r >> 4) * 2 + (c >> 5), rr = r & 15, cc = c & 31, ob = rr * 64 + cc * 2; return st * 1024 + (ob ^ (((ob >> 9) & 1) << 5)); }
__host__ __device__ __forceinline__ void stage_rc(int b, int& R, int& C) { const int st = b / 1024, sb = b % 1024, swz = sb ^ (((sb >> 9) & 1) << 5); R = (st >> 1) * 16 + swz / 64; C = (st & 1) * 32 + (swz % 64) / 2; }
__host__ __device__ __forceinline__ int perm32(int rho) { const int n = rho >> 4, i = rho & 15; return 8 * (i >> 2) + 4 * n + (i & 3); }

struct Unit { int pm, pn; };
struct Gemm { const bf16_t* A; const bf16_t* Bt; int M, N, K; };

struct StaticOrder {
    int nM, nN, nwg, G, c;
    __host__ __device__ void init(int M, int N, int G_, int c_) { nM = M / BM; nN = N / BM; nwg = nM * nN; G = G_; c = c_; }
    __host__ __device__ bool next(int i, Unit& u) const {
        const long L = (long)i * G + c; if (L >= nwg) return false;
        int wgid = (int)L; { const int q = nwg / NXCD, r = nwg % NXCD, xcd = wgid % NXCD, off = wgid / NXCD; wgid = (xcd < r ? xcd * (q + 1) : r * (q + 1) + (xcd - r) * q) + off; }
        const int nig = WGM * nN, gid = wgid / nig, fm = gid * WGM, gsz = (nM - fm) < WGM ? (nM - fm) : WGM;
        u.pm = fm + ((wgid % nig) % gsz); u.pn = (wgid % nig) / gsz; return true;
    }
    __device__ __forceinline__ void a_ready(const Unit&) const {}
    __device__ __forceinline__ void done(const Unit&) const {}
};

__device__ __forceinline__ unsigned cvt_pk_bf16(float lo, float hi) { unsigned r; asm volatile("v_cvt_pk_bf16_f32 %0, %1, %2" : "=v"(r) : "v"(lo), "v"(hi)); return r; }
typedef float f32x2 __attribute__((ext_vector_type(2)));
__device__ __forceinline__ float sigmoid_f(float v) { return __builtin_amdgcn_rcpf(1.0f + __builtin_amdgcn_exp2f(-1.4426950408889634f * v)); }
struct EpiSwiGlu {
    static constexpr bool PERM = true, AFTER_DRAIN = false;
    bf16_t* O; int ldc;
    __device__ __forceinline__ void operator()(const f32x4 (&acc)[2][2][4][2], const Unit& u, int wr, int wc, int fr, int fq) const {
        const int row0 = u.pm * BM + wr * 64 + fr, col0 = u.pn * HALF + wc * 32 + 8 * fq;
#pragma unroll
        for (int ai = 0; ai < 2; ++ai)
#pragma unroll
            for (int m = 0; m < 4; ++m) { bf16_t* rowp = O + (size_t)(row0 + ai * HALF + m * 16) * ldc + col0;
                const f32x4 g0 = acc[ai][0][m][0], g1 = acc[ai][0][m][1], u0 = acc[ai][1][m][0], u1 = acc[ai][1][m][1];
                float v[8];
#pragma unroll
                for (int i = 0; i < 4; ++i) { v[i] = g0[i] * sigmoid_f(g0[i]) * u0[i]; v[4 + i] = g1[i] * sigmoid_f(g1[i]) * u1[i]; }
                u32x4 w; w.x = cvt_pk_bf16(v[0], v[1]); w.y = cvt_pk_bf16(v[2], v[3]); w.z = cvt_pk_bf16(v[4], v[5]); w.w = cvt_pk_bf16(v[6], v[7]);
                *(u32x4*)rowp = w; }
    }
};
struct EpiResGate {
    static constexpr bool PERM = false, AFTER_DRAIN = false;
    const float* xin; float* xout; const float* gate; float coef; int ldc;
    __device__ __forceinline__ void operator()(const f32x4 (&acc)[2][2][4][2], const Unit& u, int wr, int wc, int fr, int fq) const {
        const int row0 = u.pm * BM + wr * 64 + fr, col0 = u.pn * BM + wc * 32 + 4 * fq;
        f32x4 gv[2][2];
#pragma unroll
        for (int bj = 0; bj < 2; ++bj)
#pragma unroll
            for (int n = 0; n < 2; ++n) gv[bj][n] = *(const f32x4*)(gate + col0 + bj * HALF + n * 16) * coef;
#pragma unroll
        for (int ai = 0; ai < 2; ++ai)
#pragma unroll
            for (int m = 0; m < 4; ++m) { const size_t off = (size_t)(row0 + ai * HALF + m * 16) * ldc + col0;
#pragma unroll
                for (int bj = 0; bj < 2; ++bj)
#pragma unroll
                    for (int n = 0; n < 2; ++n) { const f32x4 xi = *(const f32x4*)(xin + off + bj * HALF + n * 16);
                        *(f32x4*)(xout + off + bj * HALF + n * 16) = xi + gv[bj][n] * acc[ai][bj][m][n]; }
                if (m & 1) asm volatile("" ::: "memory"); }
    }
};
struct EpiWin {
    static constexpr bool PERM = true, AFTER_DRAIN = false;
    bf16_t *Q, *K, *V, *U; const float *qg, *kg; float qscale;
    __device__ __forceinline__ void operator()(const f32x4 (&acc)[2][2][4][2], const Unit& u, int wr, int wc, int fr, int fq) const {
        const int sec = u.pn >> 2, tile = u.pn & 3; const int row0 = u.pm * BM + wr * 64 + fr;
        if (sec < 2) {
            const float* gn = sec == 0 ? qg : kg; const float sc = sec == 0 ? qscale : 1.0f;
            bf16_t* base = sec == 0 ? Q : K;
            f32x4 gv[2][2];
#pragma unroll
            for (int bj = 0; bj < 2; ++bj)
#pragma unroll
                for (int n = 0; n < 2; ++n) gv[bj][n] = *(const f32x4*)(gn + 32 * bj + 8 * fq + 4 * n) * sc;
            const int col0 = tile * 256 + wc * 64 + 8 * fq;
#pragma unroll
            for (int ai = 0; ai < 2; ++ai)
#pragma unroll
                for (int m = 0; m < 4; ++m) {
                    float ss = 0.f;
#pragma unroll
                    for (int bj = 0; bj < 2; ++bj)
#pragma unroll
                        for (int n = 0; n < 2; ++n) { const f32x4 x = acc[ai][bj][m][n]; ss += (x[0] * x[0] + x[1] * x[1]) + (x[2] * x[2] + x[3] * x[3]); }
                    ss += __shfl_xor(ss, 16); ss += __shfl_xor(ss, 32);
                    const float r = __builtin_amdgcn_rsqf(ss * (1.0f / 64.0f) + 1e-6f);
                    bf16_t* rowp = base + (size_t)(row0 + ai * HALF + m * 16) * 1024 + col0;
#pragma unroll
                    for (int bj = 0; bj < 2; ++bj) { const f32x4 v0 = acc[ai][bj][m][0] * gv[bj][0] * r, v1 = acc[ai][bj][m][1] * gv[bj][1] * r;
                        u32x4 w; w.x = cvt_pk_bf16(v0[0], v0[1]); w.y = cvt_pk_bf16(v0[2], v0[3]); w.z = cvt_pk_bf16(v1[0], v1[1]); w.w = cvt_pk_bf16(v1[2], v1[3]);
                        *(u32x4*)(rowp + 32 * bj) = w; }
                }
        } else {
            bf16_t* base = sec == 2 ? V : U; const int col0 = tile * 256 + wc * 32 + 8 * fq;
#pragma unroll
            for (int ai = 0; ai < 2; ++ai)
#pragma unroll
                for (int m = 0; m < 4; ++m) { bf16_t* rowp = base + (size_t)(row0 + ai * HALF + m * 16) * 1024 + col0;
#pragma unroll
                    for (int bj = 0; bj < 2; ++bj) { const f32x4 v0 = acc[ai][bj][m][0], v1 = acc[ai][bj][m][1];
                        u32x4 w; w.x = cvt_pk_bf16(v0[0], v0[1]); w.y = cvt_pk_bf16(v0[2], v0[3]); w.z = cvt_pk_bf16(v1[0], v1[1]); w.w = cvt_pk_bf16(v1[2], v1[3]);
                        *(u32x4*)(rowp + HALF * bj) = w; } }
        }
    }
};
__device__ __forceinline__ float bf_lo(unsigned w) { return __uint_as_float(w << 16); }
__device__ __forceinline__ float bf_hi(unsigned w) { return __uint_as_float(w & 0xffff0000u); }
struct EpiGlu {
    static constexpr bool PERM = true, AFTER_DRAIN = false;
    const bf16_t* YG; bf16_t* CAT; const float* bias;
    __device__ __forceinline__ void operator()(const f32x4 (&acc)[2][2][4][2], const Unit& u, int wr, int wc, int fr, int fq) const {
        const int row0 = u.pm * BM + wr * 64 + fr, col0 = u.pn * BM + wc * 32 + 8 * fq;
        f32x4 bv[2][2];
#pragma unroll
        for (int bj = 0; bj < 2; ++bj)
#pragma unroll
            for (int n = 0; n < 2; ++n) bv[bj][n] = *(const f32x4*)(bias + col0 + bj * HALF + 4 * n);
#pragma unroll
        for (int ai = 0; ai < 2; ++ai)
#pragma unroll
            for (int m = 0; m < 4; ++m) { const size_t row = (size_t)(row0 + ai * HALF + m * 16);
#pragma unroll
                for (int bj = 0; bj < 2; ++bj) { const f32x4 z0 = acc[ai][bj][m][0] + bv[bj][0], z1 = acc[ai][bj][m][1] + bv[bj][1];
                    const u32x4 y = *(const u32x4*)(YG + row * 1024 + col0 + bj * HALF);
                    u32x4 w;
                    w.x = cvt_pk_bf16(bf_lo(y.x) * sigmoid_f(z0[0]), bf_hi(y.x) * sigmoid_f(z0[1])); w.y = cvt_pk_bf16(bf_lo(y.y) * sigmoid_f(z0[2]), bf_hi(y.y) * sigmoid_f(z0[3]));
                    w.z = cvt_pk_bf16(bf_lo(y.z) * sigmoid_f(z1[0]), bf_hi(y.z) * sigmoid_f(z1[1])); w.w = cvt_pk_bf16(bf_lo(y.w) * sigmoid_f(z1[2]), bf_hi(y.w) * sigmoid_f(z1[3]));
                    *(u32x4*)(CAT + row * 2048 + 1024 + col0 + bj * HALF) = w; } }
    }
};

template <class Epi, class Sched, bool ALIGN_EPI = false, bool SP2 = false>
__device__ __forceinline__ void gemm_phase(PG8_LAS unsigned char* lds, const Gemm g, const Sched& S, const Epi& E) {
    int tid_ = threadIdx.x; asm volatile("" : "+v"(tid_));
    const int tid = tid_, wid = __builtin_amdgcn_readfirstlane(tid >> 6), lane = tid & 63, wr = wid >> 2, wc = wid & 3, fr = lane & 15, fq = lane >> 4;
    const int K = g.K, nt = K / BK;
    unsigned voffA[2], voffB[2];
#pragma unroll
    for (int i = 0; i < 2; ++i) { int R, C; stage_rc(tid * 16 + i * 8192, R, C); const int Rb = Epi::PERM ? ((R & ~31) + perm32(R & 31)) : R;
        voffA[i] = (unsigned)(R * K + C) * 2u; voffB[i] = (unsigned)(Rb * K + C) * 2u; }
    const size_t kstep = (size_t)(BK * 2);
    const size_t hstep = (size_t)HALF * K * 2;
    const size_t tstep = 2 * hstep;
    const unsigned ldsw = (unsigned)wid * 1024u;
    const int aoff = lds_byte(wr * 64 + fr, fq * 8), boff = lds_byte(wc * 32 + fr, fq * 8);
#define PG8_SA(b, h) (((b) * 2 + (h)) * HTB)
#define PG8_SB(b, h) ((4 + (b) * 2 + (h)) * HTB)
#define PG8_STAGE(bufoff, gbase, voff) do { _Pragma("unroll") for (int _i = 0; _i < 2; ++_i) \
        __builtin_amdgcn_global_load_lds((const unsigned*)((const char*)(gbase) + (voff)[_i]), (PG8_LAS unsigned*)(lds + (bufoff) + ldsw + _i * 8192), 16, 0, 0); } while (0)
#define PG8_LDA(dst, b, h) do { _Pragma("unroll") for (int m = 0; m < 4; ++m) _Pragma("unroll") for (int k = 0; k < 2; ++k) dst[m][k] = *(const PG8_LAS bf16x8*)(lds + PG8_SA(b, h) + aoff + m * 2048 + k * 1024); } while (0)
#define PG8_LDB(dst, b, h) do { _Pragma("unroll") for (int n = 0; n < 2; ++n) _Pragma("unroll") for (int k = 0; k < 2; ++k) dst[n][k] = *(const PG8_LAS bf16x8*)(lds + PG8_SB(b, h) + boff + n * 2048 + k * 1024); } while (0)
#define PG8_MMA(ai, bj, At, Bt) do { __builtin_amdgcn_s_setprio(1); _Pragma("unroll") for (int m = 0; m < 4; ++m) _Pragma("unroll") for (int n = 0; n < 2; ++n) _Pragma("unroll") for (int k = 0; k < 2; ++k) \
        acc[ai][bj][m][n] = __builtin_amdgcn_mfma_f32_16x16x32_bf16(Bt[n][k], At[m][k], acc[ai][bj][m][n], 0, 0, 0); __builtin_amdgcn_s_setprio(0); } while (0)
#define PG8_WAIT_V(n) asm volatile("s_waitcnt vmcnt(" #n ")" ::: "memory")
#define PG8_WAIT_L(n) asm volatile("s_waitcnt lgkmcnt(" #n ")" ::: "memory")
#define PG8_BAR __builtin_amdgcn_s_barrier()
#define PG8_SCHED __builtin_amdgcn_sched_barrier(0)
    Unit cur, nxt; int ui = 0;
    if (!S.next(0, cur)) return;
    f32x4 acc[2][2][4][2];
#pragma unroll
    for (int a = 0; a < 2; ++a)
#pragma unroll
        for (int b = 0; b < 2; ++b)
#pragma unroll
            for (int m = 0; m < 4; ++m)
#pragma unroll
                for (int n = 0; n < 2; ++n) acc[a][b][m][n] = (f32x4){0.f, 0.f, 0.f, 0.f};
    bf16x8 At[4][2], B0[2][2], B1[2][2];
    const char* cA = (const char*)g.A + (size_t)cur.pm * tstep; const char* cB = (const char*)g.Bt + (size_t)cur.pn * tstep;
    S.a_ready(cur);
    if constexpr (SP2) {
        PG8_STAGE(PG8_SB(0, 0), cB, voffB); PG8_STAGE(PG8_SB(0, 1), cB + hstep, voffB); PG8_STAGE(PG8_SA(0, 0), cA, voffA); PG8_STAGE(PG8_SA(0, 1), cA + hstep, voffA);
        if (wr == 1) PG8_BAR;
        PG8_WAIT_V(2); PG8_BAR;
        PG8_STAGE(PG8_SB(1, 0), cB + kstep, voffB); PG8_STAGE(PG8_SA(1, 0), cA + kstep, voffA); PG8_STAGE(PG8_SB(1, 1), cB + hstep + kstep, voffB);
        PG8_WAIT_V(6); PG8_BAR;
    } else {
        PG8_STAGE(PG8_SB(0, 0), cB, voffB); PG8_STAGE(PG8_SA(0, 0), cA, voffA); PG8_STAGE(PG8_SB(0, 1), cB + hstep, voffB); PG8_STAGE(PG8_SA(0, 1), cA + hstep, voffA);
        if (wr == 1) PG8_BAR;
        PG8_WAIT_V(4); PG8_BAR;
        PG8_STAGE(PG8_SB(1, 0), cB + kstep, voffB); PG8_STAGE(PG8_SA(1, 0), cA + kstep, voffA); PG8_STAGE(PG8_SB(1, 1), cB + hstep + kstep, voffB);
        PG8_WAIT_V(6); PG8_BAR;
    }
    for (;;) {
        const bool has_next = S.next(ui + 1, nxt);
        const char* nA = has_next ? (const char*)g.A + (size_t)nxt.pm * tstep : cA; const char* nB = has_next ? (const char*)g.Bt + (size_t)nxt.pn * tstep : cB;
        for (int t = 0; t < nt; t += 2) {
            const bool last = (t == nt - 2);
            const char* a1 = cA + (size_t)(t + 1) * kstep;
            const char* a2 = last ? nA : cA + (size_t)(t + 2) * kstep; const char* b2 = last ? nB : cB + (size_t)(t + 2) * kstep;
            const char* a3 = a2 + kstep; const char* b3 = b2 + kstep;
            if (last && has_next) S.a_ready(nxt);
            if constexpr (SP2) {
            PG8_LDB(B0, 0, 0); PG8_LDB(B1, 0, 1); PG8_SCHED; PG8_LDA(At, 0, 0); PG8_STAGE(PG8_SA(1, 1), a1 + hstep, voffA);
            PG8_WAIT_V(8); PG8_WAIT_L(0); PG8_BAR; PG8_MMA(0, 0, At, B0); PG8_MMA(0, 1, At, B1); PG8_BAR; PG8_SCHED;
            PG8_LDA(At, 0, 1); PG8_STAGE(PG8_SB(0, 0), b2, voffB); PG8_STAGE(PG8_SB(0, 1), b2 + hstep, voffB); PG8_STAGE(PG8_SA(0, 0), a2, voffA);
            PG8_WAIT_V(8); PG8_WAIT_L(0); PG8_BAR; PG8_MMA(1, 0, At, B0); PG8_MMA(1, 1, At, B1); PG8_BAR; PG8_SCHED;
            PG8_LDB(B0, 1, 0); PG8_LDB(B1, 1, 1); PG8_SCHED; PG8_LDA(At, 1, 0); PG8_STAGE(PG8_SA(0, 1), a2 + hstep, voffA);
            PG8_WAIT_V(8); PG8_WAIT_L(0); PG8_BAR; PG8_MMA(0, 0, At, B0); PG8_MMA(0, 1, At, B1); PG8_BAR; PG8_SCHED;
            PG8_LDA(At, 1, 1); PG8_STAGE(PG8_SB(1, 0), b3, voffB); PG8_STAGE(PG8_SB(1, 1), b3 + hstep, voffB); PG8_STAGE(PG8_SA(1, 0), a3, voffA);
            PG8_WAIT_V(8); PG8_WAIT_L(0); PG8_BAR; PG8_MMA(1, 0, At, B0); PG8_MMA(1, 1, At, B1); PG8_BAR; PG8_SCHED;
            } else {
            PG8_LDB(B0, 0, 0); PG8_SCHED; PG8_LDA(At, 0, 0); PG8_STAGE(PG8_SA(1, 1), a1 + hstep, voffA);
            PG8_WAIT_L(8); PG8_BAR; PG8_WAIT_L(0); PG8_MMA(0, 0, At, B0); PG8_BAR; PG8_SCHED;
            PG8_LDB(B1, 0, 1); PG8_STAGE(PG8_SB(0, 0), b2, voffB);
            PG8_BAR; PG8_WAIT_L(0); PG8_MMA(0, 1, At, B1); PG8_BAR;
            PG8_LDA(At, 0, 1); PG8_STAGE(PG8_SA(0, 0), a2, voffA);
            PG8_BAR; PG8_WAIT_L(0); PG8_MMA(1, 0, At, B0); PG8_BAR; PG8_SCHED;
            PG8_STAGE(PG8_SB(0, 1), b2 + hstep, voffB);
            PG8_WAIT_V(6); PG8_BAR; PG8_MMA(1, 1, At, B1); PG8_BAR;
            PG8_LDB(B0, 1, 0); PG8_SCHED; PG8_LDA(At, 1, 0); PG8_STAGE(PG8_SA(0, 1), a2 + hstep, voffA);
            PG8_WAIT_L(8); PG8_BAR; PG8_WAIT_L(0); PG8_MMA(0, 0, At, B0); PG8_BAR; PG8_SCHED;
            PG8_LDB(B1, 1, 1); PG8_STAGE(PG8_SB(1, 0), b3, voffB);
            PG8_BAR; PG8_WAIT_L(0); PG8_MMA(0, 1, At, B1); PG8_BAR;
            PG8_LDA(At, 1, 1); PG8_STAGE(PG8_SA(1, 0), a3, voffA);
            PG8_BAR; PG8_WAIT_L(0); PG8_MMA(1, 0, At, B0); PG8_BAR; PG8_SCHED;
            PG8_STAGE(PG8_SB(1, 1), b3 + hstep, voffB);
            PG8_WAIT_V(6); PG8_BAR; PG8_MMA(1, 1, At, B1); PG8_BAR;
            }
        }
        if constexpr (ALIGN_EPI) { if (wr == 0) PG8_BAR; }
        if constexpr (!Epi::AFTER_DRAIN) { E(acc, cur, wr, wc, fr, fq); S.done(cur); }
        if (!has_next) break;
#pragma unroll
        for (int a = 0; a < 2; ++a)
#pragma unroll
            for (int b = 0; b < 2; ++b)
#pragma unroll
                for (int m = 0; m < 4; ++m)
#pragma unroll
                    for (int n = 0; n < 2; ++n) acc[a][b][m][n] = (f32x4){0.f, 0.f, 0.f, 0.f};
        cur = nxt; cA = nA; cB = nB; ++ui;
        if constexpr (ALIGN_EPI) { if (wr == 1) PG8_BAR; }
    }
    PG8_WAIT_V(0);
    if constexpr (!ALIGN_EPI) { if (wr == 0) PG8_BAR; }
    PG8_BAR;
    if constexpr (Epi::AFTER_DRAIN) { E.fused(acc, cur, wr, wc, fr, fq, lds, wid, lane); S.done(cur); }
#undef PG8_SA
#undef PG8_SB
#undef PG8_STAGE
#undef PG8_LDA
#undef PG8_LDB
#undef PG8_MMA
#undef PG8_WAIT_V
#undef PG8_WAIT_L
#undef PG8_BAR
#undef PG8_SCHED
}
}
#include <hip/hip_bf16.h>
#include <cmath>
namespace attn_body {
using bf16=__hip_bfloat16;
using bf16x8=__attribute__((ext_vector_type(8)))short;
using s16x4=__attribute__((ext_vector_type(4)))short;
using f32x16=__attribute__((ext_vector_type(16)))float;
using u32x4=__attribute__((ext_vector_type(4)))unsigned;
constexpr int SEQ=8192,D=64,DM=1024,OPITCH=2048;
constexpr int NW=8,QBLK=32,QB=QBLK*NW,KVBLK=64,NQB=SEQ/QB;
constexpr int ATTN_PITCH=DM, ATTN_UNIT_ROWS=QB;
__device__ __forceinline__ int crow(int r,int hi){return (r&3)+8*(r>>2)+4*hi;}
#define SBAR() __builtin_amdgcn_sched_barrier(0)
typedef const __attribute__((address_space(3))) float* lds_cfptr;
__device__ __forceinline__ void cmask(f32x16&p0,f32x16&p1,int jb,int qrel,int hi,lds_cfptr bt){
  const float NEG=-INFINITY; int kb=64*jb+4*hi;
  #pragma unroll
  for(int r=0;r<16;++r){int kv=kb+(r&3)+8*(r>>2); int d0=qrel-kv, d1=d0-32;
    unsigned i0=(unsigned)d0<127u?(unsigned)d0:127u, i1=(unsigned)d1<127u?(unsigned)d1:127u;
    float b0=bt[i0], b1=bt[i1];
    p0[r]=(d0<0)?NEG:p0[r]+b0; p1[r]=(d1<0)?NEG:p1[r]+b1;}
}

constexpr int NSLOT=3, SLOTB=8192;
constexpr int LDS_K=0, LDS_V=NSLOT*SLOTB, LDS_WS=2*NSLOT*SLOTB, LDS_OST=LDS_WS+NW*64*4, LDS_BT=LDS_OST+NW*4096, LDS_BYTES=LDS_BT+512;
constexpr float C2=0.125f*1.4426950408889634f;
__device__ __forceinline__ void glds16(const void*gsrc,unsigned lds_dst){unsigned keep;
  asm volatile("s_mov_b32 %0, m0\n\ts_mov_b32 m0, %2\n\ts_nop 0\n\tglobal_load_lds_dwordx4 %1, off\n\ts_mov_b32 m0, %0":"=&s"(keep):"v"(gsrc),"s"(lds_dst):"memory");}
__device__ __forceinline__ float max3f(float a,float b,float c){float r;asm("v_max3_f32 %0, %1, %2, %3":"=v"(r):"v"(a),"v"(b),"v"(c));return r;}
__device__ __forceinline__ float max2f(float a,float b){float r;asm("v_max_f32_e32 %0, %1, %2":"=v"(r):"v"(a),"v"(b));return r;}
__device__ __forceinline__ float fadd_s(float a,float b){float r;asm("v_add_f32_e32 %0, %1, %2":"=v"(r):"v"(a),"v"(b));return r;}
__device__ __forceinline__ float fsub_s(float a,float b){float r;asm("v_sub_f32_e32 %0, %1, %2":"=v"(r):"v"(a),"v"(b));return r;}
typedef float f32x2_t __attribute__((ext_vector_type(2))); typedef __bf16 bf16x2_t __attribute__((ext_vector_type(2)));
__device__ __forceinline__ unsigned cvtpk_s(float lo,float hi){f32x2_t v={lo,hi};bf16x2_t b=__builtin_convertvector(v,bf16x2_t);return __builtin_bit_cast(unsigned,b);}
#define WAIT_BAR(N) asm volatile("s_waitcnt vmcnt(" #N ") lgkmcnt(0)\n\ts_barrier":::"memory")

__device__ __forceinline__ void qkt(f32x16&p0,f32x16&p1,const char*Kslot,const bf16x8*qr,const f32x16&negm,int r32,int hi){
  const char*kb=Kslot+hi*1024+r32*16;
  #pragma unroll
  for(int d0=0;d0<4;++d0){
    const bf16x8 b0=*reinterpret_cast<const bf16x8*>(kb+d0*2048);
    const bf16x8 b1=*reinterpret_cast<const bf16x8*>(kb+d0*2048+512);
    if(d0==0){p0=__builtin_amdgcn_mfma_f32_32x32x16_bf16(b0,qr[0],negm,0,0,0);p1=__builtin_amdgcn_mfma_f32_32x32x16_bf16(b1,qr[0],negm,0,0,0);}
    else{p0=__builtin_amdgcn_mfma_f32_32x32x16_bf16(b0,qr[d0],p0,0,0,0);p1=__builtin_amdgcn_mfma_f32_32x32x16_bf16(b1,qr[d0],p1,0,0,0);}}
}
typedef __attribute__((address_space(3))) const char* lds_cptr;
typedef short v4i16_t __attribute__((ext_vector_type(4)));
__device__ __forceinline__ void kload8(bf16x8*kf,lds_cptr kp){
  kf[0]=*(const __attribute__((address_space(3))) bf16x8*)(kp);      kf[1]=*(const __attribute__((address_space(3))) bf16x8*)(kp+512);
  kf[2]=*(const __attribute__((address_space(3))) bf16x8*)(kp+2048); kf[3]=*(const __attribute__((address_space(3))) bf16x8*)(kp+2560);
  kf[4]=*(const __attribute__((address_space(3))) bf16x8*)(kp+4096); kf[5]=*(const __attribute__((address_space(3))) bf16x8*)(kp+4608);
  kf[6]=*(const __attribute__((address_space(3))) bf16x8*)(kp+6144); kf[7]=*(const __attribute__((address_space(3))) bf16x8*)(kp+6656);
}
__device__ __forceinline__ void kload2(bf16x8*kf,lds_cptr kp,int j){ kf[2*j]=*(const __attribute__((address_space(3))) bf16x8*)(kp+j*2048); kf[2*j+1]=*(const __attribute__((address_space(3))) bf16x8*)(kp+j*2048+512); }
__device__ __forceinline__ s16x4 vtr(lds_cptr p){ return __builtin_bit_cast(s16x4,__builtin_amdgcn_ds_read_tr16_b64_v4i16((__attribute__((address_space(3))) v4i16_t*)p)); }
__device__ __forceinline__ float rowmax(const f32x16&p0,const f32x16&p1){
  float a=max3f(p0[0],p0[1],p1[0]),b=max3f(p0[2],p0[3],p1[1]);a=max3f(a,p1[2],p1[3]);
  #pragma unroll
  for(int r=4;r<16;r+=4){a=max3f(a,p0[r],p0[r+1]);b=max3f(b,p0[r+2],p0[r+3]);a=max3f(a,p1[r],p1[r+1]);b=max3f(b,p1[r+2],p1[r+3]);}
  const float m=max2f(a,b);
  auto rr=__builtin_amdgcn_permlane32_swap(__float_as_uint(m),__float_as_uint(m),false,false);
  return max2f(__uint_as_float(rr[0]),__uint_as_float(rr[1]));
}
__device__ __forceinline__ void pv(f32x16*o,int vb,bf16x8 pa0,bf16x8 pa1,bf16x8 pa2,bf16x8 pa3){
  #pragma unroll
  for(int d0=0;d0<2;++d0){s16x4 lo[4],hi[4];
    #pragma unroll
    for(int ks=0;ks<4;++ks){
      asm volatile("ds_read_b64_tr_b16 %0,%1 offset:%c2":"=&v"(lo[ks]):"v"(vb),"i"(d0*4096+ks*1024):"memory");
      asm volatile("ds_read_b64_tr_b16 %0,%1 offset:%c2":"=&v"(hi[ks]):"v"(vb),"i"(d0*4096+ks*1024+512):"memory");}
    asm volatile("s_waitcnt lgkmcnt(0)":::"memory");SBAR();
    #define PK(k) (bf16x8){lo[k][0],lo[k][1],lo[k][2],lo[k][3],hi[k][0],hi[k][1],hi[k][2],hi[k][3]}
    o[d0]=__builtin_amdgcn_mfma_f32_32x32x16_bf16(pa0,PK(0),o[d0],0,0,0);
    o[d0]=__builtin_amdgcn_mfma_f32_32x32x16_bf16(pa1,PK(1),o[d0],0,0,0);
    o[d0]=__builtin_amdgcn_mfma_f32_32x32x16_bf16(pa2,PK(2),o[d0],0,0,0);
    o[d0]=__builtin_amdgcn_mfma_f32_32x32x16_bf16(pa3,PK(3),o[d0],0,0,0);
    #undef PK
  }
}

#ifndef ATTN_STORE16
#define ATTN_STORE16(p,v) (*(u32x4*)(p)=(v))
#endif
template<int THRL> __device__ __forceinline__ void attn_unit(int qcol,int vcol,int ocol,int hb,int qb,const bf16*Q,const bf16*K,const bf16*V,bf16*O,const float*biasd,char*shm){
  int tid_=threadIdx.x; asm volatile("":"+v"(tid_)); const int tid=tid_,lane=tid&63,r32=lane&31,hi=lane>>5; const int wid=__builtin_amdgcn_readfirstlane(tid>>6);
  const long rowbase=0; const int q0=qb*QB;
  const bf16*Qw=Q+(rowbase+q0+wid*QBLK)*DM+qcol;
  const bf16*Kh=K+rowbase*DM+qcol,*Vh=V+rowbase*DM+vcol;
  { __attribute__((address_space(3))) float* btw=(__attribute__((address_space(3))) float*)(lds_cptr)shm+LDS_BT/4; if(tid<128)btw[tid]=biasd[hb*128+tid]; }
  const lds_cfptr btab=(lds_cfptr)((lds_cptr)shm+LDS_BT);
  const unsigned lds0=(unsigned)(uintptr_t)shm;
  float*wsf=(float*)(shm+LDS_WS)+wid*64;
  const bf16*ksrc=Kh+(long)lane*DM+wid*8;
  const bf16*vsrc=Vh+(long)(16*(wid&3)+(lane>>2))*DM+(wid>>2)*32+(lane&3)*8;
  const unsigned kdst=lds0+LDS_K+wid*1024, vdst=lds0+LDS_V+wid*1024;
  #define DMA_K(t,slot) glds16(ksrc+(long)(t)*KVBLK*DM,(unsigned)__builtin_amdgcn_readfirstlane(kdst+(slot)))
  #define DMA_V(t,slot) glds16(vsrc+(long)(t)*KVBLK*DM,(unsigned)__builtin_amdgcn_readfirstlane(vdst+(slot)))
  const int vb0=(int)(lds0+LDS_V)+((lane>>4)&1)*32+(lane&3)*8+(4*hi+((lane&15)>>2))*64;
  const char*Kbase=shm+LDS_K; bf16x8 kf[8];
  const lds_cptr shm3=(lds_cptr)shm; const lds_cptr kp0=shm3+LDS_K+hi*1024+r32*16; const lds_cptr vp0=shm3+LDS_V+((lane>>4)&1)*32+(lane&3)*8+(4*hi+((lane&15)>>2))*64;
  const int NT=(q0+QB)/KVBLK;
  DMA_K(0,0);DMA_V(0,0);DMA_K(1,SLOTB);
  bf16x8 qr[4];
  #pragma unroll
  for(int d0=0;d0<4;++d0)qr[d0]=*reinterpret_cast<const bf16x8*>(&Qw[(long)r32*DM+d0*16+hi*8]);
  float mhat=0.f,l_reg=0.f;f32x16 o[2];o[0]=f32x16{};o[1]=f32x16{};f32x16 negm=f32x16{};asm volatile("":"+v"(negm));
  const int qrel=wid*QBLK+r32;
  #define CMASK(P0,P1,t) do{int jb_=(t)-(NT-4); if(jb_>=-2)cmask(P0,P1,jb_,qrel,hi,btab);}while(0)
  bool resc=false;
  #define START(P0,P1) do{ const float rm=rowmax(P0,P1); resc=false; \
    { const float dl=rm; mhat=fadd_s(mhat,dl); \
      _Pragma("unroll") for(int r=0;r<16;++r){P0[r]=fsub_s(P0[r],dl);P1[r]=fsub_s(P1[r],dl);} \
      _Pragma("unroll") for(int r=0;r<16;++r)negm[r]=-mhat; asm volatile("":"+v"(negm)); } \
    _Pragma("unroll") for(int r=0;r<16;++r)P0[r]=__builtin_amdgcn_exp2f(P0[r]); }while(0)
  #define RESC() do{ if(resc){ asm volatile("s_waitcnt lgkmcnt(0)":::"memory"); \
      _Pragma("unroll") for(int d_=0;d_<2;++d_) _Pragma("unroll") for(int r=0;r<16;++r)o[d_][r]*=wsf[crow(r,hi)]; } }while(0)
  f32x16 pA0,pA1,pB0,pB1;
  int sl_prev=0,sl_cur=0,sl_next=SLOTB;
  #define ROT() do{sl_prev=sl_cur;sl_cur=sl_next;sl_next=(sl_next==(NSLOT-1)*SLOTB)?0:sl_next+SLOTB;}while(0)
  DMA_K(2,2*SLOTB);
  WAIT_BAR(3);
  qkt(pA0,pA1,Kbase,qr,negm,r32,hi);asm volatile("s_nop 15\n\ts_nop 7":"+v"(pA0),"+v"(pA1));CMASK(pA0,pA1,0);
  START(pA0,pA1);
  _Pragma("unroll") for(int r=0;r<16;++r)pA1[r]=__builtin_amdgcn_exp2f(pA1[r]);
  WAIT_BAR(0);
  DMA_K(3,0);DMA_V(1,SLOTB);
  ROT();
  kload8(kf,kp0+sl_cur);
  WAIT_BAR(2);
  s16x4 vlo[8],vhi[8]; u32x4 pw0,pw1,pw2,pw3;
  #define PKW(P,B) cvtpk_s(P[B],P[B+1])
  #define PAF(k) __builtin_bit_cast(bf16x8,pw##k)
  #define VFR(i) (bf16x8){vlo[i][0],vlo[i][1],vlo[i][2],vlo[i][3],vhi[i][0],vhi[i][1],vhi[i][2],vhi[i][3]}
  #define PIN(x) asm volatile("":"+v"(x))
  #define MX3(a,b,c) __builtin_fmaxf(__builtin_fmaxf((a),(b)),(c))
  #define GAPA(MF,A0,A1,A2,A3,W0,W1,PW) do{ MF; sacc+=A0; sacc+=A1; sacc+=A2; sacc+=A3; PIN(sacc); W0; W1; PIN(PW); SBAR(); }while(0)
  #define EX(v) __builtin_amdgcn_exp2f(v)
  #define GAPB(MF,X,B) do{ MF; X[B]=EX(X[B]); X[B+1]=EX(X[B+1]); X[B+2]=EX(X[B+2]); X[B+3]=EX(X[B+3]); PIN(X); SBAR(); }while(0)
  #define VRD(i) do{ vlo[i]=vtr(vp_+(((i)>>2)*4096+((i)&3)*1024)); vhi[i]=vtr(vp_+(((i)>>2)*4096+((i)&3)*1024+512)); }while(0)
  #define KRD(G,j) do{ if(G){ kload2(kf,kp0+sl_next,j); SBAR(); } }while(0)
  #define STEP(C0,C1,P0,P1,t,GK,GV,GL) do{ SBAR(); \
    const lds_cptr vp_=vp0+sl_prev; \
    VRD(0); SBAR(); float sacc=(P0[0]+P0[1]); \
    GAPA(C0=__builtin_amdgcn_mfma_f32_32x32x16_bf16(kf[0],qr[0],negm,0,0,0), P0[2],P0[3],P0[4],P0[5],     pw0[0]=PKW(P0,0), pw0[1]=PKW(P0,2), pw0); \
    VRD(4); SBAR(); GAPA(C1=__builtin_amdgcn_mfma_f32_32x32x16_bf16(kf[1],qr[0],negm,0,0,0), P0[6],P0[7],P0[8],P0[9],     pw0[2]=PKW(P0,4), pw0[3]=PKW(P0,6), pw0); \
    VRD(1); SBAR(); GAPA(C0=__builtin_amdgcn_mfma_f32_32x32x16_bf16(kf[2],qr[1],C0,0,0,0),   P0[10],P0[11],P0[12],P0[13], pw1[0]=PKW(P0,8), pw1[1]=PKW(P0,10), pw1); \
    VRD(5); SBAR(); GAPA(C1=__builtin_amdgcn_mfma_f32_32x32x16_bf16(kf[3],qr[1],C1,0,0,0),   P0[14],P0[15],P1[0],P1[1],   pw1[2]=PKW(P0,12),pw1[3]=PKW(P0,14), pw1); \
    VRD(2); SBAR(); GAPA(C0=__builtin_amdgcn_mfma_f32_32x32x16_bf16(kf[4],qr[2],C0,0,0,0),   P1[2],P1[3],P1[4],P1[5],     pw2[0]=PKW(P1,0), pw2[1]=PKW(P1,2), pw2); \
    VRD(6); SBAR(); GAPA(C1=__builtin_amdgcn_mfma_f32_32x32x16_bf16(kf[5],qr[2],C1,0,0,0),   P1[6],P1[7],P1[8],P1[9],     pw2[2]=PKW(P1,4), pw2[3]=PKW(P1,6), pw2); \
    VRD(3); SBAR(); GAPA(C0=__builtin_amdgcn_mfma_f32_32x32x16_bf16(kf[6],qr[3],C0,0,0,0),   P1[10],P1[11],P1[12],P1[13], pw3[0]=PKW(P1,8), pw3[1]=PKW(P1,10), pw3); \
    VRD(7); SBAR(); GAPA(C1=__builtin_amdgcn_mfma_f32_32x32x16_bf16(kf[7],qr[3],C1,0,0,0),   P1[14],P1[15],0.f,0.f,       pw3[2]=PKW(P1,12),pw3[3]=PKW(P1,14), pw3); \
    l_reg+=sacc; \
    if(GK){DMA_K((t)+3,sl_cur);} if(GV){DMA_V((t)+1,sl_next);} \
    CMASK(C0,C1,t); \
    { float a=MX3(C0[0],C0[1],C1[0]),b=MX3(C0[2],C0[3],C1[1]); a=MX3(a,C1[2],C1[3]); \
      _Pragma("unroll") for(int r=4;r<16;r+=4){a=MX3(a,C0[r],C0[r+1]);b=MX3(b,C0[r+2],C0[r+3]);a=MX3(a,C1[r],C1[r+1]);b=MX3(b,C1[r+2],C1[r+3]);} \
      float rm=__builtin_fmaxf(a,b); { auto rr=__builtin_amdgcn_permlane32_swap(__float_as_uint(rm),__float_as_uint(rm),false,false); rm=__builtin_fmaxf(__uint_as_float(rr[0]),__uint_as_float(rr[1])); } \
      resc=false; \
      if(__builtin_expect(__any(rm>(float)THRL),0)){ const float dl=__builtin_fmaxf(rm,0.f); mhat+=dl; \
        _Pragma("unroll") for(int r=0;r<16;++r){C0[r]-=dl;C1[r]-=dl;} \
        _Pragma("unroll") for(int r=0;r<16;++r)negm[r]=-mhat; asm volatile("":"+v"(negm)); \
        const float f=__builtin_amdgcn_exp2f(-dl); l_reg*=f; if(hi==0)wsf[r32]=f; resc=true; } } \
    SBAR(); \
    GAPB(o[0]=__builtin_amdgcn_mfma_f32_32x32x16_bf16(PAF(0),VFR(0),o[0],0,0,0), C0,0); \
    GAPB(o[1]=__builtin_amdgcn_mfma_f32_32x32x16_bf16(PAF(0),VFR(4),o[1],0,0,0), C0,4); \
    KRD(GL,0); GAPB(o[0]=__builtin_amdgcn_mfma_f32_32x32x16_bf16(PAF(1),VFR(1),o[0],0,0,0), C0,8); \
    KRD(GL,1); GAPB(o[1]=__builtin_amdgcn_mfma_f32_32x32x16_bf16(PAF(1),VFR(5),o[1],0,0,0), C0,12); \
    KRD(GL,2); GAPB(o[0]=__builtin_amdgcn_mfma_f32_32x32x16_bf16(PAF(2),VFR(2),o[0],0,0,0), C1,0); \
    KRD(GL,3); GAPB(o[1]=__builtin_amdgcn_mfma_f32_32x32x16_bf16(PAF(2),VFR(6),o[1],0,0,0), C1,4); \
    GAPB(o[0]=__builtin_amdgcn_mfma_f32_32x32x16_bf16(PAF(3),VFR(3),o[0],0,0,0), C1,8); \
    GAPB(o[1]=__builtin_amdgcn_mfma_f32_32x32x16_bf16(PAF(3),VFR(7),o[1],0,0,0), C1,12); \
    }while(0)
  int t=1;
  #undef CMASK
  #define CMASK(P0,P1,t) do{}while(0)
  for(;t+7<NT;t+=2){
    STEP(pB0,pB1,pA0,pA1,t,true,true,true);     WAIT_BAR(2); RESC(); ROT();
    STEP(pA0,pA1,pB0,pB1,t+1,true,true,true);   WAIT_BAR(2); RESC(); ROT();
  }
  #undef CMASK
  #define CMASK(P0,P1,t) do{int jb_=(t)-(NT-4); if(jb_>=-2)cmask(P0,P1,jb_,qrel,hi,btab);}while(0)
  #define ENDW(tt) do{ if((tt)+3<NT){WAIT_BAR(2);} else if((tt)+2<NT){WAIT_BAR(1);} else {WAIT_BAR(0);} }while(0)
  for(;t+1<NT;t+=2){
    STEP(pB0,pB1,pA0,pA1,t,(t+3<NT),(t+1<NT),(t+1<NT));       ENDW(t);   RESC(); ROT();
    STEP(pA0,pA1,pB0,pB1,t+1,(t+4<NT),(t+2<NT),(t+2<NT));     ENDW(t+1); RESC(); ROT();
  }
  STEP(pB0,pB1,pA0,pA1,NT-1,false,false,false); RESC();
  { float sacc=pB0[0]+pB0[1]; _Pragma("unroll") for(int r=2;r<16;++r)sacc+=pB0[r]; _Pragma("unroll") for(int r=0;r<16;++r)sacc+=pB1[r]; l_reg+=sacc;
    pw0=(u32x4){PKW(pB0,0),PKW(pB0,2),PKW(pB0,4),PKW(pB0,6)};pw1=(u32x4){PKW(pB0,8),PKW(pB0,10),PKW(pB0,12),PKW(pB0,14)};pw2=(u32x4){PKW(pB1,0),PKW(pB1,2),PKW(pB1,4),PKW(pB1,6)};pw3=(u32x4){PKW(pB1,8),PKW(pB1,10),PKW(pB1,12),PKW(pB1,14)};
    SBAR(); pv(o,vb0+sl_cur,PAF(0),PAF(1),PAF(2),PAF(3)); }
  #undef PKW
  #undef PAF
  #undef VFR
  #undef PIN
  #undef MX3
  #undef GAPA
  #undef GAPB
  #undef EX
  #undef VRD
  #undef KRD
  #undef STEP
  #undef ENDW
  {auto rr=__builtin_amdgcn_permlane32_swap(__float_as_uint(l_reg),__float_as_uint(l_reg),false,false);l_reg=__uint_as_float(rr[0])+__uint_as_float(rr[1]);}
  if(hi==0)wsf[32+r32]=l_reg;asm volatile("s_waitcnt lgkmcnt(0)":::"memory");
  float rli[16];
  #pragma unroll
  for(int r=0;r<16;++r)rli[r]=__builtin_amdgcn_rcpf(wsf[32+crow(r,hi)]);
  bf16*Ow=O+(rowbase+q0+wid*QBLK)*OPITCH+ocol;
  { bf16*stg=(bf16*)(shm+LDS_OST)+wid*2048;
    #pragma unroll
    for(int r=0;r<16;++r){const int orow=crow(r,hi);
      #pragma unroll
      for(int d0=0;d0<2;++d0)stg[orow*64+d0*32+r32]=__float2bfloat16(o[d0][r]*rli[r]);}
    asm volatile("s_waitcnt lgkmcnt(0)":::"memory");
    #pragma unroll
    for(int i=0;i<4;++i){const int row=i*8+(lane>>3),ch=lane&7; const u32x4 v=*(const u32x4*)(stg+row*64+ch*8); ATTN_STORE16(Ow+(long)row*OPITCH+ch*8,v);} }
  asm volatile("s_waitcnt lgkmcnt(0)\n\ts_barrier":::"memory");
  #undef DMA_K
  #undef DMA_V
  #undef CMASK
  #undef START
  #undef RESC
  #undef ROT
}
constexpr int ATTN_LDS_BYTES=LDS_BYTES;
struct AttnTensors { const bf16* Q; const bf16* K; const bf16* V; bf16* O; const float* biasd; };
template<int THRL=8> __device__ __forceinline__ void attn_phase(char*lds,const AttnTensors&T,int vcu){
  const int inst=vcu>>3, s=vcu&7;
  for(int i=0;i<4;++i){ const int qb=(i==0)?s:(i==1)?15-s:(i==2)?16+s:31-s;
    attn_unit<THRL>((inst>>1)*64,(inst>>2)*128+(inst&1)*64,inst*64,inst>>2,qb,T.Q,T.K,T.V,T.O,T.biasd,lds); }
}
#undef SBAR
#undef WAIT_BAR
}
constexpr int NWAVES = 8;
constexpr int SEQ = 8192, DM = 2048, DFF = 5632, INW = 4096, AW = 1024, SW = 1024, NCOND = 9, DEPTH = 2;
constexpr int NG = 64, NP = 64, HC = 16;
constexpr int SCHUNK = 256, NCHUNK = SEQ / SCHUNK;
constexpr float LOG2E = 1.4426950408889634f;
constexpr size_t MiB = 1u << 20;
constexpr size_t WS_CTL = 0, CTL_ZERO_BYTES = 1 * MiB;
constexpr size_t WS_BIASD = 1 * MiB;
constexpr size_t WS_XEND = 2 * MiB;
constexpr size_t WS_WGU = 8 * MiB;
constexpr size_t WS_WD = WS_WGU + 4 * 44 * MiB;
constexpr size_t WS_WIN = WS_WD + 4 * 22 * MiB;
constexpr size_t WS_WOUT = WS_WIN + 2 * 16 * MiB;
constexpr size_t WS_WGLU = WS_WOUT + 2 * 8 * MiB;
constexpr size_t WS_H = WS_WGLU + 2 * 2 * MiB;
constexpr size_t WS_ACT = WS_H + 32 * MiB;
constexpr size_t WS_Q = WS_ACT + 88 * MiB;
constexpr size_t WS_K = WS_Q + 16 * MiB, WS_V = WS_K + 16 * MiB, WS_U = WS_V + 16 * MiB;
constexpr size_t WS_OP = WS_U + 16 * MiB;
constexpr size_t WS_CAT = WS_OP + 32 * MiB;
constexpr size_t WS_YG = WS_CAT + 32 * MiB;
constexpr size_t WS_END = WS_YG + 16 * MiB;
constexpr int RING_BYTES = 131072, LDS_BYTES = 147456;

#define LAS __attribute__((address_space(3)))
typedef unsigned short bf16;
typedef unsigned v4u __attribute__((ext_vector_type(4)));
typedef unsigned v2u __attribute__((ext_vector_type(2)));
typedef float f32x4 __attribute__((ext_vector_type(4)));
typedef float f32x2v __attribute__((ext_vector_type(2)));
typedef short bf16x8 __attribute__((ext_vector_type(8)));
#define LDS_WAIT() asm volatile("s_waitcnt lgkmcnt(0)" ::: "memory")
__device__ __forceinline__ unsigned pk2(float lo, float hi) { return pg8::cvt_pk_bf16(lo, hi); }
__device__ __forceinline__ float wave_sum(float v) {
#pragma unroll
    for (int o = 1; o < 64; o <<= 1) v += __shfl_xor(v, o);
    return v;
}

struct Frame {
    LAS unsigned char* lds;
    int tid, lane, wave, vcu, G;
};
__device__ __forceinline__ Frame frame_opaque(const Frame& F0) { Frame F = F0; asm volatile("" : "+v"(F.tid)); F.lane = F.tid & 63; return F; }

__device__ __forceinline__ void p0_transpose_item(const float* W, int K, int N, bf16* WT, int k0, int n0, int drow0, LAS float* scr, int lane) {
#pragma unroll 8
    for (int i = 0; i < 32; ++i) { const int kk = 2 * i + (lane >> 5); scr[kk * 33 + (lane & 31)] = W[(size_t)(k0 + kk) * N + n0 + (lane & 31)]; }
    LDS_WAIT(); asm volatile("" ::: "memory");
    const int c = lane & 7;
#pragma unroll
    for (int j = 0; j < 4; ++j) { const int n = (lane >> 3) + 8 * j; const LAS float* s = scr + (8 * c) * 33 + n;
        v4u o; o.x = pk2(s[0 * 33], s[1 * 33]); o.y = pk2(s[2 * 33], s[3 * 33]); o.z = pk2(s[4 * 33], s[5 * 33]); o.w = pk2(s[6 * 33], s[7 * 33]);
        *(v4u*)(WT + (size_t)(drow0 + n) * K + k0 + 8 * c) = o; }
    LDS_WAIT(); asm volatile("" ::: "memory");
}
__device__ __forceinline__ void p0_matrix_item(const float* W, int K, int N, bf16* WT, int mode, int item, LAS float* scr, int lane) {
    const int nblk = N / 32, kb = item / nblk, nb = item % nblk, k0 = 64 * kb, n0 = 32 * nb;
    int drow0 = n0;
    if (mode == 1 || mode == 2) drow0 = (n0 >> 7) * 256 + (mode - 1) * 128 + (n0 & 127);
    else if (mode == 3 && n0 < 2048) { const int pn = n0 >> 8, cc = n0 & 255; drow0 = pn * 256 + ((cc >> 5) & 1) * 128 + (cc >> 6) * 32; }
    p0_transpose_item(W, K, N, WT, k0, n0, drow0, scr, lane);
}
struct In { const float* p[31]; };
__device__ __forceinline__ const float* inp(int i) { const float* const __attribute__((address_space(4)))* t = (const float* const __attribute__((address_space(4)))*)__builtin_amdgcn_kernarg_segment_ptr(); asm volatile("" : "+s"(t)); return t[i]; }
__device__ __forceinline__ int t5_bucket(int d) {
    if (d < 16) return d;
    int b = 16; b += d >= 19; b += d >= 21; b += d >= 24; b += d >= 27; b += d >= 31; b += d >= 35; b += d >= 40; b += d >= 46; b += d >= 52; b += d >= 59; b += d >= 67; b += d >= 77; b += d >= 87; b += d >= 99; b += d >= 113;
    return b;
}
__device__ __forceinline__ void p0_prologue(const Frame& F0, unsigned char* ws) { const Frame F = frame_opaque(F0);
    LAS float* scr = (LAS float*)(F.lds + F.wave * 16384);
    const int gw = F.vcu * NWAVES + F.wave, NGW = F.G * NWAVES;
    if (blockIdx.x == 0) { float* bd = (float*)(ws + WS_BIASD); const float* rb = inp(2);
        for (int i = F.tid; i < 1024; i += NWAVES * 64) { const int h = i >> 7, d = i & 127; bd[i] = (rb[t5_bucket(d) * 8 + h] - rb[31 * 8 + h]) * LOG2E; } }
    { float* mod = (float*)(ws + WS_CTL); const float* cvec = inp(1);
      for (int it = gw; it < 144 * 16; it += NGW) { const int cb = it % 144, kc = it / 144, layer = cb / 72, col = (cb % 72) * 256 + F.lane * 4;
          const float* W = inp(3) + ((size_t)layer * DM + kc * 128) * (NCOND * DM) + col;
          f32x4 acc = (f32x4){0.f, 0.f, 0.f, 0.f}; if (kc == 0) acc = *(const f32x4*)(inp(4) + layer * (NCOND * DM) + col);
#pragma unroll 8
          for (int kk = 0; kk < 128; ++kk) { const float cv = cvec[kc * 128 + kk]; const float sv = cv * pg8::sigmoid_f(cv); acc += sv * *(const f32x4*)(W + (size_t)kk * (NCOND * DM)); }
          float* dst = mod + layer * (NCOND * DM) + col; atomicAdd(dst, acc[0]); atomicAdd(dst + 1, acc[1]); atomicAdd(dst + 2, acc[2]); atomicAdd(dst + 3, acc[3]); } }
    constexpr int I_F = (DM / 64) * (DFF / 32), I_IN = (DM / 64) * (INW / 32), I_OUT = (DM / 64) * (DM / 32), I_GLU = (SW / 64) * (SW / 32);
    constexpr int PER_LAYER = 6 * I_F + I_IN + I_OUT + I_GLU;
    for (int it = gw; it < DEPTH * PER_LAYER; it += NGW) {
        const int li = it / PER_LAYER; int r = it % PER_LAYER;
        const size_t fo = (size_t)li * DM * DFF;
        bf16* wgu1 = (bf16*)(ws + WS_WGU) + (size_t)(li * 2 + 0) * 2 * DFF * DM; bf16* wgu2 = (bf16*)(ws + WS_WGU) + (size_t)(li * 2 + 1) * 2 * DFF * DM;
        bf16* wd1 = (bf16*)(ws + WS_WD) + (size_t)(li * 2 + 0) * DM * DFF; bf16* wd2 = (bf16*)(ws + WS_WD) + (size_t)(li * 2 + 1) * DM * DFF;
        if (r < I_F) { p0_matrix_item(inp(6) + fo, DM, DFF, wgu1, 1, r, scr, F.lane); continue; } r -= I_F;
        if (r < I_F) { p0_matrix_item(inp(7) + fo, DM, DFF, wgu1, 2, r, scr, F.lane); continue; } r -= I_F;
        if (r < I_F) { p0_matrix_item(inp(8) + fo, DFF, DM, wd1, 0, r, scr, F.lane); continue; } r -= I_F;
        if (r < I_F) { p0_matrix_item(inp(9) + fo, DM, DFF, wgu2, 1, r, scr, F.lane); continue; } r -= I_F;
        if (r < I_F) { p0_matrix_item(inp(10) + fo, DM, DFF, wgu2, 2, r, scr, F.lane); continue; } r -= I_F;
        if (r < I_F) { p0_matrix_item(inp(11) + fo, DFF, DM, wd2, 0, r, scr, F.lane); continue; } r -= I_F;
        if (r < I_IN) { p0_matrix_item(inp(12) + (size_t)li * DM * INW, DM, INW, (bf16*)(ws + WS_WIN) + (size_t)li * INW * DM, 3, r, scr, F.lane); continue; } r -= I_IN;
        if (r < I_OUT) { p0_matrix_item(inp(13) + (size_t)li * DM * DM, DM, DM, (bf16*)(ws + WS_WOUT) + (size_t)li * DM * DM, 0, r, scr, F.lane); continue; } r -= I_OUT;
        p0_matrix_item(inp(29) + (size_t)li * SW * SW, SW, SW, (bf16*)(ws + WS_WGLU) + (size_t)li * SW * SW, 0, r, scr, F.lane);
    }
}

__device__ __forceinline__ void norm_phase(const Frame& F0, const float* xin, const float* gnorm, const float* shift, const float* scale, bf16* H) { const Frame F = frame_opaque(F0);
    const int gw = F.vcu * NWAVES + F.wave, NGW = F.G * NWAVES;
    f32x4 gam[8], sh[8];
#pragma unroll
    for (int j = 0; j < 8; ++j) { const int idx = 4 * F.lane + 256 * j; gam[j] = *(const f32x4*)(gnorm + idx) * (1.0f + *(const f32x4*)(scale + idx)); sh[j] = *(const f32x4*)(shift + idx); }
    for (int m = gw; m < SEQ; m += NGW) {
        const f32x4* xr = (const f32x4*)(xin + (size_t)m * DM) + F.lane;
        f32x4 v[8]; float s = 0.f;
#pragma unroll
        for (int j = 0; j < 8; ++j) { v[j] = xr[64 * j]; s += (v[j].x * v[j].x + v[j].y * v[j].y) + (v[j].z * v[j].z + v[j].w * v[j].w); }
        const float rstd = __builtin_amdgcn_rsqf(wave_sum(s) * (1.0f / DM) + 1e-6f);
        v2u* o8 = (v2u*)(H + (size_t)m * DM) + F.lane;
#pragma unroll
        for (int j = 0; j < 8; ++j) { const f32x4 y = v[j] * rstd * gam[j] + sh[j]; v2u w; w.x = pk2(y.x, y.y); w.y = pk2(y.z, y.w); o8[64 * j] = w; }
    }
}

__device__ __forceinline__ void combine_phase(const Frame& F0, const bf16* OP, bf16* CAT, const float* lq1, const float* lk1, const float* lq2, const float* lk2, const float* subg, float lam_init) { const Frame F = frame_opaque(F0);
    const int gw = F.vcu * NWAVES + F.wave, NGW = F.G * NWAVES;
    const float lam = expf(wave_sum(lq1[F.lane] * lk1[F.lane])) - expf(wave_sum(lq2[F.lane] * lk2[F.lane])) + lam_init;
    const int h = F.lane >> 3, j0 = (F.lane & 7) * 16;
    float gs[16];
#pragma unroll
    for (int i = 0; i < 16; ++i) gs[i] = subg[j0 + i] * (1.0f - lam_init);
    for (int m = gw; m < SEQ; m += NGW) {
        const bf16* p1 = OP + (size_t)m * 2048 + (2 * h) * 128 + j0; const bf16* p2 = p1 + 128;
        const v4u a0 = *(const v4u*)p1, a1 = *(const v4u*)(p1 + 8), b0 = *(const v4u*)p2, b1 = *(const v4u*)(p2 + 8);
        float o[16];
#pragma unroll
        for (int i = 0; i < 4; ++i) { o[2 * i] = pg8::bf_lo(a0[i]) - lam * pg8::bf_lo(b0[i]); o[2 * i + 1] = pg8::bf_hi(a0[i]) - lam * pg8::bf_hi(b0[i]);
                                      o[8 + 2 * i] = pg8::bf_lo(a1[i]) - lam * pg8::bf_lo(b1[i]); o[8 + 2 * i + 1] = pg8::bf_hi(a1[i]) - lam * pg8::bf_hi(b1[i]); }
        float ss = 0.f;
#pragma unroll
        for (int i = 0; i < 16; ++i) ss += o[i] * o[i];
        ss += __shfl_xor(ss, 1); ss += __shfl_xor(ss, 2); ss += __shfl_xor(ss, 4);
        const float r = __builtin_amdgcn_rsqf(ss * (1.0f / 128.0f) + 1e-5f);
        v4u w0, w1;
#pragma unroll
        for (int i = 0; i < 4; ++i) { w0[i] = pk2(o[2 * i] * r * gs[2 * i], o[2 * i + 1] * r * gs[2 * i + 1]); w1[i] = pk2(o[8 + 2 * i] * r * gs[8 + 2 * i], o[8 + 2 * i + 1] * r * gs[8 + 2 * i + 1]); }
        bf16* q = CAT + (size_t)m * 2048 + h * 128 + j0; *(v4u*)q = w0; *(v4u*)(q + 8) = w1;
    }
}

struct SsmP { const float *lam_re, *lam_im, *log_step, *b_re, *b_im, *c_re, *c_im, *dv; };
__device__ __forceinline__ void cexp_s(float lr, float li, float s, float& er, float& ei) {
    const float m = expf(lr * s);
    double tr = (double)li * (double)s * 0.15915494309189535; tr -= floor(tr);
    const float a = (float)(tr * 6.283185307179586);
    float sn, cs; sincosf(a, &sn, &cs); er = m * cs; ei = m * sn;
}
__device__ __forceinline__ void ssm_lam(const SsmP& P, int g, int p, float& lr, float& li, float& step) {
    lr = fminf(P.lam_re[g * NP + p], -1e-4f); li = P.lam_im[g * NP + p]; step = expf(P.log_step[g]);
}
__device__ __forceinline__ void ssm_bfrag(const SsmP& P, int g, int lane, bf16x8 (&bfr)[8]) {
    const int q = lane >> 4, ci = lane & 15, hb = 8 * (q & 1);
#pragma unroll
    for (int pb = 0; pb < 4; ++pb) { const int p = 16 * pb + ci; float lr, li, step, ar, ai; ssm_lam(P, g, p, lr, li, step); cexp_s(lr, li, step, ar, ai);
        const float nr = ar - 1.0f, ni = ai, den = 1.0f / (lr * lr + li * li); const float cr = (nr * lr + ni * li) * den, cim = (ni * lr - nr * li) * den;
        const float* br = P.b_re + ((size_t)g * NP + p) * HC + hb; const float* bi = P.b_im + ((size_t)g * NP + p) * HC + hb;
        const f32x4 r0 = *(const f32x4*)br, r1 = *(const f32x4*)(br + 4), i0 = *(const f32x4*)bi, i1 = *(const f32x4*)(bi + 4);
        const f32x4 re0 = cr * r0 - cim * i0, re1 = cr * r1 - cim * i1, im0 = cr * i0 + cim * r0, im1 = cr * i1 + cim * r1;
        v4u wr_, wi_; wr_.x = pk2(re0[0], re0[1]); wr_.y = pk2(re0[2], re0[3]); wr_.z = pk2(re1[0], re1[1]); wr_.w = pk2(re1[2], re1[3]);
        wi_.x = pk2(im0[0], im0[1]); wi_.y = pk2(im0[2], im0[3]); wi_.z = pk2(im1[0], im1[1]); wi_.w = pk2(im1[2], im1[3]);
        if (q >= 2) { wr_ = (v4u){0u, 0u, 0u, 0u}; wi_ = (v4u){0u, 0u, 0u, 0u}; }
        bfr[pb] = __builtin_bit_cast(bf16x8, wr_); bfr[4 + pb] = __builtin_bit_cast(bf16x8, wi_); }
}
constexpr int BU_STRIDE = 132, XB_STRIDE = 136;
__device__ __forceinline__ void ssm_bu_to_lds(bf16x8 af, const bf16x8 (&bfr)[8], LAS float* bu, int lane) {
    const int q = lane >> 4, ci = lane & 15;
#pragma unroll
    for (int nb = 0; nb < 8; ++nb) { const f32x4 d = __builtin_amdgcn_mfma_f32_16x16x32_bf16(af, bfr[nb], (f32x4){0.f, 0.f, 0.f, 0.f}, 0, 0, 0);
#pragma unroll
        for (int r = 0; r < 4; ++r) bu[(4 * q + r) * BU_STRIDE + 16 * nb + ci] = d[r]; }
}
__device__ __forceinline__ bf16x8 ssm_load_u(const bf16* U, int g, int t, int q) {
    bf16x8 af = (bf16x8){0, 0, 0, 0, 0, 0, 0, 0};
    if (q < 2) af = *(const bf16x8*)(U + (size_t)t * SW + g * HC + 8 * q);
    return af;
}
__device__ __forceinline__ void ssm_pass1(const Frame& F0, const SsmP& P, const bf16* U, float* XEND) { const Frame F = frame_opaque(F0);
    const int gw = F.vcu * NWAVES + F.wave, NGW = F.G * NWAVES, lane = F.lane, q = lane >> 4, ci = lane & 15;
    LAS float* bu = (LAS float*)(F.lds + F.wave * 16384);
    for (int it = gw; it < NG * NCHUNK; it += NGW) { const int g = it / NCHUNK, c = it % NCHUNK, t0 = c * SCHUNK;
        bf16x8 bfr[8]; ssm_bfrag(P, g, lane, bfr);
        float lr, li, step, ar, ai; ssm_lam(P, g, lane, lr, li, step); cexp_s(lr, li, step, ar, ai);
        float xr = 0.f, xi = 0.f;
        bf16x8 af = ssm_load_u(U, g, t0 + ci, q);
        for (int sb = 0; sb < SCHUNK / 16; ++sb) {
            ssm_bu_to_lds(af, bfr, bu, lane);
            if (sb + 1 < SCHUNK / 16) af = ssm_load_u(U, g, t0 + (sb + 1) * 16 + ci, q);
            LDS_WAIT();
#pragma unroll
            for (int tt = 0; tt < 16; ++tt) { const float br_ = bu[tt * BU_STRIDE + lane], bi_ = bu[tt * BU_STRIDE + 64 + lane];
                const float nxr = ar * xr - ai * xi + br_, nxi = ar * xi + ai * xr + bi_; xr = nxr; xi = nxi; }
            LDS_WAIT();
        }
        *(f32x2v*)(XEND + ((size_t)it * NP + lane) * 2) = (f32x2v){xr, xi};
    }
}
__device__ __forceinline__ float gelu_tanh(float x) {
    const float z = x + 0.044715f * x * x * x;
    return x * __builtin_amdgcn_rcpf(1.0f + __builtin_amdgcn_exp2f(-2.0f * 0.7978845608028654f * LOG2E * z));
}
__device__ __forceinline__ void ssm_pass2(const Frame& F0, const SsmP& P, const bf16* U, const float* XEND, bf16* YG) { const Frame F = frame_opaque(F0);
    const int gw = F.vcu * NWAVES + F.wave, NGW = F.G * NWAVES, lane = F.lane, q = lane >> 4, ci = lane & 15;
    LAS float* bu = (LAS float*)(F.lds + F.wave * 16384);
    LAS bf16* xb = (LAS bf16*)(F.lds + F.wave * 16384 + 16 * BU_STRIDE * 4);
    for (int it = gw; it < NG * NCHUNK; it += NGW) { const int g = it / NCHUNK, c = it % NCHUNK, t0 = c * SCHUNK;
        bf16x8 bfr[8]; ssm_bfrag(P, g, lane, bfr);
        float lr, li, step, ar, ai; ssm_lam(P, g, lane, lr, li, step); cexp_s(lr, li, step, ar, ai);
        float xr = 0.f, xi = 0.f;
        { float aTr, aTi; cexp_s(lr, li, step * (float)SCHUNK, aTr, aTi);
          for (int cc = 0; cc < c; ++cc) { const f32x2v e = *(const f32x2v*)(XEND + ((size_t)(g * NCHUNK + cc) * NP + lane) * 2);
              const float nxr = aTr * xr - aTi * xi + e.x, nxi = aTr * xi + aTi * xr + e.y; xr = nxr; xi = nxi; } }
        bf16x8 cf[4];
#pragma unroll
        for (int kb = 0; kb < 4; ++kb) { const float* src = (kb < 2 ? P.c_re : P.c_im) + ((size_t)g * HC + ci) * NP + 32 * (kb & 1) + 8 * q; const float sg = kb < 2 ? 1.0f : -1.0f;
            const f32x4 a = *(const f32x4*)src * sg, b = *(const f32x4*)(src + 4) * sg;
            v4u w; w.x = pk2(a[0], a[1]); w.y = pk2(a[2], a[3]); w.z = pk2(b[0], b[1]); w.w = pk2(b[2], b[3]); cf[kb] = __builtin_bit_cast(bf16x8, w); }
        const f32x4 dv4 = *(const f32x4*)(P.dv + g * HC + 4 * q);
        bf16x8 af = ssm_load_u(U, g, t0 + ci, q);
        for (int sb = 0; sb < SCHUNK / 16; ++sb) {
            ssm_bu_to_lds(af, bfr, bu, lane);
            if (sb + 1 < SCHUNK / 16) af = ssm_load_u(U, g, t0 + (sb + 1) * 16 + ci, q);
            const int t = t0 + sb * 16 + ci;
            const v2u uu = *(const v2u*)(U + (size_t)t * SW + g * HC + 4 * q);
            LDS_WAIT();
#pragma unroll
            for (int tt = 0; tt < 16; ++tt) { const float br_ = bu[tt * BU_STRIDE + lane], bi_ = bu[tt * BU_STRIDE + 64 + lane];
                const float nxr = ar * xr - ai * xi + br_, nxi = ar * xi + ai * xr + bi_; xr = nxr; xi = nxi;
                const unsigned pk = pk2(xr, xi); xb[tt * XB_STRIDE + lane] = (bf16)(pk & 0xffffu); xb[tt * XB_STRIDE + 64 + lane] = (bf16)(pk >> 16); }
            LDS_WAIT();
            f32x4 yd = (f32x4){0.f, 0.f, 0.f, 0.f};
#pragma unroll
            for (int kb = 0; kb < 4; ++kb) { const bf16x8 xf = *(const LAS bf16x8*)(xb + ci * XB_STRIDE + 32 * kb + 8 * q); yd = __builtin_amdgcn_mfma_f32_16x16x32_bf16(cf[kb], xf, yd, 0, 0, 0); }
            const float y0 = gelu_tanh(yd[0] + dv4[0] * pg8::bf_lo(uu.x)), y1 = gelu_tanh(yd[1] + dv4[1] * pg8::bf_hi(uu.x));
            const float y2 = gelu_tanh(yd[2] + dv4[2] * pg8::bf_lo(uu.y)), y3 = gelu_tanh(yd[3] + dv4[3] * pg8::bf_hi(uu.y));
            v2u w; w.x = pk2(y0, y1); w.y = pk2(y2, y3);
            *(v2u*)(YG + (size_t)t * SW + g * HC + 4 * q) = w;
            LDS_WAIT();
        }
    }
}

struct Args { In in; float* out; unsigned char* ws; int ph_lo, ph_hi; };
constexpr int N_PHASES = 1 + 12 * DEPTH;
__global__ void __launch_bounds__(NWAVES * 64, 2) mega_fwd(Args args) {
    extern __shared__ __attribute__((aligned(16))) unsigned char lds[];
    cg::grid_group grid = cg::this_grid();
    Frame F;
    F.lds = (LAS unsigned char*)lds;
    F.tid = threadIdx.x; F.lane = F.tid & 63; F.wave = __builtin_amdgcn_readfirstlane(F.tid >> 6);
    F.G = gridDim.x; { const int bx = blockIdx.x; F.vcu = (F.G % 8 == 0) ? (bx % 8) * (F.G / 8) + bx / 8 : bx; }
    const int lo = args.ph_lo, hi = args.ph_hi;
    int ph = 0;
#define PH_ON (ph >= lo && ph < hi)
#define PH_END do { if (ph >= lo && ph + 1 < hi) grid.sync(); ++ph; } while (0)
#define PH_LOCALS unsigned char* ws = args.ws; float* xout = args.out; int li = li_, f = f_; asm volatile("" : "+s"(ws), "+s"(xout), "+s"(li), "+s"(f)); \
    const float* md = (const float*)(ws + WS_CTL) + li * (NCOND * DM); const float* ng = inp(5) + (size_t)li * 3 * DM; const int sub = f == 0 ? 0 : 2; \
    const float* xcur = (li == 0 && f == 0) ? inp(0) : (const float*)xout; (void)md; (void)ng; (void)sub; (void)xcur;

    if (PH_ON) p0_prologue(F, args.ws);
    PH_END;

    for (int li_ = 0; li_ < DEPTH; ++li_) {
        for (int f_ = 0; f_ < 2; ++f_) {
            if (PH_ON) { PH_LOCALS; norm_phase(F, xcur, ng + sub * DM, md + (3 * sub) * DM, md + (3 * sub + 1) * DM, (bf16*)(ws + WS_H)); }
            PH_END;
            if (PH_ON) { PH_LOCALS; pg8::Gemm g{(const bf16*)(ws + WS_H), (const bf16*)(ws + WS_WGU) + (size_t)(li * 2 + f) * 2 * DFF * DM, SEQ, 2 * DFF, DM}; pg8::StaticOrder S; S.init(SEQ, 2 * DFF, F.G, (int)blockIdx.x);
                pg8::EpiSwiGlu E{(bf16*)(ws + WS_ACT), DFF};
                pg8::gemm_phase<pg8::EpiSwiGlu, pg8::StaticOrder, true, true>(F.lds, g, S, E); }
            PH_END;
            if (PH_ON) { PH_LOCALS; pg8::Gemm g{(const bf16*)(ws + WS_ACT), (const bf16*)(ws + WS_WD) + (size_t)(li * 2 + f) * DM * DFF, SEQ, DM, DFF}; pg8::StaticOrder S; S.init(SEQ, DM, F.G, (int)blockIdx.x);
                pg8::EpiResGate E{xcur, xout, md + (3 * sub + 2) * DM, 0.5f, DM};
                pg8::gemm_phase<pg8::EpiResGate, pg8::StaticOrder, true, true>(F.lds, g, S, E); }
            PH_END;
            if (f_ == 1) break;
            if (PH_ON) { PH_LOCALS; norm_phase(F, xout, ng + 1 * DM, md + 3 * DM, md + 4 * DM, (bf16*)(ws + WS_H)); }
            PH_END;
            if (PH_ON) { PH_LOCALS; pg8::Gemm g{(const bf16*)(ws + WS_H), (const bf16*)(ws + WS_WIN) + (size_t)li * INW * DM, SEQ, INW, DM}; pg8::StaticOrder S; S.init(SEQ, INW, F.G, (int)blockIdx.x);
                pg8::EpiWin E{(bf16*)(ws + WS_Q), (bf16*)(ws + WS_K), (bf16*)(ws + WS_V), (bf16*)(ws + WS_U), inp(14) + li * 64, inp(15) + li * 64, attn_body::C2};
                pg8::gemm_phase<pg8::EpiWin, pg8::StaticOrder, true, true>(F.lds, g, S, E); }
            PH_END;
#define SSM_PARAMS SsmP P{inp(21) + (size_t)li * NG * NP, inp(22) + (size_t)li * NG * NP, inp(23) + li * NG, inp(24) + (size_t)li * NG * NP * HC, inp(25) + (size_t)li * NG * NP * HC, \
                   inp(26) + (size_t)li * NG * HC * NP, inp(27) + (size_t)li * NG * HC * NP, inp(28) + li * NG * HC}
            if (PH_ON) { PH_LOCALS;
#ifndef NO_ATTN
                { const attn_body::AttnTensors AT{(const attn_body::bf16*)(ws + WS_Q), (const attn_body::bf16*)(ws + WS_K), (const attn_body::bf16*)(ws + WS_V), (attn_body::bf16*)(ws + WS_OP), (const float*)(ws + WS_BIASD)};
                  attn_body::attn_phase<8>((char*)lds, AT, F.vcu); }
#endif
#ifndef NO_SSM
                { SSM_PARAMS; ssm_pass1(F, P, (const bf16*)(ws + WS_U), (float*)(ws + WS_XEND)); }
#endif
                }
            PH_END;
            if (PH_ON) { PH_LOCALS; combine_phase(F, (const bf16*)(ws + WS_OP), (bf16*)(ws + WS_CAT), inp(16) + li * 64, inp(17) + li * 64, inp(18) + li * 64, inp(19) + li * 64, inp(20) + li * 128, li == 0 ? 0.2f : 0.35550906759096924f);
#ifndef NO_SSM
                { SSM_PARAMS; ssm_pass2(F, P, (const bf16*)(ws + WS_U), (const float*)(ws + WS_XEND), (bf16*)(ws + WS_YG)); }
#endif
                }
            PH_END;
            if (PH_ON) { PH_LOCALS; pg8::Gemm g{(const bf16*)(ws + WS_YG), (const bf16*)(ws + WS_WGLU) + (size_t)li * SW * SW, SEQ, SW, SW}; pg8::StaticOrder S; S.init(SEQ, SW, F.G, (int)blockIdx.x);
                pg8::EpiGlu E{(const bf16*)(ws + WS_YG), (bf16*)(ws + WS_CAT), inp(30) + li * SW};
                pg8::gemm_phase<pg8::EpiGlu, pg8::StaticOrder, true, true>(F.lds, g, S, E); }
            PH_END;
            if (PH_ON) { PH_LOCALS; pg8::Gemm g{(const bf16*)(ws + WS_CAT), (const bf16*)(ws + WS_WOUT) + (size_t)li * DM * DM, SEQ, DM, DM}; pg8::StaticOrder S; S.init(SEQ, DM, F.G, (int)blockIdx.x);
                pg8::EpiResGate E{xout, xout, md + 5 * DM, 1.0f, DM};
                pg8::gemm_phase<pg8::EpiResGate, pg8::StaticOrder, true, true>(F.lds, g, S, E); }
            PH_END;
        }
    }
#undef PH_ON
#undef PH_END
#undef PH_LOCALS
#undef SSM_PARAMS
}

extern "C" void kernel_launch(void* const* d_in, const int* in_sizes, int n_in, void* d_out, int out_size, void* d_ws, size_t ws_size, hipStream_t stream) {
    static int grid = 0;
    if (grid == 0) {
        if (n_in != 31 || in_sizes[0] != SEQ * DM || out_size != SEQ * DM || ws_size < WS_END) { fprintf(stderr, "kernel_launch: unexpected shapes (n_in %d, in0 %d, out %d, ws %zu < %zu?); nothing launched\n", n_in, n_in > 0 ? in_sizes[0] : -1, out_size, ws_size, (size_t)WS_END); grid = -1; return; }
        int dev = 0, cus = 0, per_cu = 0;
        if (hipGetDevice(&dev) != hipSuccess || hipDeviceGetAttribute(&cus, hipDeviceAttributeMultiprocessorCount, dev) != hipSuccess) { fprintf(stderr, "kernel_launch: device query failed\n"); grid = -1; return; }
        if (hipFuncSetAttribute((const void*)mega_fwd, hipFuncAttributeMaxDynamicSharedMemorySize, LDS_BYTES) != hipSuccess) { fprintf(stderr, "kernel_launch: hipFuncSetAttribute failed\n"); grid = -1; return; }
        if (hipOccupancyMaxActiveBlocksPerMultiprocessor(&per_cu, (const void*)mega_fwd, NWAVES * 64, LDS_BYTES) != hipSuccess || per_cu < 1) { fprintf(stderr, "kernel_launch: occupancy query says %d\n", per_cu); per_cu = 1; }
        (void)hipGetLastError();
        grid = cus;
        if (grid != 256) { fprintf(stderr, "kernel_launch: built for a 256-CU device, got %d\n", grid); grid = -1; return; }
    }
    if (grid < 0) return;
    if (hipMemsetAsync((char*)d_ws + WS_CTL, 0, CTL_ZERO_BYTES, stream) != hipSuccess) { fprintf(stderr, "kernel_launch: memset failed\n"); return; }
    Args a{};
    for (int i = 0; i < 31; ++i) a.in.p[i] = (const float*)d_in[i];
    a.out = (float*)d_out; a.ws = (unsigned char*)d_ws;
#if MK_ONE_LAUNCH
    a.ph_lo = 0; a.ph_hi = N_PHASES;
    void* kargs[] = {&a};
    hipError_t e = hipLaunchCooperativeKernel((const void*)mega_fwd, dim3(grid), dim3(NWAVES * 64), kargs, LDS_BYTES, stream);
    if (e != hipSuccess) fprintf(stderr, "kernel_launch: cooperative launch failed: %s\n", hipGetErrorString(e));
#else
    for (int ph = 0; ph < N_PHASES; ++ph) { a.ph_lo = ph; a.ph_hi = ph + 1;
        hipLaunchKernelGGL(mega_fwd, dim3(grid), dim3(NWAVES * 64), LDS_BYTES, stream, a);
        const hipError_t le = hipPeekAtLastError();
        if (le != hipSuccess) { fprintf(stderr, "kernel_launch: launch %d failed: %s\n", ph, hipGetErrorName(le)); break; } }
#endif
}
```

```cpp
#include <hip/hip_runtime.h>
#include <hip/hip_cooperative_groups.h>
#include <cstdio>
#include <cstdint>
namespace cg = cooperative_groups;
#ifndef MK_ONE_LAUNCH
#define MK_ONE_LAUNCH 1
#endif
namespace pg8 {
#define PG8_LAS __attribute__((address_space(3)))
typedef unsigned short bf16_t;
typedef short bf16x8 __attribute__((ext_vector_type(8)));
typedef float f32x4 __attribute__((ext_vector_type(4)));
typedef unsigned u32x4 __attribute__((ext_vector_type(4)));
constexpr int BM = 256, BK = 64, HALF = 128, HTB = HALF * BK * 2  , STAGE_BYTES = 8 * HTB, NXCD = 8, WGM = 8;

__host__ __device__ __forceinline__ int lds_byte(int r, int c) { const int st = (r >> 4) * 2 + (c >> 5), rr = r & 15, cc = c & 31, ob = rr * 64 + cc * 2; return st * 1024 + (ob ^ (((ob >> 9) & 1) << 5)); }
__host__ __device__ __forceinline__ void stage_rc(int b, int& R, int& C) { const int st = b / 1024, sb = b % 1024, swz = sb ^ (((sb >> 9) & 1) << 5); R = (st >> 1) * 16 + swz / 64; C = (st & 1) * 32 + (swz % 64) / 2; }
__host__ __device__ __forceinline__ int perm32(int rho) { const int n = rho >> 4, i = rho & 15; return 8 * (i >> 2) + 4 * n + (i & 3); }

struct Unit { int pm, pn; };
struct Gemm { const bf16_t* A; const bf16_t* Bt; int M, N, K; };

struct StaticOrder {
    int nM, nN, nwg, G, c;
    __host__ __device__ void init(int M, int N, int G_, int c_) { nM = M / BM; nN = N / BM; nwg = nM * nN; G = G_; c = c_; }
    __host__ __device__ bool next(int i, Unit& u) const {
        const long L = (long)i * G + c; if (L >= nwg) return false;
        int wgid = (int)L; { const int q = nwg / NXCD, r = nwg % NXCD, xcd = wgid % NXCD, off = wgid / NXCD; wgid = (xcd < r ? xcd * (q + 1) : r * (q + 1) + (xcd - r) * q) + off; }
        const int nig = WGM * nN, gid = wgid / nig, fm = gid * WGM, gsz = (nM - fm) < WGM ? (nM - fm) : WGM;
        u.pm = fm + ((wgid % nig) % gsz); u.pn = (wgid % nig) / gsz; return true;
    }
    __device__ __forceinline__ void a_ready(const Unit&) const {}
    __device__ __forceinline__ void done(const Unit&) const {}
};

__device__ __forceinline__ unsigned cvt_pk_bf16(float lo, float hi) { unsigned r; asm volatile("v_cvt_pk_bf16_f32 %0, %1, %2" : "=v"(r) : "v"(lo), "v"(hi)); return r; }
typedef float f32x2 __attribute__((ext_vector_type(2)));
__device__ __forceinline__ float sigmoid_f(float v) { return __builtin_amdgcn_rcpf(1.0f + __builtin_amdgcn_exp2f(-1.4426950408889634f * v)); }
struct EpiSwiGlu {
    static constexpr bool PERM = true, AFTER_DRAIN = false;
    bf16_t* O; int ldc;
    __device__ __forceinline__ void operator()(const f32x4 (&acc)[2][2][4][2], const Unit& u, int wr, int wc, int fr, int fq) const {
        const int row0 = u.pm * BM + wr * 64 + fr, col0 = u.pn * HALF + wc * 32 + 8 * fq;
#pragma unroll
        for (int ai = 0; ai < 2; ++ai)
#pragma unroll
            for (int m = 0; m < 4; ++m) { bf16_t* rowp = O + (size_t)(row0 + ai * HALF + m * 16) * ldc + col0;
                const f32x4 g0 = acc[ai][0][m][0], g1 = acc[ai][0][m][1], u0 = acc[ai][1][m][0], u1 = acc[ai][1][m][1];
                float v[8];
#pragma unroll
                for (int i = 0; i < 4; ++i) { v[i] = g0[i] * sigmoid_f(g0[i]) * u0[i]; v[4 + i] = g1[i] * sigmoid_f(g1[i]) * u1[i]; }
                u32x4 w; w.x = cvt_pk_bf16(v[0], v[1]); w.y = cvt_pk_bf16(v[2], v[3]); w.z = cvt_pk_bf16(v[4], v[5]); w.w = cvt_pk_bf16(v[6], v[7]);
                *(u32x4*)rowp = w; }
    }
};
struct EpiResGate {
    static constexpr bool PERM = false, AFTER_DRAIN = false;
    const float* xin; float* xout; const float* gate; float coef; int ldc;
    __device__ __forceinline__ void operator()(const f32x4 (&acc)[2][2][4][2], const Unit& u, int wr, int wc, int fr, int fq) const {
        const int row0 = u.pm * BM + wr * 64 + fr, col0 = u.pn * BM + wc * 32 + 4 * fq;
        f32x4 gv[2][2];
#pragma unroll
        for (int bj = 0; bj < 2; ++bj)
#pragma unroll
            for (int n = 0; n < 2; ++n) gv[bj][n] = *(const f32x4*)(gate + col0 + bj * HALF + n * 16) * coef;
#pragma unroll
        for (int ai = 0; ai < 2; ++ai)
#pragma unroll
            for (int m = 0; m < 4; ++m) { const size_t off = (size_t)(row0 + ai * HALF + m * 16) * ldc + col0;
#pragma unroll
                for (int bj = 0; bj < 2; ++bj)
#pragma unroll
                    for (int n = 0; n < 2; ++n) { const f32x4 xi = *(const f32x4*)(xin + off + bj * HALF + n * 16);
                        *(f32x4*)(xout + off + bj * HALF + n * 16) = xi + gv[bj][n] * acc[ai][bj][m][n]; }
                if (m & 1) asm volatile("" ::: "memory"); }
    }
};
struct EpiWin {
    static constexpr bool PERM = true, AFTER_DRAIN = false;
    bf16_t *Q, *K, *V, *U; const float *qg, *kg; float qscale;
    __device__ __forceinline__ void operator()(const f32x4 (&acc)[2][2][4][2], const Unit& u, int wr, int wc, int fr, int fq) const {
        const int sec = u.pn >> 2, tile = u.pn & 3; const int row0 = u.pm * BM + wr * 64 + fr;
        if (sec < 2) {
            const float* gn = sec == 0 ? qg : kg; const float sc = sec == 0 ? qscale : 1.0f;
            bf16_t* base = sec == 0 ? Q : K;
            f32x4 gv[2][2];
#pragma unroll
            for (int bj = 0; bj < 2; ++bj)
#pragma unroll
                for (int n = 0; n < 2; ++n) gv[bj][n] = *(const f32x4*)(gn + 32 * bj + 8 * fq + 4 * n) * sc;
            const int col0 = tile * 256 + wc * 64 + 8 * fq;
#pragma unroll
            for (int ai = 0; ai < 2; ++ai)
#pragma unroll
                for (int m = 0; m < 4; ++m) {
                    float ss = 0.f;
#pragma unroll
                    for (int bj = 0; bj < 2; ++bj)
#pragma unroll
                        for (int n = 0; n < 2; ++n) { const f32x4 x = acc[ai][bj][m][n]; ss += (x[0] * x[0] + x[1] * x[1]) + (x[2] * x[2] + x[3] * x[3]); }
                    ss += __shfl_xor(ss, 16); ss += __shfl_xor(ss, 32);
                    const float r = __builtin_amdgcn_rsqf(ss * (1.0f / 64.0f) + 1e-6f);
                    bf16_t* rowp = base + (size_t)(row0 + ai * HALF + m * 16) * 1024 + col0;
#pragma unroll
                    for (int bj = 0; bj < 2; ++bj) { const f32x4 v0 = acc[ai][bj][m][0] * gv[bj][0] * r, v1 = acc[ai][bj][m][1] * gv[bj][1] * r;
                        u32x4 w; w.x = cvt_pk_bf16(v0[0], v0[1]); w.y = cvt_pk_bf16(v0[2], v0[3]); w.z = cvt_pk_bf16(v1[0], v1[1]); w.w = cvt_pk_bf16(v1[2], v1[3]);
                        *(u32x4*)(rowp + 32 * bj) = w; }
                }
        } else {
            bf16_t* base = sec == 2 ? V : U; const int col0 = tile * 256 + wc * 32 + 8 * fq;
#pragma unroll
            for (int ai = 0; ai < 2; ++ai)
#pragma unroll
                for (int m = 0; m < 4; ++m) { bf16_t* rowp = base + (size_t)(row0 + ai * HALF + m * 16) * 1024 + col0;
#pragma unroll
                    for (int bj = 0; bj < 2; ++bj) { const f32x4 v0 = acc[ai][bj][m][0], v1 = acc[ai][bj][m][1];
                        u32x4 w; w.x = cvt_pk_bf16(v0[0], v0[1]); w.y = cvt_pk_bf16(v0[2], v0[3]); w.z = cvt_pk_bf16(v1[0], v1[1]); w.w = cvt_pk_bf16(v1[2], v1[3]);
                        *(u32x4*)(rowp + HALF * bj) = w; } }
        }
    }
};
__device__ __forceinline__ float bf_lo(unsigned w) { return __uint_as_float(w << 16); }
__device__ __forceinline__ float bf_hi(unsigned w) { return __uint_as_float(w & 0xffff0000u); }
struct EpiGlu {
    static constexpr bool PERM = true, AFTER_DRAIN = false;
    const bf16_t* YG; bf16_t* CAT; const float* bias;
    __device__ __forceinline__ void operator()(const f32x4 (&acc)[2][2][4][2], const Unit& u, int wr, int wc, int fr, int fq) const {
        const int row0 = u.pm * BM + wr * 64 + fr, col0 = u.pn * BM + wc * 32 + 8 * fq;
        f32x4 bv[2][2];
#pragma unroll
        for (int bj = 0; bj < 2; ++bj)
#pragma unroll
            for (int n = 0; n < 2; ++n) bv[bj][n] = *(const f32x4*)(bias + col0 + bj * HALF + 4 * n);
#pragma unroll
        for (int ai = 0; ai < 2; ++ai)
#pragma unroll
            for (int m = 0; m < 4; ++m) { const size_t row = (size_t)(row0 + ai * HALF + m * 16);
#pragma unroll
                for (int bj = 0; bj < 2; ++bj) { const f32x4 z0 = acc[ai][bj][m][0] + bv[bj][0], z1 = acc[ai][bj][m][1] + bv[bj][1];
                    const u32x4 y = *(const u32x4*)(YG + row * 1024 + col0 + bj * HALF);
                    u32x4 w;
                    w.x = cvt_pk_bf16(bf_lo(y.x) * sigmoid_f(z0[0]), bf_hi(y.x) * sigmoid_f(z0[1])); w.y = cvt_pk_bf16(bf_lo(y.y) * sigmoid_f(z0[2]), bf_hi(y.y) * sigmoid_f(z0[3]));
                    w.z = cvt_pk_bf16(bf_lo(y.z) * sigmoid_f(z1[0]), bf_hi(y.z) * sigmoid_f(z1[1])); w.w = cvt_pk_bf16(bf_lo(y.w) * sigmoid_f(z1[2]), bf_hi(y.w) * sigmoid_f(z1[3]));
                    *(u32x4*)(CAT + row * 2048 + 1024 + col0 + bj * HALF) = w; } }
    }
};

template <class Epi, class Sched, bool ALIGN_EPI = false, bool SP2 = false>
__device__ __forceinline__ void gemm_phase(PG8_LAS unsigned char* lds, const Gemm g, const Sched& S, const Epi& E) {
    int tid_ = threadIdx.x; asm volatile("" : "+v"(tid_));
    const int tid = tid_, wid = __builtin_amdgcn_readfirstlane(tid >> 6), lane = tid & 63, wr = wid >> 2, wc = wid & 3, fr = lane & 15, fq = lane >> 4;
    const int K = g.K, nt = K / BK;
    unsigned voffA[2], voffB[2];
#pragma unroll
    for (int i = 0; i < 2; ++i) { int R, C; stage_rc(tid * 16 + i * 8192, R, C); const int Rb = Epi::PERM ? ((R & ~31) + perm32(R & 31)) : R;
        voffA[i] = (unsigned)(R * K + C) * 2u; voffB[i] = (unsigned)(Rb * K + C) * 2u; }
    const size_t kstep = (size_t)(BK * 2);
    const size_t hstep = (size_t)HALF * K * 2;
    const size_t tstep = 2 * hstep;
    const unsigned ldsw = (unsigned)wid * 1024u;
    const int aoff = lds_byte(wr * 64 + fr, fq * 8), boff = lds_byte(wc * 32 + fr, fq * 8);
#define PG8_SA(b, h) (((b) * 2 + (h)) * HTB)
#define PG8_SB(b, h) ((4 + (b) * 2 + (h)) * HTB)
#define PG8_STAGE(bufoff, gbase, voff) do { _Pragma("unroll") for (int _i = 0; _i < 2; ++_i) \
        __builtin_amdgcn_global_load_lds((const unsigned*)((const char*)(gbase) + (voff)[_i]), (PG8_LAS unsigned*)(lds + (bufoff) + ldsw + _i * 8192), 16, 0, 0); } while (0)
#define PG8_LDA(dst, b, h) do { _Pragma("unroll") for (int m = 0; m < 4; ++m) _Pragma("unroll") for (int k = 0; k < 2; ++k) dst[m][k] = *(const PG8_LAS bf16x8*)(lds + PG8_SA(b, h) + aoff + m * 2048 + k * 1024); } while (0)
#define PG8_LDB(dst, b, h) do { _Pragma("unroll") for (int n = 0; n < 2; ++n) _Pragma("unroll") for (int k = 0; k < 2; ++k) dst[n][k] = *(const PG8_LAS bf16x8*)(lds + PG8_SB(b, h) + boff + n * 2048 + k * 1024); } while (0)
#define PG8_MMA(ai, bj, At, Bt) do { __builtin_amdgcn_s_setprio(1); _Pragma("unroll") for (int m = 0; m < 4; ++m) _Pragma("unroll") for (int n = 0; n < 2; ++n) _Pragma("unroll") for (int k = 0; k < 2; ++k) \
        acc[ai][bj][m][n] = __builtin_amdgcn_mfma_f32_16x16x32_bf16(Bt[n][k], At[m][k], acc[ai][bj][m][n], 0, 0, 0); __builtin_amdgcn_s_setprio(0); } while (0)
#define PG8_WAIT_V(n) asm volatile("s_waitcnt vmcnt(" #n ")" ::: "memory")
#define PG8_WAIT_L(n) asm volatile("s_waitcnt lgkmcnt(" #n ")" ::: "memory")
#define PG8_BAR __builtin_amdgcn_s_barrier()
#define PG8_SCHED __builtin_amdgcn_sched_barrier(0)
    Unit cur, nxt; int ui = 0;
    if (!S.next(0, cur)) return;
    f32x4 acc[2][2][4][2];
#pragma unroll
    for (int a = 0; a < 2; ++a)
#pragma unroll
        for (int b = 0; b < 2; ++b)
#pragma unroll
            for (int m = 0; m < 4; ++m)
#pragma unroll
                for (int n = 0; n < 2; ++n) acc[a][b][m][n] = (f32x4){0.f, 0.f, 0.f, 0.f};
    bf16x8 At[4][2], B0[2][2], B1[2][2];
    const char* cA = (const char*)g.A + (size_t)cur.pm * tstep; const char* cB = (const char*)g.Bt + (size_t)cur.pn * tstep;
    S.a_ready(cur);
    if constexpr (SP2) {
        PG8_STAGE(PG8_SB(0, 0), cB, voffB); PG8_STAGE(PG8_SB(0, 1), cB + hstep, voffB); PG8_STAGE(PG8_SA(0, 0), cA, voffA); PG8_STAGE(PG8_SA(0, 1), cA + hstep, voffA);
        if (wr == 1) PG8_BAR;
        PG8_WAIT_V(2); PG8_BAR;
        PG8_STAGE(PG8_SB(1, 0), cB + kstep, voffB); PG8_STAGE(PG8_SA(1, 0), cA + kstep, voffA); PG8_STAGE(PG8_SB(1, 1), cB + hstep + kstep, voffB);
        PG8_WAIT_V(6); PG8_BAR;
    } else {
        PG8_STAGE(PG8_SB(0, 0), cB, voffB); PG8_STAGE(PG8_SA(0, 0), cA, voffA); PG8_STAGE(PG8_SB(0, 1), cB + hstep, voffB); PG8_STAGE(PG8_SA(0, 1), cA + hstep, voffA);
        if (wr == 1) PG8_BAR;
        PG8_WAIT_V(4); PG8_BAR;
        PG8_STAGE(PG8_SB(1, 0), cB + kstep, voffB); PG8_STAGE(PG8_SA(1, 0), cA + kstep, voffA); PG8_STAGE(PG8_SB(1, 1), cB + hstep + kstep, voffB);
        PG8_WAIT_V(6); PG8_BAR;
    }
    for (;;) {
        const bool has_next = S.next(ui + 1, nxt);
        const char* nA = has_next ? (const char*)g.A + (size_t)nxt.pm * tstep : cA; const char* nB = has_next ? (const char*)g.Bt + (size_t)nxt.pn * tstep : cB;
        for (int t = 0; t < nt; t += 2) {
            const bool last = (t == nt - 2);
            const char* a1 = cA + (size_t)(t + 1) * kstep;
            const char* a2 = last ? nA : cA + (size_t)(t + 2) * kstep; const char* b2 = last ? nB : cB + (size_t)(t + 2) * kstep;
            const char* a3 = a2 + kstep; const char* b3 = b2 + kstep;
            if (last && has_next) S.a_ready(nxt);
            if constexpr (SP2) {
            PG8_LDB(B0, 0, 0); PG8_LDB(B1, 0, 1); PG8_SCHED; PG8_LDA(At, 0, 0); PG8_STAGE(PG8_SA(1, 1), a1 + hstep, voffA);
            PG8_WAIT_V(8); PG8_WAIT_L(0); PG8_BAR; PG8_MMA(0, 0, At, B0); PG8_MMA(0, 1, At, B1); PG8_BAR; PG8_SCHED;
            PG8_LDA(At, 0, 1); PG8_STAGE(PG8_SB(0, 0), b2, voffB); PG8_STAGE(PG8_SB(0, 1), b2 + hstep, voffB); PG8_STAGE(PG8_SA(0, 0), a2, voffA);
            PG8_WAIT_V(8); PG8_WAIT_L(0); PG8_BAR; PG8_MMA(1, 0, At, B0); PG8_MMA(1, 1, At, B1); PG8_BAR; PG8_SCHED;
            PG8_LDB(B0, 1, 0); PG8_LDB(B1, 1, 1); PG8_SCHED; PG8_LDA(At, 1, 0); PG8_STAGE(PG8_SA(0, 1), a2 + hstep, voffA);
            PG8_WAIT_V(8); PG8_WAIT_L(0); PG8_BAR; PG8_MMA(0, 0, At, B0); PG8_MMA(0, 1, At, B1); PG8_BAR; PG8_SCHED;
            PG8_LDA(At, 1, 1); PG8_STAGE(PG8_SB(1, 0), b3, voffB); PG8_STAGE(PG8_SB(1, 1), b3 + hstep, voffB); PG8_STAGE(PG8_SA(1, 0), a3, voffA);
            PG8_WAIT_V(8); PG8_WAIT_L(0); PG8_BAR; PG8_MMA(1, 0, At, B0); PG8_MMA(1, 1, At, B1); PG8_BAR; PG8_SCHED;
            } else {
            PG8_LDB(B0, 0, 0); PG8_SCHED; PG8_LDA(At, 0, 0); PG8_STAGE(PG8_SA(1, 1), a1 + hstep, voffA);
            PG8_WAIT_L(8); PG8_BAR; PG8_WAIT_L(0); PG8_MMA(0, 0, At, B0); PG8_BAR; PG8_SCHED;
            PG8_LDB(B1, 0, 1); PG8_STAGE(PG8_SB(0, 0), b2, voffB);
            PG8_BAR; PG8_WAIT_L(0); PG8_MMA(0, 1, At, B1); PG8_BAR;
            PG8_LDA(At, 0, 1); PG8_STAGE(PG8_SA(0, 0), a2, voffA);
            PG8_BAR; PG8_WAIT_L(0); PG8_MMA(1, 0, At, B0); PG8_BAR; PG8_SCHED;
            PG8_STAGE(PG8_SB(0, 1), b2 + hstep, voffB);
            PG8_WAIT_V(6); PG8_BAR; PG8_MMA(1, 1, At, B1); PG8_BAR;
            PG8_LDB(B0, 1, 0); PG8_SCHED; PG8_LDA(At, 1, 0); PG8_STAGE(PG8_SA(0, 1), a2 + hstep, voffA);
            PG8_WAIT_L(8); PG8_BAR; PG8_WAIT_L(0); PG8_MMA(0, 0, At, B0); PG8_BAR; PG8_SCHED;
            PG8_LDB(B1, 1, 1); PG8_STAGE(PG8_SB(1, 0), b3, voffB);
            PG8_BAR; PG8_WAIT_L(0); PG8_MMA(0, 1, At, B1); PG8_BAR;
            PG8_LDA(At, 1, 1); PG8_STAGE(PG8_SA(1, 0), a3, voffA);
            PG8_BAR; PG8_WAIT_L(0); PG8_MMA(1, 0, At, B0); PG8_BAR; PG8_SCHED;
            PG8_STAGE(PG8_SB(1, 1), b3 + hstep, voffB);
            PG8_WAIT_V(6); PG8_BAR; PG8_MMA(1, 1, At, B1); PG8_BAR;
            }
        }
        if constexpr (ALIGN_EPI) { if (wr == 0) PG8_BAR; }
        if constexpr (!Epi::AFTER_DRAIN) { E(acc, cur, wr, wc, fr, fq); S.done(cur); }
        if (!has_next) break;
#pragma unroll
        for (int a = 0; a < 2; ++a)
#pragma unroll
            for (int b = 0; b < 2; ++b)
#pragma unroll
                for (int m = 0; m < 4; ++m)
#pragma unroll
                    for (int n = 0; n < 2; ++n) acc[a][b][m][n] = (f32x4){0.f, 0.f, 0.f, 0.f};
        cur = nxt; cA = nA; cB = nB; ++ui;
        if constexpr (ALIGN_EPI) { if (wr == 1) PG8_BAR; }
    }
    PG8_WAIT_V(0);
    if constexpr (!ALIGN_EPI) { if (wr == 0) PG8_BAR; }
    PG8_BAR;
    if constexpr (Epi::AFTER_DRAIN) { E.fused(acc, cur, wr, wc, fr, fq, lds, wid, lane); S.done(cur); }
#undef PG8_SA
#undef PG8_SB
#undef PG8_STAGE
#undef PG8_LDA
#undef PG8_LDB
#undef PG8_MMA
#undef PG8_WAIT_V
#undef PG8_WAIT_L
#undef PG8_BAR
#undef PG8_SCHED
}
}
#include <hip/hip_bf16.h>
#include <cmath>
namespace attn_body {
using bf16=__hip_bfloat16;
using bf16x8=__attribute__((ext_vector_type(8)))short;
using s16x4=__attribute__((ext_vector_type(4)))short;
using f32x16=__attribute__((ext_vector_type(16)))float;
using u32x4=__attribute__((ext_vector_type(4)))unsigned;
constexpr int SEQ=8192,D=64,DM=1024,OPITCH=2048;
constexpr int NW=8,QBLK=32,QB=QBLK*NW,KVBLK=64,NQB=SEQ/QB;
constexpr int ATTN_PITCH=DM, ATTN_UNIT_ROWS=QB;
__device__ __forceinline__ int crow(int r,int hi){return (r&3)+8*(r>>2)+4*hi;}
#define SBAR() __builtin_amdgcn_sched_barrier(0)
typedef const __attribute__((address_space(3))) float* lds_cfptr;
__device__ __forceinline__ void cmask(f32x16&p0,f32x16&p1,int jb,int qrel,int hi,lds_cfptr bt){
  const float NEG=-INFINITY; int kb=64*jb+4*hi;
  #pragma unroll
  for(int r=0;r<16;++r){int kv=kb+(r&3)+8*(r>>2); int d0=qrel-kv, d1=d0-32;
    unsigned i0=(unsigned)d0<127u?(unsigned)d0:127u, i1=(unsigned)d1<127u?(unsigned)d1:127u;
    float b0=bt[i0], b1=bt[i1];
    p0[r]=(d0<0)?NEG:p0[r]+b0; p1[r]=(d1<0)?NEG:p1[r]+b1;}
}

constexpr int NSLOT=3, SLOTB=8192;
constexpr int LDS_K=0, LDS_V=NSLOT*SLOTB, LDS_WS=2*NSLOT*SLOTB, LDS_OST=LDS_WS+NW*64*4, LDS_BT=LDS_OST+NW*4096, LDS_BYTES=LDS_BT+512;
constexpr float C2=0.125f*1.4426950408889634f;
__device__ __forceinline__ void glds16(const void*gsrc,unsigned lds_dst){unsigned keep;
  asm volatile("s_mov_b32 %0, m0\n\ts_mov_b32 m0, %2\n\ts_nop 0\n\tglobal_load_lds_dwordx4 %1, off\n\ts_mov_b32 m0, %0":"=&s"(keep):"v"(gsrc),"s"(lds_dst):"memory");}
__device__ __forceinline__ float max3f(float a,float b,float c){float r;asm("v_max3_f32 %0, %1, %2, %3":"=v"(r):"v"(a),"v"(b),"v"(c));return r;}
__device__ __forceinline__ float max2f(float a,float b){float r;asm("v_max_f32_e32 %0, %1, %2":"=v"(r):"v"(a),"v"(b));return r;}
__device__ __forceinline__ float fadd_s(float a,float b){float r;asm("v_add_f32_e32 %0, %1, %2":"=v"(r):"v"(a),"v"(b));return r;}
__device__ __forceinline__ float fsub_s(float a,float b){float r;asm("v_sub_f32_e32 %0, %1, %2":"=v"(r):"v"(a),"v"(b));return r;}
typedef float f32x2_t __attribute__((ext_vector_type(2))); typedef __bf16 bf16x2_t __attribute__((ext_vector_type(2)));
__device__ __forceinline__ unsigned cvtpk_s(float lo,float hi){f32x2_t v={lo,hi};bf16x2_t b=__builtin_convertvector(v,bf16x2_t);return __builtin_bit_cast(unsigned,b);}
#define WAIT_BAR(N) asm volatile("s_waitcnt vmcnt(" #N ") lgkmcnt(0)\n\ts_barrier":::"memory")

__device__ __forceinline__ void qkt(f32x16&p0,f32x16&p1,const char*Kslot,const bf16x8*qr,const f32x16&negm,int r32,int hi){
  const char*kb=Kslot+hi*1024+r32*16;
  #pragma unroll
  for(int d0=0;d0<4;++d0){
    const bf16x8 b0=*reinterpret_cast<const bf16x8*>(kb+d0*2048);
    const bf16x8 b1=*reinterpret_cast<const bf16x8*>(kb+d0*2048+512);
    if(d0==0){p0=__builtin_amdgcn_mfma_f32_32x32x16_bf16(b0,qr[0],negm,0,0,0);p1=__builtin_amdgcn_mfma_f32_32x32x16_bf16(b1,qr[0],negm,0,0,0);}
    else{p0=__builtin_amdgcn_mfma_f32_32x32x16_bf16(b0,qr[d0],p0,0,0,0);p1=__builtin_amdgcn_mfma_f32_32x32x16_bf16(b1,qr[d0],p1,0,0,0);}}
}
typedef __attribute__((address_space(3))) const char* lds_cptr;
typedef short v4i16_t __attribute__((ext_vector_type(4)));
__device__ __forceinline__ void kload8(bf16x8*kf,lds_cptr kp){
  kf[0]=*(const __attribute__((address_space(3))) bf16x8*)(kp);      kf[1]=*(const __attribute__((address_space(3))) bf16x8*)(kp+512);
  kf[2]=*(const __attribute__((address_space(3))) bf16x8*)(kp+2048); kf[3]=*(const __attribute__((address_space(3))) bf16x8*)(kp+2560);
  kf[4]=*(const __attribute__((address_space(3))) bf16x8*)(kp+4096); kf[5]=*(const __attribute__((address_space(3))) bf16x8*)(kp+4608);
  kf[6]=*(const __attribute__((address_space(3))) bf16x8*)(kp+6144); kf[7]=*(const __attribute__((address_space(3))) bf16x8*)(kp+6656);
}
__device__ __forceinline__ void kload2(bf16x8*kf,lds_cptr kp,int j){ kf[2*j]=*(const __attribute__((address_space(3))) bf16x8*)(kp+j*2048); kf[2*j+1]=*(const __attribute__((address_space(3))) bf16x8*)(kp+j*2048+512); }
__device__ __forceinline__ s16x4 vtr(lds_cptr p){ return __builtin_bit_cast(s16x4,__builtin_amdgcn_ds_read_tr16_b64_v4i16((__attribute__((address_space(3))) v4i16_t*)p)); }
__device__ __forceinline__ float rowmax(const f32x16&p0,const f32x16&p1){
  float a=max3f(p0[0],p0[1],p1[0]),b=max3f(p0[2],p0[3],p1[1]);a=max3f(a,p1[2],p1[3]);
  #pragma unroll
  for(int r=4;r<16;r+=4){a=max3f(a,p0[r],p0[r+1]);b=max3f(b,p0[r+2],p0[r+3]);a=max3f(a,p1[r],p1[r+1]);b=max3f(b,p1[r+2],p1[r+3]);}
  const float m=max2f(a,b);
  auto rr=__builtin_amdgcn_permlane32_swap(__float_as_uint(m),__float_as_uint(m),false,false);
  return max2f(__uint_as_float(rr[0]),__uint_as_float(rr[1]));
}
__device__ __forceinline__ void pv(f32x16*o,int vb,bf16x8 pa0,bf16x8 pa1,bf16x8 pa2,bf16x8 pa3){
  #pragma unroll
  for(int d0=0;d0<2;++d0){s16x4 lo[4],hi[4];
    #pragma unroll
    for(int ks=0;ks<4;++ks){
      asm volatile("ds_read_b64_tr_b16 %0,%1 offset:%c2":"=&v"(lo[ks]):"v"(vb),"i"(d0*4096+ks*1024):"memory");
      asm volatile("ds_read_b64_tr_b16 %0,%1 offset:%c2":"=&v"(hi[ks]):"v"(vb),"i"(d0*4096+ks*1024+512):"memory");}
    asm volatile("s_waitcnt lgkmcnt(0)":::"memory");SBAR();
    #define PK(k) (bf16x8){lo[k][0],lo[k][1],lo[k][2],lo[k][3],hi[k][0],hi[k][1],hi[k][2],hi[k][3]}
    o[d0]=__builtin_amdgcn_mfma_f32_32x32x16_bf16(pa0,PK(0),o[d0],0,0,0);
    o[d0]=__builtin_amdgcn_mfma_f32_32x32x16_bf16(pa1,PK(1),o[d0],0,0,0);
    o[d0]=__builtin_amdgcn_mfma_f32_32x32x16_bf16(pa2,PK(2),o[d0],0,0,0);
    o[d0]=__builtin_amdgcn_mfma_f32_32x32x16_bf16(pa3,PK(3),o[d0],0,0,0);
    #undef PK
  }
}

#ifndef ATTN_STORE16
#define ATTN_STORE16(p,v) (*(u32x4*)(p)=(v))
#endif
template<int THRL> __device__ __forceinline__ void attn_unit(int qcol,int vcol,int ocol,int hb,int qb,const bf16*Q,const bf16*K,const bf16*V,bf16*O,const float*biasd,char*shm){
  int tid_=threadIdx.x; asm volatile("":"+v"(tid_)); const int tid=tid_,lane=tid&63,r32=lane&31,hi=lane>>5; const int wid=__builtin_amdgcn_readfirstlane(tid>>6);
  const long rowbase=0; const int q0=qb*QB;
  const bf16*Qw=Q+(rowbase+q0+wid*QBLK)*DM+qcol;
  const bf16*Kh=K+rowbase*DM+qcol,*Vh=V+rowbase*DM+vcol;
  { __attribute__((address_space(3))) float* btw=(__attribute__((address_space(3))) float*)(lds_cptr)shm+LDS_BT/4; if(tid<128)btw[tid]=biasd[hb*128+tid]; }
  const lds_cfptr btab=(lds_cfptr)((lds_cptr)shm+LDS_BT);
  const unsigned lds0=(unsigned)(uintptr_t)shm;
  float*wsf=(float*)(shm+LDS_WS)+wid*64;
  const bf16*ksrc=Kh+(long)lane*DM+wid*8;
  const bf16*vsrc=Vh+(long)(16*(wid&3)+(lane>>2))*DM+(wid>>2)*32+(lane&3)*8;
  const unsigned kdst=lds0+LDS_K+wid*1024, vdst=lds0+LDS_V+wid*1024;
  #define DMA_K(t,slot) glds16(ksrc+(long)(t)*KVBLK*DM,(unsigned)__builtin_amdgcn_readfirstlane(kdst+(slot)))
  #define DMA_V(t,slot) glds16(vsrc+(long)(t)*KVBLK*DM,(unsigned)__builtin_amdgcn_readfirstlane(vdst+(slot)))
  const int vb0=(int)(lds0+LDS_V)+((lane>>4)&1)*32+(lane&3)*8+(4*hi+((lane&15)>>2))*64;
  const char*Kbase=shm+LDS_K; bf16x8 kf[8];
  const lds_cptr shm3=(lds_cptr)shm; const lds_cptr kp0=shm3+LDS_K+hi*1024+r32*16; const lds_cptr vp0=shm3+LDS_V+((lane>>4)&1)*32+(lane&3)*8+(4*hi+((lane&15)>>2))*64;
  const int NT=(q0+QB)/KVBLK;
  DMA_K(0,0);DMA_V(0,0);DMA_K(1,SLOTB);
  bf16x8 qr[4];
  #pragma unroll
  for(int d0=0;d0<4;++d0)qr[d0]=*reinterpret_cast<const bf16x8*>(&Qw[(long)r32*DM+d0*16+hi*8]);
  float mhat=0.f,l_reg=0.f;f32x16 o[2];o[0]=f32x16{};o[1]=f32x16{};f32x16 negm=f32x16{};asm volatile("":"+v"(negm));
  const int qrel=wid*QBLK+r32;
  #define CMASK(P0,P1,t) do{int jb_=(t)-(NT-4); if(jb_>=-2)cmask(P0,P1,jb_,qrel,hi,btab);}while(0)
  bool resc=false;
  #define START(P0,P1) do{ const float rm=rowmax(P0,P1); resc=false; \
    { const float dl=rm; mhat=fadd_s(mhat,dl); \
      _Pragma("unroll") for(int r=0;r<16;++r){P0[r]=fsub_s(P0[r],dl);P1[r]=fsub_s(P1[r],dl);} \
      _Pragma("unroll") for(int r=0;r<16;++r)negm[r]=-mhat; asm volatile("":"+v"(negm)); } \
    _Pragma("unroll") for(int r=0;r<16;++r)P0[r]=__builtin_amdgcn_exp2f(P0[r]); }while(0)
  #define RESC() do{ if(resc){ asm volatile("s_waitcnt lgkmcnt(0)":::"memory"); \
      _Pragma("unroll") for(int d_=0;d_<2;++d_) _Pragma("unroll") for(int r=0;r<16;++r)o[d_][r]*=wsf[crow(r,hi)]; } }while(0)
  f32x16 pA0,pA1,pB0,pB1;
  int sl_prev=0,sl_cur=0,sl_next=SLOTB;
  #define ROT() do{sl_prev=sl_cur;sl_cur=sl_next;sl_next=(sl_next==(NSLOT-1)*SLOTB)?0:sl_next+SLOTB;}while(0)
  DMA_K(2,2*SLOTB);
  WAIT_BAR(3);
  qkt(pA0,pA1,Kbase,qr,negm,r32,hi);asm volatile("s_nop 15\n\ts_nop 7":"+v"(pA0),"+v"(pA1));CMASK(pA0,pA1,0);
  START(pA0,pA1);
  _Pragma("unroll") for(int r=0;r<16;++r)pA1[r]=__builtin_amdgcn_exp2f(pA1[r]);
  WAIT_BAR(0);
  DMA_K(3,0);DMA_V(1,SLOTB);
  ROT();
  kload8(kf,kp0+sl_cur);
  WAIT_BAR(2);
  s16x4 vlo[8],vhi[8]; u32x4 pw0,pw1,pw2,pw3;
  #define PKW(P,B) cvtpk_s(P[B],P[B+1])
  #define PAF(k) __builtin_bit_cast(bf16x8,pw##k)
  #define VFR(i) (bf16x8){vlo[i][0],vlo[i][1],vlo[i][2],vlo[i][3],vhi[i][0],vhi[i][1],vhi[i][2],vhi[i][3]}
  #define PIN(x) asm volatile("":"+v"(x))
  #define MX3(a,b,c) __builtin_fmaxf(__builtin_fmaxf((a),(b)),(c))
  #define GAPA(MF,A0,A1,A2,A3,W0,W1,PW) do{ MF; sacc+=A0; sacc+=A1; sacc+=A2; sacc+=A3; PIN(sacc); W0; W1; PIN(PW); SBAR(); }while(0)
  #define EX(v) __builtin_amdgcn_exp2f(v)
  #define GAPB(MF,X,B) do{ MF; X[B]=EX(X[B]); X[B+1]=EX(X[B+1]); X[B+2]=EX(X[B+2]); X[B+3]=EX(X[B+3]); PIN(X); SBAR(); }while(0)
  #define VRD(i) do{ vlo[i]=vtr(vp_+(((i)>>2)*4096+((i)&3)*1024)); vhi[i]=vtr(vp_+(((i)>>2)*4096+((i)&3)*1024+512)); }while(0)
  #define KRD(G,j) do{ if(G){ kload2(kf,kp0+sl_next,j); SBAR(); } }while(0)
  #define STEP(C0,C1,P0,P1,t,GK,GV,GL) do{ SBAR(); \
    const lds_cptr vp_=vp0+sl_prev; \
    VRD(0); SBAR(); float sacc=(P0[0]+P0[1]); \
    GAPA(C0=__builtin_amdgcn_mfma_f32_32x32x16_bf16(kf[0],qr[0],negm,0,0,0), P0[2],P0[3],P0[4],P0[5],     pw0[0]=PKW(P0,0), pw0[1]=PKW(P0,2), pw0); \
    VRD(4); SBAR(); GAPA(C1=__builtin_amdgcn_mfma_f32_32x32x16_bf16(kf[1],qr[0],negm,0,0,0), P0[6],P0[7],P0[8],P0[9],     pw0[2]=PKW(P0,4), pw0[3]=PKW(P0,6), pw0); \
    VRD(1); SBAR(); GAPA(C0=__builtin_amdgcn_mfma_f32_32x32x16_bf16(kf[2],qr[1],C0,0,0,0),   P0[10],P0[11],P0[12],P0[13], pw1[0]=PKW(P0,8), pw1[1]=PKW(P0,10), pw1); \
    VRD(5); SBAR(); GAPA(C1=__builtin_amdgcn_mfma_f32_32x32x16_bf16(kf[3],qr[1],C1,0,0,0),   P0[14],P0[15],P1[0],P1[1],   pw1[2]=PKW(P0,12),pw1[3]=PKW(P0,14), pw1); \
    VRD(2); SBAR(); GAPA(C0=__builtin_amdgcn_mfma_f32_32x32x16_bf16(kf[4],qr[2],C0,0,0,0),   P1[2],P1[3],P1[4],P1[5],     pw2[0]=PKW(P1,0), pw2[1]=PKW(P1,2), pw2); \
    VRD(6); SBAR(); GAPA(C1=__builtin_amdgcn_mfma_f32_32x32x16_bf16(kf[5],qr[2],C1,0,0,0),   P1[6],P1[7],P1[8],P1[9],     pw2[2]=PKW(P1,4), pw2[3]=PKW(P1,6), pw2); \
    VRD(3); SBAR(); GAPA(C0=__builtin_amdgcn_mfma_f32_32x32x16_bf16(kf[6],qr[3],C0,0,0,0),   P1[10],P1[11],P1[12],P1[13], pw3[0]=PKW(P1,8), pw3[1]=PKW(P1,10), pw3); \
    VRD(7); SBAR(); GAPA(C1=__builtin_amdgcn_mfma_f32_32x32x16_bf16(kf[7],qr[3],C1,0,0,0),   P1[14],P1[15],0.f,0.f,       pw3[2]=PKW(P1,12),pw3[3]=PKW(P1,14), pw3); \
    l_reg+=sacc; \
    if(GK){DMA_K((t)+3,sl_cur);} if(GV){DMA_V((t)+1,sl_next);} \
    CMASK(C0,C1,t); \
    { float a=MX3(C0[0],C0[1],C1[0]),b=MX3(C0[2],C0[3],C1[1]); a=MX3(a,C1[2],C1[3]); \
      _Pragma("unroll") for(int r=4;r<16;r+=4){a=MX3(a,C0[r],C0[r+1]);b=MX3(b,C0[r+2],C0[r+3]);a=MX3(a,C1[r],C1[r+1]);b=MX3(b,C1[r+2],C1[r+3]);} \
      float rm=__builtin_fmaxf(a,b); { auto rr=__builtin_amdgcn_permlane32_swap(__float_as_uint(rm),__float_as_uint(rm),false,false); rm=__builtin_fmaxf(__uint_as_float(rr[0]),__uint_as_float(rr[1])); } \
      resc=false; \
      if(__builtin_expect(__any(rm>(float)THRL),0)){ const float dl=__builtin_fmaxf(rm,0.f); mhat+=dl; \
        _Pragma("unroll") for(int r=0;r<16;++r){C0[r]-=dl;C1[r]-=dl;} \
        _Pragma("unroll") for(int r=0;r<16;++r)negm[r]=-mhat; asm volatile("":"+v"(negm)); \
        const float f=__builtin_amdgcn_exp2f(-dl); l_reg*=f; if(hi==0)wsf[r32]=f; resc=true; } } \
    SBAR(); \
    GAPB(o[0]=__builtin_amdgcn_mfma_f32_32x32x16_bf16(PAF(0),VFR(0),o[0],0,0,0), C0,0); \
    GAPB(o[1]=__builtin_amdgcn_mfma_f32_32x32x16_bf16(PAF(0),VFR(4),o[1],0,0,0), C0,4); \
    KRD(GL,0); GAPB(o[0]=__builtin_amdgcn_mfma_f32_32x32x16_bf16(PAF(1),VFR(1),o[0],0,0,0), C0,8); \
    KRD(GL,1); GAPB(o[1]=__builtin_amdgcn_mfma_f32_32x32x16_bf16(PAF(1),VFR(5),o[1],0,0,0), C0,12); \
    KRD(GL,2); GAPB(o[0]=__builtin_amdgcn_mfma_f32_32x32x16_bf16(PAF(2),VFR(2),o[0],0,0,0), C1,0); \
    KRD(GL,3); GAPB(o[1]=__builtin_amdgcn_mfma_f32_32x32x16_bf16(PAF(2),VFR(6),o[1],0,0,0), C1,4); \
    GAPB(o[0]=__builtin_amdgcn_mfma_f32_32x32x16_bf16(PAF(3),VFR(3),o[0],0,0,0), C1,8); \
    GAPB(o[1]=__builtin_amdgcn_mfma_f32_32x32x16_bf16(PAF(3),VFR(7),o[1],0,0,0), C1,12); \
    }while(0)
  int t=1;
  #undef CMASK
  #define CMASK(P0,P1,t) do{}while(0)
  for(;t+7<NT;t+=2){
    STEP(pB0,pB1,pA0,pA1,t,true,true,true);     WAIT_BAR(2); RESC(); ROT();
    STEP(pA0,pA1,pB0,pB1,t+1,true,true,true);   WAIT_BAR(2); RESC(); ROT();
  }
  #undef CMASK
  #define CMASK(P0,P1,t) do{int jb_=(t)-(NT-4); if(jb_>=-2)cmask(P0,P1,jb_,qrel,hi,btab);}while(0)
  #define ENDW(tt) do{ if((tt)+3<NT){WAIT_BAR(2);} else if((tt)+2<NT){WAIT_BAR(1);} else {WAIT_BAR(0);} }while(0)
  for(;t+1<NT;t+=2){
    STEP(pB0,pB1,pA0,pA1,t,(t+3<NT),(t+1<NT),(t+1<NT));       ENDW(t);   RESC(); ROT();
    STEP(pA0,pA1,pB0,pB1,t+1,(t+4<NT),(t+2<NT),(t+2<NT));     ENDW(t+1); RESC(); ROT();
  }
  STEP(pB0,pB1,pA0,pA1,NT-1,false,false,false); RESC();
  { float sacc=pB0[0]+pB0[1]; _Pragma("unroll") for(int r=2;r<16;++r)sacc+=pB0[r]; _Pragma("unroll") for(int r=0;r<16;++r)sacc+=pB1[r]; l_reg+=sacc;
    pw0=(u32x4){PKW(pB0,0),PKW(pB0,2),PKW(pB0,4),PKW(pB0,6)};pw1=(u32x4){PKW(pB0,8),PKW(pB0,10),PKW(pB0,12),PKW(pB0,14)};pw2=(u32x4){PKW(pB1,0),PKW(pB1,2),PKW(pB1,4),PKW(pB1,6)};pw3=(u32x4){PKW(pB1,8),PKW(pB1,10),PKW(pB1,12),PKW(pB1,14)};
    SBAR(); pv(o,vb0+sl_cur,PAF(0),PAF(1),PAF(2),PAF(3)); }
  #undef PKW
  #undef PAF
  #undef VFR
  #undef PIN
  #undef MX3
  #undef GAPA
  #undef GAPB
  #undef EX
  #undef VRD
  #undef KRD
  #undef STEP
  #undef ENDW
  {auto rr=__builtin_amdgcn_permlane32_swap(__float_as_uint(l_reg),__float_as_uint(l_reg),false,false);l_reg=__uint_as_float(rr[0])+__uint_as_float(rr[1]);}
  if(hi==0)wsf[32+r32]=l_reg;asm volatile("s_waitcnt lgkmcnt(0)":::"memory");
  float rli[16];
  #pragma unroll
  for(int r=0;r<16;++r)rli[r]=__builtin_amdgcn_rcpf(wsf[32+crow(r,hi)]);
  bf16*Ow=O+(rowbase+q0+wid*QBLK)*OPITCH+ocol;
  { bf16*stg=(bf16*)(shm+LDS_OST)+wid*2048;
    #pragma unroll
    for(int r=0;r<16;++r){const int orow=crow(r,hi);
      #pragma unroll
      for(int d0=0;d0<2;++d0)stg[orow*64+d0*32+r32]=__float2bfloat16(o[d0][r]*rli[r]);}
    asm volatile("s_waitcnt lgkmcnt(0)":::"memory");
    #pragma unroll
    for(int i=0;i<4;++i){const int row=i*8+(lane>>3),ch=lane&7; const u32x4 v=*(const u32x4*)(stg+row*64+ch*8); ATTN_STORE16(Ow+(long)row*OPITCH+ch*8,v);} }
  asm volatile("s_waitcnt lgkmcnt(0)\n\ts_barrier":::"memory");
  #undef DMA_K
  #undef DMA_V
  #undef CMASK
  #undef START
  #undef RESC
  #undef ROT
}
constexpr int ATTN_LDS_BYTES=LDS_BYTES;
struct AttnTensors { const bf16* Q; const bf16* K; const bf16* V; bf16* O; const float* biasd; };
template<int THRL=8> __device__ __forceinline__ void attn_phase(char*lds,const AttnTensors&T,int vcu){
  const int inst=vcu>>3, s=vcu&7;
  for(int i=0;i<4;++i){ const int qb=(i==0)?s:(i==1)?15-s:(i==2)?16+s:31-s;
    attn_unit<THRL>((inst>>1)*64,(inst>>2)*128+(inst&1)*64,inst*64,inst>>2,qb,T.Q,T.K,T.V,T.O,T.biasd,lds); }
}
#undef SBAR
#undef WAIT_BAR
}
constexpr int NWAVES = 8;
constexpr int SEQ = 8192, DM = 2048, DFF = 5632, INW = 4096, AW = 1024, SW = 1024, NCOND = 9, DEPTH = 2;
constexpr int NG = 64, NP = 64, HC = 16;
constexpr int SCHUNK = 256, NCHUNK = SEQ / SCHUNK;
constexpr float LOG2E = 1.4426950408889634f;
constexpr size_t MiB = 1u << 20;
constexpr size_t WS_CTL = 0, CTL_ZERO_BYTES = 1 * MiB;
constexpr size_t WS_BIASD = 1 * MiB;
constexpr size_t WS_XEND = 2 * MiB;
constexpr size_t WS_WGU = 8 * MiB;
constexpr size_t WS_WD = WS_WGU + 4 * 44 * MiB;
constexpr size_t WS_WIN = WS_WD + 4 * 22 * MiB;
constexpr size_t WS_WOUT = WS_WIN + 2 * 16 * MiB;
constexpr size_t WS_WGLU = WS_WOUT + 2 * 8 * MiB;
constexpr size_t WS_H = WS_WGLU + 2 * 2 * MiB;
constexpr size_t WS_ACT = WS_H + 32 * MiB;
constexpr size_t WS_Q = WS_ACT + 88 * MiB;
constexpr size_t WS_K = WS_Q + 16 * MiB, WS_V = WS_K + 16 * MiB, WS_U = WS_V + 16 * MiB;
constexpr size_t WS_OP = WS_U + 16 * MiB;
constexpr size_t WS_CAT = WS_OP + 32 * MiB;
constexpr size_t WS_YG = WS_CAT + 32 * MiB;
constexpr size_t WS_END = WS_YG + 16 * MiB;
constexpr int RING_BYTES = 131072, LDS_BYTES = 147456;

#define LAS __attribute__((address_space(3)))
typedef unsigned short bf16;
typedef unsigned v4u __attribute__((ext_vector_type(4)));
typedef unsigned v2u __attribute__((ext_vector_type(2)));
typedef float f32x4 __attribute__((ext_vector_type(4)));
typedef float f32x2v __attribute__((ext_vector_type(2)));
typedef short bf16x8 __attribute__((ext_vector_type(8)));
#define LDS_WAIT() asm volatile("s_waitcnt lgkmcnt(0)" ::: "memory")
__device__ __forceinline__ unsigned pk2(float lo, float hi) { return pg8::cvt_pk_bf16(lo, hi); }
__device__ __forceinline__ float wave_sum(float v) {
#pragma unroll
    for (int o = 1; o < 64; o <<= 1) v += __shfl_xor(v, o);
    return v;
}

struct Frame {
    LAS unsigned char* lds;
    int tid, lane, wave, vcu, G;
};
__device__ __forceinline__ Frame frame_opaque(const Frame& F0) { Frame F = F0; asm volatile("" : "+v"(F.tid)); F.lane = F.tid & 63; return F; }

__device__ __forceinline__ void p0_transpose_item(const float* W, int K, int N, bf16* WT, int k0, int n0, int drow0, LAS float* scr, int lane) {
#pragma unroll 8
    for (int i = 0; i < 32; ++i) { const int kk = 2 * i + (lane >> 5); scr[kk * 33 + (lane & 31)] = W[(size_t)(k0 + kk) * N + n0 + (lane & 31)]; }
    LDS_WAIT(); asm volatile("" ::: "memory");
    const int c = lane & 7;
#pragma unroll
    for (int j = 0; j < 4; ++j) { const int n = (lane >> 3) + 8 * j; const LAS float* s = scr + (8 * c) * 33 + n;
        v4u o; o.x = pk2(s[0 * 33], s[1 * 33]); o.y = pk2(s[2 * 33], s[3 * 33]); o.z = pk2(s[4 * 33], s[5 * 33]); o.w = pk2(s[6 * 33], s[7 * 33]);
        *(v4u*)(WT + (size_t)(drow0 + n) * K + k0 + 8 * c) = o; }
    LDS_WAIT(); asm volatile("" ::: "memory");
}
__device__ __forceinline__ void p0_matrix_item(const float* W, int K, int N, bf16* WT, int mode, int item, LAS float* scr, int lane) {
    const int nblk = N / 32, kb = item / nblk, nb = item % nblk, k0 = 64 * kb, n0 = 32 * nb;
    int drow0 = n0;
    if (mode == 1 || mode == 2) drow0 = (n0 >> 7) * 256 + (mode - 1) * 128 + (n0 & 127);
    else if (mode == 3 && n0 < 2048) { const int pn = n0 >> 8, cc = n0 & 255; drow0 = pn * 256 + ((cc >> 5) & 1) * 128 + (cc >> 6) * 32; }
    p0_transpose_item(W, K, N, WT, k0, n0, drow0, scr, lane);
}
struct In { const float* p[31]; };
__device__ __forceinline__ const float* inp(int i) { const float* const __attribute__((address_space(4)))* t = (const float* const __attribute__((address_space(4)))*)__builtin_amdgcn_kernarg_segment_ptr(); asm volatile("" : "+s"(t)); return t[i]; }
__device__ __forceinline__ int t5_bucket(int d) {
    if (d < 16) return d;
    int b = 16; b += d >= 19; b += d >= 21; b += d >= 24; b += d >= 27; b += d >= 31; b += d >= 35; b += d >= 40; b += d >= 46; b += d >= 52; b += d >= 59; b += d >= 67; b += d >= 77; b += d >= 87; b += d >= 99; b += d >= 113;
    return b;
}
__device__ __forceinline__ void p0_prologue(const Frame& F0, unsigned char* ws) { const Frame F = frame_opaque(F0);
    LAS float* scr = (LAS float*)(F.lds + F.wave * 16384);
    const int gw = F.vcu * NWAVES + F.wave, NGW = F.G * NWAVES;
    if (blockIdx.x == 0) { float* bd = (float*)(ws + WS_BIASD); const float* rb = inp(2);
        for (int i = F.tid; i < 1024; i += NWAVES * 64) { const int h = i >> 7, d = i & 127; bd[i] = (rb[t5_bucket(d) * 8 + h] - rb[31 * 8 + h]) * LOG2E; } }
    { float* mod = (float*)(ws + WS_CTL); const float* cvec = inp(1);
      for (int it = gw; it < 144 * 16; it += NGW) { const int cb = it % 144, kc = it / 144, layer = cb / 72, col = (cb % 72) * 256 + F.lane * 4;
          const float* W = inp(3) + ((size_t)layer * DM + kc * 128) * (NCOND * DM) + col;
          f32x4 acc = (f32x4){0.f, 0.f, 0.f, 0.f}; if (kc == 0) acc = *(const f32x4*)(inp(4) + layer * (NCOND * DM) + col);
#pragma unroll 8
          for (int kk = 0; kk < 128; ++kk) { const float cv = cvec[kc * 128 + kk]; const float sv = cv * pg8::sigmoid_f(cv); acc += sv * *(const f32x4*)(W + (size_t)kk * (NCOND * DM)); }
          float* dst = mod + layer * (NCOND * DM) + col; atomicAdd(dst, acc[0]); atomicAdd(dst + 1, acc[1]); atomicAdd(dst + 2, acc[2]); atomicAdd(dst + 3, acc[3]); } }
    constexpr int I_F = (DM / 64) * (DFF / 32), I_IN = (DM / 64) * (INW / 32), I_OUT = (DM / 64) * (DM / 32), I_GLU = (SW / 64) * (SW / 32);
    constexpr int PER_LAYER = 6 * I_F + I_IN + I_OUT + I_GLU;
    for (int it = gw; it < DEPTH * PER_LAYER; it += NGW) {
        const int li = it / PER_LAYER; int r = it % PER_LAYER;
        const size_t fo = (size_t)li * DM * DFF;
        bf16* wgu1 = (bf16*)(ws + WS_WGU) + (size_t)(li * 2 + 0) * 2 * DFF * DM; bf16* wgu2 = (bf16*)(ws + WS_WGU) + (size_t)(li * 2 + 1) * 2 * DFF * DM;
        bf16* wd1 = (bf16*)(ws + WS_WD) + (size_t)(li * 2 + 0) * DM * DFF; bf16* wd2 = (bf16*)(ws + WS_WD) + (size_t)(li * 2 + 1) * DM * DFF;
        if (r < I_F) { p0_matrix_item(inp(6) + fo, DM, DFF, wgu1, 1, r, scr, F.lane); continue; } r -= I_F;
        if (r < I_F) { p0_matrix_item(inp(7) + fo, DM, DFF, wgu1, 2, r, scr, F.lane); continue; } r -= I_F;
        if (r < I_F) { p0_matrix_item(inp(8) + fo, DFF, DM, wd1, 0, r, scr, F.lane); continue; } r -= I_F;
        if (r < I_F) { p0_matrix_item(inp(9) + fo, DM, DFF, wgu2, 1, r, scr, F.lane); continue; } r -= I_F;
        if (r < I_F) { p0_matrix_item(inp(10) + fo, DM, DFF, wgu2, 2, r, scr, F.lane); continue; } r -= I_F;
        if (r < I_F) { p0_matrix_item(inp(11) + fo, DFF, DM, wd2, 0, r, scr, F.lane); continue; } r -= I_F;
        if (r < I_IN) { p0_matrix_item(inp(12) + (size_t)li * DM * INW, DM, INW, (bf16*)(ws + WS_WIN) + (size_t)li * INW * DM, 3, r, scr, F.lane); continue; } r -= I_IN;
        if (r < I_OUT) { p0_matrix_item(inp(13) + (size_t)li * DM * DM, DM, DM, (bf16*)(ws + WS_WOUT) + (size_t)li * DM * DM, 0, r, scr, F.lane); continue; } r -= I_OUT;
        p0_matrix_item(inp(29) + (size_t)li * SW * SW, SW, SW, (bf16*)(ws + WS_WGLU) + (size_t)li * SW * SW, 0, r, scr, F.lane);
    }
}

__device__ __forceinline__ void norm_phase(const Frame& F0, const float* xin, const float* gnorm, const float* shift, const float* scale, bf16* H) { const Frame F = frame_opaque(F0);
    const int gw = F.vcu * NWAVES + F.wave, NGW = F.G * NWAVES;
    f32x4 gam[8], sh[8];
#pragma unroll
    for (int j = 0; j < 8; ++j) { const int idx = 4 * F.lane + 256 * j; gam[j] = *(const f32x4*)(gnorm + idx) * (1.0f + *(const f32x4*)(scale + idx)); sh[j] = *(const f32x4*)(shift + idx); }
    for (int m = gw; m < SEQ; m += NGW) {
        const f32x4* xr = (const f32x4*)(xin + (size_t)m * DM) + F.lane;
        f32x4 v[8]; float s = 0.f;
#pragma unroll
        for (int j = 0; j < 8; ++j) { v[j] = xr[64 * j]; s += (v[j].x * v[j].x + v[j].y * v[j].y) + (v[j].z * v[j].z + v[j].w * v[j].w); }
        const float rstd = __builtin_amdgcn_rsqf(wave_sum(s) * (1.0f / DM) + 1e-6f);
        v2u* o8 = (v2u*)(H + (size_t)m * DM) + F.lane;
#pragma unroll
        for (int j = 0; j < 8; ++j) { const f32x4 y = v[j] * rstd * gam[j] + sh[j]; v2u w; w.x = pk2(y.x, y.y); w.y = pk2(y.z, y.w); o8[64 * j] = w; }
    }
}

__device__ __forceinline__ void combine_phase(const Frame& F0, const bf16* OP, bf16* CAT, const float* lq1, const float* lk1, const float* lq2, const float* lk2, const float* subg, float lam_init) { const Frame F = frame_opaque(F0);
    const int gw = F.vcu * NWAVES + F.wave, NGW = F.G * NWAVES;
    const float lam = expf(wave_sum(lq1[F.lane] * lk1[F.lane])) - expf(wave_sum(lq2[F.lane] * lk2[F.lane])) + lam_init;
    const int h = F.lane >> 3, j0 = (F.lane & 7) * 16;
    float gs[16];
#pragma unroll
    for (int i = 0; i < 16; ++i) gs[i] = subg[j0 + i] * (1.0f - lam_init);
    for (int m = gw; m < SEQ; m += NGW) {
        const bf16* p1 = OP + (size_t)m * 2048 + (2 * h) * 128 + j0; const bf16* p2 = p1 + 128;
        const v4u a0 = *(const v4u*)p1, a1 = *(const v4u*)(p1 + 8), b0 = *(const v4u*)p2, b1 = *(const v4u*)(p2 + 8);
        float o[16];
#pragma unroll
        for (int i = 0; i < 4; ++i) { o[2 * i] = pg8::bf_lo(a0[i]) - lam * pg8::bf_lo(b0[i]); o[2 * i + 1] = pg8::bf_hi(a0[i]) - lam * pg8::bf_hi(b0[i]);
                                      o[8 + 2 * i] = pg8::bf_lo(a1[i]) - lam * pg8::bf_lo(b1[i]); o[8 + 2 * i + 1] = pg8::bf_hi(a1[i]) - lam * pg8::bf_hi(b1[i]); }
        float ss = 0.f;
#pragma unroll
        for (int i = 0; i < 16; ++i) ss += o[i] * o[i];
        ss += __shfl_xor(ss, 1); ss += __shfl_xor(ss, 2); ss += __shfl_xor(ss, 4);
        const float r = __builtin_amdgcn_rsqf(ss * (1.0f / 128.0f) + 1e-5f);
        v4u w0, w1;
#pragma unroll
        for (int i = 0; i < 4; ++i) { w0[i] = pk2(o[2 * i] * r * gs[2 * i], o[2 * i + 1] * r * gs[2 * i + 1]); w1[i] = pk2(o[8 + 2 * i] * r * gs[8 + 2 * i], o[8 + 2 * i + 1] * r * gs[8 + 2 * i + 1]); }
        bf16* q = CAT + (size_t)m * 2048 + h * 128 + j0; *(v4u*)q = w0; *(v4u*)(q + 8) = w1;
    }
}

struct SsmP { const float *lam_re, *lam_im, *log_step, *b_re, *b_im, *c_re, *c_im, *dv; };
__device__ __forceinline__ void cexp_s(float lr, float li, float s, float& er, float& ei) {
    const float m = expf(lr * s);
    double tr = (double)li * (double)s * 0.15915494309189535; tr -= floor(tr);
    const float a = (float)(tr * 6.283185307179586);
    float sn, cs; sincosf(a, &sn, &cs); er = m * cs; ei = m * sn;
}
__device__ __forceinline__ void ssm_lam(const SsmP& P, int g, int p, float& lr, float& li, float& step) {
    lr = fminf(P.lam_re[g * NP + p], -1e-4f); li = P.lam_im[g * NP + p]; step = expf(P.log_step[g]);
}
__device__ __forceinline__ void ssm_bfrag(const SsmP& P, int g, int lane, bf16x8 (&bfr)[8]) {
    const int q = lane >> 4, ci = lane & 15, hb = 8 * (q & 1);
#pragma unroll
    for (int pb = 0; pb < 4; ++pb) { const int p = 16 * pb + ci; float lr, li, step, ar, ai; ssm_lam(P, g, p, lr, li, step); cexp_s(lr, li, step, ar, ai);
        const float nr = ar - 1.0f, ni = ai, den = 1.0f / (lr * lr + li * li); const float cr = (nr * lr + ni * li) * den, cim = (ni * lr - nr * li) * den;
        const float* br = P.b_re + ((size_t)g * NP + p) * HC + hb; const float* bi = P.b_im + ((size_t)g * NP + p) * HC + hb;
        const f32x4 r0 = *(const f32x4*)br, r1 = *(const f32x4*)(br + 4), i0 = *(const f32x4*)bi, i1 = *(const f32x4*)(bi + 4);
        const f32x4 re0 = cr * r0 - cim * i0, re1 = cr * r1 - cim * i1, im0 = cr * i0 + cim * r0, im1 = cr * i1 + cim * r1;
        v4u wr_, wi_; wr_.x = pk2(re0[0], re0[1]); wr_.y = pk2(re0[2], re0[3]); wr_.z = pk2(re1[0], re1[1]); wr_.w = pk2(re1[2], re1[3]);
        wi_.x = pk2(im0[0], im0[1]); wi_.y = pk2(im0[2], im0[3]); wi_.z = pk2(im1[0], im1[1]); wi_.w = pk2(im1[2], im1[3]);
        if (q >= 2) { wr_ = (v4u){0u, 0u, 0u, 0u}; wi_ = (v4u){0u, 0u, 0u, 0u}; }
        bfr[pb] = __builtin_bit_cast(bf16x8, wr_); bfr[4 + pb] = __builtin_bit_cast(bf16x8, wi_); }
}
constexpr int BU_STRIDE = 132, XB_STRIDE = 136;
__device__ __forceinline__ void ssm_bu_to_lds(bf16x8 af, const bf16x8 (&bfr)[8], LAS float* bu, int lane) {
    const int q = lane >> 4, ci = lane & 15;
#pragma unroll
    for (int nb = 0; nb < 8; ++nb) { const f32x4 d = __builtin_amdgcn_mfma_f32_16x16x32_bf16(af, bfr[nb], (f32x4){0.f, 0.f, 0.f, 0.f}, 0, 0, 0);
#pragma unroll
        for (int r = 0; r < 4; ++r) bu[(4 * q + r) * BU_STRIDE + 16 * nb + ci] = d[r]; }
}
__device__ __forceinline__ bf16x8 ssm_load_u(const bf16* U, int g, int t, int q) {
    bf16x8 af = (bf16x8){0, 0, 0, 0, 0, 0, 0, 0};
    if (q < 2) af = *(const bf16x8*)(U + (size_t)t * SW + g * HC + 8 * q);
    return af;
}
__device__ __forceinline__ void ssm_pass1(const Frame& F0, const SsmP& P, const bf16* U, float* XEND) { const Frame F = frame_opaque(F0);
    const int gw = F.vcu * NWAVES + F.wave, NGW = F.G * NWAVES, lane = F.lane, q = lane >> 4, ci = lane & 15;
    LAS float* bu = (LAS float*)(F.lds + F.wave * 16384);
    for (int it = gw; it < NG * NCHUNK; it += NGW) { const int g = it / NCHUNK, c = it % NCHUNK, t0 = c * SCHUNK;
        bf16x8 bfr[8]; ssm_bfrag(P, g, lane, bfr);
        float lr, li, step, ar, ai; ssm_lam(P, g, lane, lr, li, step); cexp_s(lr, li, step, ar, ai);
        float xr = 0.f, xi = 0.f;
        bf16x8 af = ssm_load_u(U, g, t0 + ci, q);
        for (int sb = 0; sb < SCHUNK / 16; ++sb) {
            ssm_bu_to_lds(af, bfr, bu, lane);
            if (sb + 1 < SCHUNK / 16) af = ssm_load_u(U, g, t0 + (sb + 1) * 16 + ci, q);
            LDS_WAIT();
#pragma unroll
            for (int tt = 0; tt < 16; ++tt) { const float br_ = bu[tt * BU_STRIDE + lane], bi_ = bu[tt * BU_STRIDE + 64 + lane];
                const float nxr = ar * xr - ai * xi + br_, nxi = ar * xi + ai * xr + bi_; xr = nxr; xi = nxi; }
            LDS_WAIT();
        }
        *(f32x2v*)(XEND + ((size_t)it * NP + lane) * 2) = (f32x2v){xr, xi};
    }
}
__device__ __forceinline__ float gelu_tanh(float x) {
    const float z = x + 0.044715f * x * x * x;
    return x * __builtin_amdgcn_rcpf(1.0f + __builtin_amdgcn_exp2f(-2.0f * 0.7978845608028654f * LOG2E * z));
}
__device__ __forceinline__ void ssm_pass2(const Frame& F0, const SsmP& P, const bf16* U, const float* XEND, bf16* YG) { const Frame F = frame_opaque(F0);
    const int gw = F.vcu * NWAVES + F.wave, NGW = F.G * NWAVES, lane = F.lane, q = lane >> 4, ci = lane & 15;
    LAS float* bu = (LAS float*)(F.lds + F.wave * 16384);
    LAS bf16* xb = (LAS bf16*)(F.lds + F.wave * 16384 + 16 * BU_STRIDE * 4);
    for (int it = gw; it < NG * NCHUNK; it += NGW) { const int g = it / NCHUNK, c = it % NCHUNK, t0 = c * SCHUNK;
        bf16x8 bfr[8]; ssm_bfrag(P, g, lane, bfr);
        float lr, li, step, ar, ai; ssm_lam(P, g, lane, lr, li, step); cexp_s(lr, li, step, ar, ai);
        float xr = 0.f, xi = 0.f;
        { float aTr, aTi; cexp_s(lr, li, step * (float)SCHUNK, aTr, aTi);
          for (int cc = 0; cc < c; ++cc) { const f32x2v e = *(const f32x2v*)(XEND + ((size_t)(g * NCHUNK + cc) * NP + lane) * 2);
              const float nxr = aTr * xr - aTi * xi + e.x, nxi = aTr * xi + aTi * xr + e.y; xr = nxr; xi = nxi; } }
        bf16x8 cf[4];
#pragma unroll
        for (int kb = 0; kb < 4; ++kb) { const float* src = (kb < 2 ? P.c_re : P.c_im) + ((size_t)g * HC + ci) * NP + 32 * (kb & 1) + 8 * q; const float sg = kb < 2 ? 1.0f : -1.0f;
            const f32x4 a = *(const f32x4*)src * sg, b = *(const f32x4*)(src + 4) * sg;
            v4u w; w.x = pk2(a[0], a[1]); w.y = pk2(a[2], a[3]); w.z = pk2(b[0], b[1]); w.w = pk2(b[2], b[3]); cf[kb] = __builtin_bit_cast(bf16x8, w); }
        const f32x4 dv4 = *(const f32x4*)(P.dv + g * HC + 4 * q);
        bf16x8 af = ssm_load_u(U, g, t0 + ci, q);
        for (int sb = 0; sb < SCHUNK / 16; ++sb) {
            ssm_bu_to_lds(af, bfr, bu, lane);
            if (sb + 1 < SCHUNK / 16) af = ssm_load_u(U, g, t0 + (sb + 1) * 16 + ci, q);
            const int t = t0 + sb * 16 + ci;
            const v2u uu = *(const v2u*)(U + (size_t)t * SW + g * HC + 4 * q);
            LDS_WAIT();
#pragma unroll
            for (int tt = 0; tt < 16; ++tt) { const float br_ = bu[tt * BU_STRIDE + lane], bi_ = bu[tt * BU_STRIDE + 64 + lane];
                const float nxr = ar * xr - ai * xi + br_, nxi = ar * xi + ai * xr + bi_; xr = nxr; xi = nxi;
                const unsigned pk = pk2(xr, xi); xb[tt * XB_STRIDE + lane] = (bf16)(pk & 0xffffu); xb[tt * XB_STRIDE + 64 + lane] = (bf16)(pk >> 16); }
            LDS_WAIT();
            f32x4 yd = (f32x4){0.f, 0.f, 0.f, 0.f};
#pragma unroll
            for (int kb = 0; kb < 4; ++kb) { const bf16x8 xf = *(const LAS bf16x8*)(xb + ci * XB_STRIDE + 32 * kb + 8 * q); yd = __builtin_amdgcn_mfma_f32_16x16x32_bf16(cf[kb], xf, yd, 0, 0, 0); }
            const float y0 = gelu_tanh(yd[0] + dv4[0] * pg8::bf_lo(uu.x)), y1 = gelu_tanh(yd[1] + dv4[1] * pg8::bf_hi(uu.x));
            const float y2 = gelu_tanh(yd[2] + dv4[2] * pg8::bf_lo(uu.y)), y3 = gelu_tanh(yd[3] + dv4[3] * pg8::bf_hi(uu.y));
            v2u w; w.x = pk2(y0, y1); w.y = pk2(y2, y3);
            *(v2u*)(YG + (size_t)t * SW + g * HC + 4 * q) = w;
            LDS_WAIT();
        }
    }
}

struct Args { In in; float* out; unsigned char* ws; int ph_lo, ph_hi; };
constexpr int N_PHASES = 1 + 12 * DEPTH;
__global__ void __launch_bounds__(NWAVES * 64, 2) mega_fwd(Args args) {
    extern __shared__ __attribute__((aligned(16))) unsigned char lds[];
    cg::grid_group grid = cg::this_grid();
    Frame F;
    F.lds = (LAS unsigned char*)lds;
    F.tid = threadIdx.x; F.lane = F.tid & 63; F.wave = __builtin_amdgcn_readfirstlane(F.tid >> 6);
    F.G = gridDim.x; { const int bx = blockIdx.x; F.vcu = (F.G % 8 == 0) ? (bx % 8) * (F.G / 8) + bx / 8 : bx; }
    const int lo = args.ph_lo, hi = args.ph_hi;
    int ph = 0;
#define PH_ON (ph >= lo && ph < hi)
#define PH_END do { if (ph >= lo && ph + 1 < hi) grid.sync(); ++ph; } while (0)
#define PH_LOCALS unsigned char* ws = args.ws; float* xout = args.out; int li = li_, f = f_; asm volatile("" : "+s"(ws), "+s"(xout), "+s"(li), "+s"(f)); \
    const float* md = (const float*)(ws + WS_CTL) + li * (NCOND * DM); const float* ng = inp(5) + (size_t)li * 3 * DM; const int sub = f == 0 ? 0 : 2; \
    const float* xcur = (li == 0 && f == 0) ? inp(0) : (const float*)xout; (void)md; (void)ng; (void)sub; (void)xcur;

    if (PH_ON) p0_prologue(F, args.ws);
    PH_END;

    for (int li_ = 0; li_ < DEPTH; ++li_) {
        for (int f_ = 0; f_ < 2; ++f_) {
            if (PH_ON) { PH_LOCALS; norm_phase(F, xcur, ng + sub * DM, md + (3 * sub) * DM, md + (3 * sub + 1) * DM, (bf16*)(ws + WS_H)); }
            PH_END;
            if (PH_ON) { PH_LOCALS; pg8::Gemm g{(const bf16*)(ws + WS_H), (const bf16*)(ws + WS_WGU) + (size_t)(li * 2 + f) * 2 * DFF * DM, SEQ, 2 * DFF, DM}; pg8::StaticOrder S; S.init(SEQ, 2 * DFF, F.G, (int)blockIdx.x);
                pg8::EpiSwiGlu E{(bf16*)(ws + WS_ACT), DFF};
                pg8::gemm_phase<pg8::EpiSwiGlu, pg8::StaticOrder, true, true>(F.lds, g, S, E); }
            PH_END;
            if (PH_ON) { PH_LOCALS; pg8::Gemm g{(const bf16*)(ws + WS_ACT), (const bf16*)(ws + WS_WD) + (size_t)(li * 2 + f) * DM * DFF, SEQ, DM, DFF}; pg8::StaticOrder S; S.init(SEQ, DM, F.G, (int)blockIdx.x);
                pg8::EpiResGate E{xcur, xout, md + (3 * sub + 2) * DM, 0.5f, DM};
                pg8::gemm_phase<pg8::EpiResGate, pg8::StaticOrder, true, true>(F.lds, g, S, E); }
            PH_END;
            if (f_ == 1) break;
            if (PH_ON) { PH_LOCALS; norm_phase(F, xout, ng + 1 * DM, md + 3 * DM, md + 4 * DM, (bf16*)(ws + WS_H)); }
            PH_END;
            if (PH_ON) { PH_LOCALS; pg8::Gemm g{(const bf16*)(ws + WS_H), (const bf16*)(ws + WS_WIN) + (size_t)li * INW * DM, SEQ, INW, DM}; pg8::StaticOrder S; S.init(SEQ, INW, F.G, (int)blockIdx.x);
                pg8::EpiWin E{(bf16*)(ws + WS_Q), (bf16*)(ws + WS_K), (bf16*)(ws + WS_V), (bf16*)(ws + WS_U), inp(14) + li * 64, inp(15) + li * 64, attn_body::C2};
                pg8::gemm_phase<pg8::EpiWin, pg8::StaticOrder, true, true>(F.lds, g, S, E); }
            PH_END;
#define SSM_PARAMS SsmP P{inp(21) + (size_t)li * NG * NP, inp(22) + (size_t)li * NG * NP, inp(23) + li * NG, inp(24) + (size_t)li * NG * NP * HC, inp(25) + (size_t)li * NG * NP * HC, \
                   inp(26) + (size_t)li * NG * HC * NP, inp(27) + (size_t)li * NG * HC * NP, inp(28) + li * NG * HC}
            if (PH_ON) { PH_LOCALS;
#ifndef NO_ATTN
                { const attn_body::AttnTensors AT{(const attn_body::bf16*)(ws + WS_Q), (const attn_body::bf16*)(ws + WS_K), (const attn_body::bf16*)(ws + WS_V), (attn_body::bf16*)(ws + WS_OP), (const float*)(ws + WS_BIASD)};
                  attn_body::attn_phase<8>((char*)lds, AT, F.vcu); }
#endif
#ifndef NO_SSM
                { SSM_PARAMS; ssm_pass1(F, P, (const bf16*)(ws + WS_U), (float*)(ws + WS_XEND)); }
#endif
                }
            PH_END;
            if (PH_ON) { PH_LOCALS; combine_phase(F, (const bf16*)(ws + WS_OP), (bf16*)(ws + WS_CAT), inp(16) + li * 64, inp(17) + li * 64, inp(18) + li * 64, inp(19) + li * 64, inp(20) + li * 128, li == 0 ? 0.2f : 0.35550906759096924f);
#ifndef NO_SSM
                { SSM_PARAMS; ssm_pass2(F, P, (const bf16*)(ws + WS_U), (const float*)(ws + WS_XEND), (bf16*)(ws + WS_YG)); }
#endif
                }
            PH_END;
            if (PH_ON) { PH_LOCALS; pg8::Gemm g{(const bf16*)(ws + WS_YG), (const bf16*)(ws + WS_WGLU) + (size_t)li * SW * SW, SEQ, SW, SW}; pg8::StaticOrder S; S.init(SEQ, SW, F.G, (int)blockIdx.x);
                pg8::EpiGlu E{(const bf16*)(ws + WS_YG), (bf16*)(ws + WS_CAT), inp(30) + li * SW};
                pg8::gemm_phase<pg8::EpiGlu, pg8::StaticOrder, true, true>(F.lds, g, S, E); }
            PH_END;
            if (PH_ON) { PH_LOCALS; pg8::Gemm g{(const bf16*)(ws + WS_CAT), (const bf16*)(ws + WS_WOUT) + (size_t)li * DM * DM, SEQ, DM, DM}; pg8::StaticOrder S; S.init(SEQ, DM, F.G, (int)blockIdx.x);
                pg8::EpiResGate E{xout, xout, md + 5 * DM, 1.0f, DM};
                pg8::gemm_phase<pg8::EpiResGate, pg8::StaticOrder, true, true>(F.lds, g, S, E); }
            PH_END;
        }
    }
#undef PH_ON
#undef PH_END
#undef PH_LOCALS
#undef SSM_PARAMS
}

extern "C" void kernel_launch(void* const* d_in, const int* in_sizes, int n_in, void* d_out, int out_size, void* d_ws, size_t ws_size, hipStream_t stream) {
    static int grid = 0;
    if (grid == 0) {
        if (n_in != 31 || in_sizes[0] != SEQ * DM || out_size != SEQ * DM || ws_size < WS_END) { fprintf(stderr, "kernel_launch: unexpected shapes (n_in %d, in0 %d, out %d, ws %zu < %zu?); nothing launched\n", n_in, n_in > 0 ? in_sizes[0] : -1, out_size, ws_size, (size_t)WS_END); grid = -1; return; }
        int dev = 0, cus = 0, per_cu = 0;
        if (hipGetDevice(&dev) != hipSuccess || hipDeviceGetAttribute(&cus, hipDeviceAttributeMultiprocessorCount, dev) != hipSuccess) { fprintf(stderr, "kernel_launch: device query failed\n"); grid = -1; return; }
        if (hipFuncSetAttribute((const void*)mega_fwd, hipFuncAttributeMaxDynamicSharedMemorySize, LDS_BYTES) != hipSuccess) { fprintf(stderr, "kernel_launch: hipFuncSetAttribute failed\n"); grid = -1; return; }
        if (hipOccupancyMaxActiveBlocksPerMultiprocessor(&per_cu, (const void*)mega_fwd, NWAVES * 64, LDS_BYTES) != hipSuccess || per_cu < 1) { fprintf(stderr, "kernel_launch: occupancy query says %d\n", per_cu); per_cu = 1; }
        (void)hipGetLastError();
        grid = cus;
        if (grid != 256) { fprintf(stderr, "kernel_launch: built for a 256-CU device, got %d\n", grid); grid = -1; return; }
    }
    if (grid < 0) return;
    if (hipMemsetAsync((char*)d_ws + WS_CTL, 0, CTL_ZERO_BYTES, stream) != hipSuccess) { fprintf(stderr, "kernel_launch: memset failed\n"); return; }
    Args a{};
    for (int i = 0; i < 31; ++i) a.in.p[i] = (const float*)d_in[i];
    a.out = (float*)d_out; a.ws = (unsigned char*)d_ws;
#if MK_ONE_LAUNCH
    a.ph_lo = 0; a.ph_hi = N_PHASES;
    void* kargs[] = {&a};
    hipError_t e = hipLaunchCooperativeKernel((const void*)mega_fwd, dim3(grid), dim3(NWAVES * 64), kargs, LDS_BYTES, stream);
    if (e != hipSuccess) fprintf(stderr, "kernel_launch: cooperative launch failed: %s\n", hipGetErrorString(e));
#else
    for (int ph = 0; ph < N_PHASES; ++ph) { a.ph_lo = ph; a.ph_hi = ph + 1;
        hipLaunchKernelGGL(mega_fwd, dim3(grid), dim3(NWAVES * 64), LDS_BYTES, stream, a);
        const hipError_t le = hipPeekAtLastError();
        if (le != hipSuccess) { fprintf(stderr, "kernel_launch: launch %d failed: %s\n", ph, hipGetErrorName(le)); break; } }
#endif
}
```

```cpp
#include <hip/hip_runtime.h>
#include <hip/hip_cooperative_groups.h>
#include <cstdio>
#include <cstdint>
namespace cg = cooperative_groups;
#ifndef MK_ONE_LAUNCH
#define MK_ONE_LAUNCH 1
#endif
namespace pg8 {
#define PG8_LAS __attribute__((address_space(3)))
typedef unsigned short bf16_t;
typedef short bf16x8 __attribute__((ext_vector_type(8)));
typedef float f32x4 __attribute__((ext_vector_type(4)));
typedef unsigned u32x4 __attribute__((ext_vector_type(4)));
constexpr int BM = 256, BK = 64, HALF = 128, HTB = HALF * BK * 2  , STAGE_BYTES = 8 * HTB, NXCD = 8, WGM = 8;

__host__ __device__ __forceinline__ int lds_byte(int r, int c) { const int st = (r >> 4) * 2 + (c >> 5), rr = r & 15, cc = c & 31, ob = rr * 64 + cc * 2; return st * 1024 + (ob ^ (((ob >> 9) & 1) << 5)); }
__host__ __device__ __forceinline__ void stage_rc(int b, int& R, int& C) { const int st = b / 1024, sb = b % 1024, swz = sb ^ (((sb >> 9) & 1) << 5); R = (st >> 1) * 16 + swz / 64; C = (st & 1) * 32 + (swz % 64) / 2; }
__host__ __device__ __forceinline__ int perm32(int rho) { const int n = rho >> 4, i = rho & 15; return 8 * (i >> 2) + 4 * n + (i & 3); }

struct Unit { int pm, pn; };
struct Gemm { const bf16_t* A; const bf16_t* Bt; int M, N, K; };

struct StaticOrder {
    int nM, nN, nwg, G, c;
    __host__ __device__ void init(int M, int N, int G_, int c_) { nM = M / BM; nN = N / BM; nwg = nM * nN; G = G_; c = c_; }
    __host__ __device__ bool next(int i, Unit& u) const {
        const long L = (long)i * G + c; if (L >= nwg) return false;
        int wgid = (int)L; { const int q = nwg / NXCD, r = nwg % NXCD, xcd = wgid % NXCD, off = wgid / NXCD; wgid = (xcd < r ? xcd * (q + 1) : r * (q + 1) + (xcd - r) * q) + off; }
        const int nig = WGM * nN, gid = wgid / nig, fm = gid * WGM, gsz = (nM - fm) < WGM ? (nM - fm) : WGM;
        u.pm = fm + ((wgid % nig) % gsz); u.pn = (wgid % nig) / gsz; return true;
    }
    __device__ __forceinline__ void a_ready(const Unit&) const {}
    __device__ __forceinline__ void done(const Unit&) const {}
};

__device__ __forceinline__ unsigned cvt_pk_bf16(float lo, float hi) { unsigned r; asm volatile("v_cvt_pk_bf16_f32 %0, %1, %2" : "=v"(r) : "v"(lo), "v"(hi)); return r; }
typedef float f32x2 __attribute__((ext_vector_type(2)));
__device__ __forceinline__ float sigmoid_f(float v) { return __builtin_amdgcn_rcpf(1.0f + __builtin_amdgcn_exp2f(-1.4426950408889634f * v)); }
struct EpiSwiGlu {
    static constexpr bool PERM = true, AFTER_DRAIN = false;
    bf16_t* O; int ldc;
    __device__ __forceinline__ void operator()(const f32x4 (&acc)[2][2][4][2], const Unit& u, int wr, int wc, int fr, int fq) const {
        const int row0 = u.pm * BM + wr * 64 + fr, col0 = u.pn * HALF + wc * 32 + 8 * fq;
#pragma unroll
        for (int ai = 0; ai < 2; ++ai)
#pragma unroll
            for (int m = 0; m < 4; ++m) { bf16_t* rowp = O + (size_t)(row0 + ai * HALF + m * 16) * ldc + col0;
                const f32x4 g0 = acc[ai][0][m][0], g1 = acc[ai][0][m][1], u0 = acc[ai][1][m][0], u1 = acc[ai][1][m][1];
                float v[8];
#pragma unroll
                for (int i = 0; i < 4; ++i) { v[i] = g0[i] * sigmoid_f(g0[i]) * u0[i]; v[4 + i] = g1[i] * sigmoid_f(g1[i]) * u1[i]; }
                u32x4 w; w.x = cvt_pk_bf16(v[0], v[1]); w.y = cvt_pk_bf16(v[2], v[3]); w.z = cvt_pk_bf16(v[4], v[5]); w.w = cvt_pk_bf16(v[6], v[7]);
                *(u32x4*)rowp = w; }
    }
};
struct EpiResGate {
    static constexpr bool PERM = false, AFTER_DRAIN = false;
    const float* xin; float* xout; const float* gate; float coef; int ldc;
    __device__ __forceinline__ void operator()(const f32x4 (&acc)[2][2][4][2], const Unit& u, int wr, int wc, int fr, int fq) const {
        const int row0 = u.pm * BM + wr * 64 + fr, col0 = u.pn * BM + wc * 32 + 4 * fq;
        f32x4 gv[2][2];
#pragma unroll
        for (int bj = 0; bj < 2; ++bj)
#pragma unroll
            for (int n = 0; n < 2; ++n) gv[bj][n] = *(const f32x4*)(gate + col0 + bj * HALF + n * 16) * coef;
#pragma unroll
        for (int ai = 0; ai < 2; ++ai)
#pragma unroll
            for (int m = 0; m < 4; ++m) { const size_t off = (size_t)(row0 + ai * HALF + m * 16) * ldc + col0;
#pragma unroll
                for (int bj = 0; bj < 2; ++bj)
#pragma unroll
                    for (int n = 0; n < 2; ++n) { const f32x4 xi = *(const f32x4*)(xin + off + bj * HALF + n * 16);
                        *(f32x4*)(xout + off + bj * HALF + n * 16) = xi + gv[bj][n] * acc[ai][bj][m][n]; }
                if (m & 1) asm volatile("" ::: "memory"); }
    }
};
struct EpiWin {
    static constexpr bool PERM = true, AFTER_DRAIN = false;
    bf16_t *Q, *K, *V, *U; const float *qg, *kg; float qscale;
    __device__ __forceinline__ void operator()(const f32x4 (&acc)[2][2][4][2], const Unit& u, int wr, int wc, int fr, int fq) const {
        const int sec = u.pn >> 2, tile = u.pn & 3; const int row0 = u.pm * BM + wr * 64 + fr;
        if (sec < 2) {
            const float* gn = sec == 0 ? qg : kg; const float sc = sec == 0 ? qscale : 1.0f;
            bf16_t* base = sec == 0 ? Q : K;
            f32x4 gv[2][2];
#pragma unroll
            for (int bj = 0; bj < 2; ++bj)
#pragma unroll
                for (int n = 0; n < 2; ++n) gv[bj][n] = *(const f32x4*)(gn + 32 * bj + 8 * fq + 4 * n) * sc;
            const int col0 = tile * 256 + wc * 64 + 8 * fq;
#pragma unroll
            for (int ai = 0; ai < 2; ++ai)
#pragma unroll
                for (int m = 0; m < 4; ++m) {
                    float ss = 0.f;
#pragma unroll
                    for (int bj = 0; bj < 2; ++bj)
#pragma unroll
                        for (int n = 0; n < 2; ++n) { const f32x4 x = acc[ai][bj][m][n]; ss += (x[0] * x[0] + x[1] * x[1]) + (x[2] * x[2] + x[3] * x[3]); }
                    ss += __shfl_xor(ss, 16); ss += __shfl_xor(ss, 32);
                    const float r = __builtin_amdgcn_rsqf(ss * (1.0f / 64.0f) + 1e-6f);
                    bf16_t* rowp = base + (size_t)(row0 + ai * HALF + m * 16) * 1024 + col0;
#pragma unroll
                    for (int bj = 0; bj < 2; ++bj) { const f32x4 v0 = acc[ai][bj][m][0] * gv[bj][0] * r, v1 = acc[ai][bj][m][1] * gv[bj][1] * r;
                        u32x4 w; w.x = cvt_pk_bf16(v0[0], v0[1]); w.y = cvt_pk_bf16(v0[2], v0[3]); w.z = cvt_pk_bf16(v1[0], v1[1]); w.w = cvt_pk_bf16(v1[2], v1[3]);
                        *(u32x4*)(rowp + 32 * bj) = w; }
                }
        } else {
            bf16_t* base = sec == 2 ? V : U; const int col0 = tile * 256 + wc * 32 + 8 * fq;
#pragma unroll
            for (int ai = 0; ai < 2; ++ai)
#pragma unroll
                for (int m = 0; m < 4; ++m) { bf16_t* rowp = base + (size_t)(row0 + ai * HALF + m * 16) * 1024 + col0;
#pragma unroll
                    for (int bj = 0; bj < 2; ++bj) { const f32x4 v0 = acc[ai][bj][m][0], v1 = acc[ai][bj][m][1];
                        u32x4 w; w.x = cvt_pk_bf16(v0[0], v0[1]); w.y = cvt_pk_bf16(v0[2], v0[3]); w.z = cvt_pk_bf16(v1[0], v1[1]); w.w = cvt_pk_bf16(v1[2], v1[3]);
                        *(u32x4*)(rowp + HALF * bj) = w; } }
        }
    }
};
__device__ __forceinline__ float bf_lo(unsigned w) { return __uint_as_float(w << 16); }
__device__ __forceinline__ float bf_hi(unsigned w) { return __uint_as_float(w & 0xffff0000u); }
struct EpiGlu {
    static constexpr bool PERM = true, AFTER_DRAIN = false;
    const bf16_t* YG; bf16_t* CAT; const float* bias;
    __device__ __forceinline__ void operator()(const f32x4 (&acc)[2][2][4][2], const Unit& u, int wr, int wc, int fr, int fq) const {
        const int row0 = u.pm * BM + wr * 64 + fr, col0 = u.pn * BM + wc * 32 + 8 * fq;
        f32x4 bv[2][2];
#pragma unroll
        for (int bj = 0; bj < 2; ++bj)
#pragma unroll
            for (int n = 0; n < 2; ++n) bv[bj][n] = *(const f32x4*)(bias + col0 + bj * HALF + 4 * n);
#pragma unroll
        for (int ai = 0; ai < 2; ++ai)
#pragma unroll
            for (int m = 0; m < 4; ++m) { const size_t row = (size_t)(row0 + ai * HALF + m * 16);
#pragma unroll
                for (int bj = 0; bj < 2; ++bj) { const f32x4 z0 = acc[ai][bj][m][0] + bv[bj][0], z1 = acc[ai][bj][m][1] + bv[bj][1];
                    const u32x4 y = *(const u32x4*)(YG + row * 1024 + col0 + bj * HALF);
                    u32x4 w;
                    w.x = cvt_pk_bf16(bf_lo(y.x) * sigmoid_f(z0[0]), bf_hi(y.x) * sigmoid_f(z0[1])); w.y = cvt_pk_bf16(bf_lo(y.y) * sigmoid_f(z0[2]), bf_hi(y.y) * sigmoid_f(z0[3]));
                    w.z = cvt_pk_bf16(bf_lo(y.z) * sigmoid_f(z1[0]), bf_hi(y.z) * sigmoid_f(z1[1])); w.w = cvt_pk_bf16(bf_lo(y.w) * sigmoid_f(z1[2]), bf_hi(y.w) * sigmoid_f(z1[3]));
                    *(u32x4*)(CAT + row * 2048 + 1024 + col0 + bj * HALF) = w; } }
    }
};

template <class Epi, class Sched, bool ALIGN_EPI = false, bool SP2 = false>
__device__ __forceinline__ void gemm_phase(PG8_LAS unsigned char* lds, const Gemm g, const Sched& S, const Epi& E) {
    int tid_ = threadIdx.x; asm volatile("" : "+v"(tid_));
    const int tid = tid_, wid = __builtin_amdgcn_readfirstlane(tid >> 6), lane = tid & 63, wr = wid >> 2, wc = wid & 3, fr = lane & 15, fq = lane >> 4;
    const int K = g.K, nt = K / BK;
    unsigned voffA[2], voffB[2];
#pragma unroll
    for (int i = 0; i < 2; ++i) { int R, C; stage_rc(tid * 16 + i * 8192, R, C); const int Rb = Epi::PERM ? ((R & ~31) + perm32(R & 31)) : R;
        voffA[i] = (unsigned)(R * K + C) * 2u; voffB[i] = (unsigned)(Rb * K + C) * 2u; }
    const size_t kstep = (size_t)(BK * 2);
    const size_t hstep = (size_t)HALF * K * 2;
    const size_t tstep = 2 * hstep;
    const unsigned ldsw = (unsigned)wid * 1024u;
    const int aoff = lds_byte(wr * 64 + fr, fq * 8), boff = lds_byte(wc * 32 + fr, fq * 8);
#define PG8_SA(b, h) (((b) * 2 + (h)) * HTB)
#define PG8_SB(b, h) ((4 + (b) * 2 + (h)) * HTB)
#define PG8_STAGE(bufoff, gbase, voff) do { _Pragma("unroll") for (int _i = 0; _i < 2; ++_i) \
        __builtin_amdgcn_global_load_lds((const unsigned*)((const char*)(gbase) + (voff)[_i]), (PG8_LAS unsigned*)(lds + (bufoff) + ldsw + _i * 8192), 16, 0, 0); } while (0)
#define PG8_LDA(dst, b, h) do { _Pragma("unroll") for (int m = 0; m < 4; ++m) _Pragma("unroll") for (int k = 0; k < 2; ++k) dst[m][k] = *(const PG8_LAS bf16x8*)(lds + PG8_SA(b, h) + aoff + m * 2048 + k * 1024); } while (0)
#define PG8_LDB(dst, b, h) do { _Pragma("unroll") for (int n = 0; n < 2; ++n) _Pragma("unroll") for (int k = 0; k < 2; ++k) dst[n][k] = *(const PG8_LAS bf16x8*)(lds + PG8_SB(b, h) + boff + n * 2048 + k * 1024); } while (0)
#define PG8_MMA(ai, bj, At, Bt) do { __builtin_amdgcn_s_setprio(1); _Pragma("unroll") for (int m = 0; m < 4; ++m) _Pragma("unroll") for (int n = 0; n < 2; ++n) _Pragma("unroll") for (int k = 0; k < 2; ++k) \
        acc[ai][bj][m][n] = __builtin_amdgcn_mfma_f32_16x16x32_bf16(Bt[n][k], At[m][k], acc[ai][bj][m][n], 0, 0, 0); __builtin_amdgcn_s_setprio(0); } while (0)
#define PG8_WAIT_V(n) asm volatile("s_waitcnt vmcnt(" #n ")" ::: "memory")
#define PG8_WAIT_L(n) asm volatile("s_waitcnt lgkmcnt(" #n ")" ::: "memory")
#define PG8_BAR __builtin_amdgcn_s_barrier()
#define PG8_SCHED __builtin_amdgcn_sched_barrier(0)
    Unit cur, nxt; int ui = 0;
    if (!S.next(0, cur)) return;
    f32x4 acc[2][2][4][2];
#pragma unroll
    for (int a = 0; a < 2; ++a)
#pragma unroll
        for (int b = 0; b < 2; ++b)
#pragma unroll
            for (int m = 0; m < 4; ++m)
#pragma unroll
                for (int n = 0; n < 2; ++n) acc[a][b][m][n] = (f32x4){0.f, 0.f, 0.f, 0.f};
    bf16x8 At[4][2], B0[2][2], B1[2][2];
    const char* cA = (const char*)g.A + (size_t)cur.pm * tstep; const char* cB = (const char*)g.Bt + (size_t)cur.pn * tstep;
    S.a_ready(cur);
    if constexpr (SP2) {
        PG8_STAGE(PG8_SB(0, 0), cB, voffB); PG8_STAGE(PG8_SB(0, 1), cB + hstep, voffB); PG8_STAGE(PG8_SA(0, 0), cA, voffA); PG8_STAGE(PG8_SA(0, 1), cA + hstep, voffA);
        if (wr == 1) PG8_BAR;
        PG8_WAIT_V(2); PG8_BAR;
        PG8_STAGE(PG8_SB(1, 0), cB + kstep, voffB); PG8_STAGE(PG8_SA(1, 0), cA + kstep, voffA); PG8_STAGE(PG8_SB(1, 1), cB + hstep + kstep, voffB);
        PG8_WAIT_V(6); PG8_BAR;
    } else {
        PG8_STAGE(PG8_SB(0, 0), cB, voffB); PG8_STAGE(PG8_SA(0, 0), cA, voffA); PG8_STAGE(PG8_SB(0, 1), cB + hstep, voffB); PG8_STAGE(PG8_SA(0, 1), cA + hstep, voffA);
        if (wr == 1) PG8_BAR;
        PG8_WAIT_V(4); PG8_BAR;
        PG8_STAGE(PG8_SB(1, 0), cB + kstep, voffB); PG8_STAGE(PG8_SA(1, 0), cA + kstep, voffA); PG8_STAGE(PG8_SB(1, 1), cB + hstep + kstep, voffB);
        PG8_WAIT_V(6); PG8_BAR;
    }
    for (;;) {
        const bool has_next = S.next(ui + 1, nxt);
        const char* nA = has_next ? (const char*)g.A + (size_t)nxt.pm * tstep : cA; const char* nB = has_next ? (const char*)g.Bt + (size_t)nxt.pn * tstep : cB;
        for (int t = 0; t < nt; t += 2) {
            const bool last = (t == nt - 2);
            const char* a1 = cA + (size_t)(t + 1) * kstep;
            const char* a2 = last ? nA : cA + (size_t)(t + 2) * kstep; const char* b2 = last ? nB : cB + (size_t)(t + 2) * kstep;
            const char* a3 = a2 + kstep; const char* b3 = b2 + kstep;
            if (last && has_next) S.a_ready(nxt);
            if constexpr (SP2) {
            PG8_LDB(B0, 0, 0); PG8_LDB(B1, 0, 1); PG8_SCHED; PG8_LDA(At, 0, 0); PG8_STAGE(PG8_SA(1, 1), a1 + hstep, voffA);
            PG8_WAIT_V(8); PG8_WAIT_L(0); PG8_BAR; PG8_MMA(0, 0, At, B0); PG8_MMA(0, 1, At, B1); PG8_BAR; PG8_SCHED;
            PG8_LDA(At, 0, 1); PG8_STAGE(PG8_SB(0, 0), b2, voffB); PG8_STAGE(PG8_SB(0, 1), b2 + hstep, voffB); PG8_STAGE(PG8_SA(0, 0), a2, voffA);
            PG8_WAIT_V(8); PG8_WAIT_L(0); PG8_BAR; PG8_MMA(1, 0, At, B0); PG8_MMA(1, 1, At, B1); PG8_BAR; PG8_SCHED;
            PG8_LDB(B0, 1, 0); PG8_LDB(B1, 1, 1); PG8_SCHED; PG8_LDA(At, 1, 0); PG8_STAGE(PG8_SA(0, 1), a2 + hstep, voffA);
            PG8_WAIT_V(8); PG8_WAIT_L(0); PG8_BAR; PG8_MMA(0, 0, At, B0); PG8_MMA(0, 1, At, B1); PG8_BAR; PG8_SCHED;
            PG8_LDA(At, 1, 1); PG8_STAGE(PG8_SB(1, 0), b3, voffB); PG8_STAGE(PG8_SB(1, 1), b3 + hstep, voffB); PG8_STAGE(PG8_SA(1, 0), a3, voffA);
            PG8_WAIT_V(8); PG8_WAIT_L(0); PG8_BAR; PG8_MMA(1, 0, At, B0); PG8_MMA(1, 1, At, B1); PG8_BAR; PG8_SCHED;
            } else {
            PG8_LDB(B0, 0, 0); PG8_SCHED; PG8_LDA(At, 0, 0); PG8_STAGE(PG8_SA(1, 1), a1 + hstep, voffA);
            PG8_WAIT_L(8); PG8_BAR; PG8_WAIT_L(0); PG8_MMA(0, 0, At, B0); PG8_BAR; PG8_SCHED;
            PG8_LDB(B1, 0, 1); PG8_STAGE(PG8_SB(0, 0), b2, voffB);
            PG8_BAR; PG8_WAIT_L(0); PG8_MMA(0, 1, At, B1); PG8_BAR;
            PG8_LDA(At, 0, 1); PG8_STAGE(PG8_SA(0, 0), a2, voffA);
            PG8_BAR; PG8_WAIT_L(0); PG8_MMA(1, 0, At, B0); PG8_BAR; PG8_SCHED;
            PG8_STAGE(PG8_SB(0, 1), b2 + hstep, voffB);
            PG8_WAIT_V(6); PG8_BAR; PG8_MMA(1, 1, At, B1); PG8_BAR;
            PG8_LDB(B0, 1, 0); PG8_SCHED; PG8_LDA(At, 1, 0); PG8_STAGE(PG8_SA(0, 1), a2 + hstep, voffA);
            PG8_WAIT_L(8); PG8_BAR; PG8_WAIT_L(0); PG8_MMA(0, 0, At, B0); PG8_BAR; PG8_SCHED;
            PG8_LDB(B1, 1, 1); PG8_STAGE(PG8_SB(1, 0), b3, voffB);
            PG8_BAR; PG8_WAIT_L(0); PG8_MMA(0, 1, At, B1); PG8_BAR;
            PG8_LDA(At, 1, 1); PG8_STAGE(PG8_SA(1, 0), a3, voffA);
            PG8_BAR; PG8_WAIT_L(0); PG8_MMA(1, 0, At, B0); PG8_BAR; PG8_SCHED;
            PG8_STAGE(PG8_SB(1, 1), b3 + hstep, voffB);
            PG8_WAIT_V(6); PG8_BAR; PG8_MMA(1, 1, At, B1); PG8_BAR;
            }
        }
        if constexpr (ALIGN_EPI) { if (wr == 0) PG8_BAR; }
        if constexpr (!Epi::AFTER_DRAIN) { E(acc, cur, wr, wc, fr, fq); S.done(cur); }
        if (!has_next) break;
#pragma unroll
        for (int a = 0; a < 2; ++a)
#pragma unroll
            for (int b = 0; b < 2; ++b)
#pragma unroll
                for (int m = 0; m < 4; ++m)
#pragma unroll
                    for (int n = 0; n < 2; ++n) acc[a][b][m][n] = (f32x4){0.f, 0.f, 0.f, 0.f};
        cur = nxt; cA = nA; cB = nB; ++ui;
        if constexpr (ALIGN_EPI) { if (wr == 1) PG8_BAR; }
    }
    PG8_WAIT_V(0);
    if constexpr (!ALIGN_EPI) { if (wr == 0) PG8_BAR; }
    PG8_BAR;
    if constexpr (Epi::AFTER_DRAIN) { E.fused(acc, cur, wr, wc, fr, fq, lds, wid, lane); S.done(cur); }
#undef PG8_SA
#undef PG8_SB
#undef PG8_STAGE
#undef PG8_LDA
#undef PG8_LDB
#undef PG8_MMA
#undef PG8_WAIT_V
#undef PG8_WAIT_L
#undef PG8_BAR
#undef PG8_SCHED
}
}
#include <hip/hip_bf16.h>
#include <cmath>
namespace attn_body {
using bf16=__hip_bfloat16;
using bf16x8=__attribute__((ext_vector_type(8)))short;
using s16x4=__attribute__((ext_vector_type(4)))short;
using f32x16=__attribute__((ext_vector_type(16)))float;
using u32x4=__attribute__((ext_vector_type(4)))unsigned;
constexpr int SEQ=8192,D=64,DM=1024,OPITCH=2048;
constexpr int NW=8,QBLK=32,QB=QBLK*NW,KVBLK=64,NQB=SEQ/QB;
constexpr int ATTN_PITCH=DM, ATTN_UNIT_ROWS=QB;
__device__ __forceinline__ int crow(int r,int hi){return (r&3)+8*(r>>2)+4*hi;}
#define SBAR() __builtin_amdgcn_sched_barrier(0)
typedef const __attribute__((address_space(3))) float* lds_cfptr;
__device__ __forceinline__ void cmask(f32x16&p0,f32x16&p1,int jb,int qrel,int hi,lds_cfptr bt){
  const float NEG=-INFINITY; int kb=64*jb+4*hi;
  #pragma unroll
  for(int r=0;r<16;++r){int kv=kb+(r&3)+8*(r>>2); int d0=qrel-kv, d1=d0-32;
    unsigned i0=(unsigned)d0<127u?(unsigned)d0:127u, i1=(unsigned)d1<127u?(unsigned)d1:127u;
    float b0=bt[i0], b1=bt[i1];
    p0[r]=(d0<0)?NEG:p0[r]+b0; p1[r]=(d1<0)?NEG:p1[r]+b1;}
}

constexpr int NSLOT=3, SLOTB=8192;
constexpr int LDS_K=0, LDS_V=NSLOT*SLOTB, LDS_WS=2*NSLOT*SLOTB, LDS_OST=LDS_WS+NW*64*4, LDS_BT=LDS_OST+NW*4096, LDS_BYTES=LDS_BT+512;
constexpr float C2=0.125f*1.4426950408889634f;
__device__ __forceinline__ void glds16(const void*gsrc,unsigned lds_dst){unsigned keep;
  asm volatile("s_mov_b32 %0, m0\n\ts_mov_b32 m0, %2\n\ts_nop 0\n\tglobal_load_lds_dwordx4 %1, off\n\ts_mov_b32 m0, %0":"=&s"(keep):"v"(gsrc),"s"(lds_dst):"memory");}
__device__ __forceinline__ float max3f(float a,float b,float c){float r;asm("v_max3_f32 %0, %1, %2, %3":"=v"(r):"v"(a),"v"(b),"v"(c));return r;}
__device__ __forceinline__ float max2f(float a,float b){float r;asm("v_max_f32_e32 %0, %1, %2":"=v"(r):"v"(a),"v"(b));return r;}
__device__ __forceinline__ float fadd_s(float a,float b){float r;asm("v_add_f32_e32 %0, %1, %2":"=v"(r):"v"(a),"v"(b));return r;}
__device__ __forceinline__ float fsub_s(float a,float b){float r;asm("v_sub_f32_e32 %0, %1, %2":"=v"(r):"v"(a),"v"(b));return r;}
typedef float f32x2_t __attribute__((ext_vector_type(2))); typedef __bf16 bf16x2_t __attribute__((ext_vector_type(2)));
__device__ __forceinline__ unsigned cvtpk_s(float lo,float hi){f32x2_t v={lo,hi};bf16x2_t b=__builtin_convertvector(v,bf16x2_t);return __builtin_bit_cast(unsigned,b);}
#define WAIT_BAR(N) asm volatile("s_waitcnt vmcnt(" #N ") lgkmcnt(0)\n\ts_barrier":::"memory")

__device__ __forceinline__ void qkt(f32x16&p0,f32x16&p1,const char*Kslot,const bf16x8*qr,const f32x16&negm,int r32,int hi){
  const char*kb=Kslot+hi*1024+r32*16;
  #pragma unroll
  for(int d0=0;d0<4;++d0){
    const bf16x8 b0=*reinterpret_cast<const bf16x8*>(kb+d0*2048);
    const bf16x8 b1=*reinterpret_cast<const bf16x8*>(kb+d0*2048+512);
    if(d0==0){p0=__builtin_amdgcn_mfma_f32_32x32x16_bf16(b0,qr[0],negm,0,0,0);p1=__builtin_amdgcn_mfma_f32_32x32x16_bf16(b1,qr[0],negm,0,0,0);}
    else{p0=__builtin_amdgcn_mfma_f32_32x32x16_bf16(b0,qr[d0],p0,0,0,0);p1=__builtin_amdgcn_mfma_f32_32x32x16_bf16(b1,qr[d0],p1,0,0,0);}}
}
typedef __attribute__((address_space(3))) const char* lds_cptr;
typedef short v4i16_t __attribute__((ext_vector_type(4)));
__device__ __forceinline__ void kload8(bf16x8*kf,lds_cptr kp){
  kf[0]=*(const __attribute__((address_space(3))) bf16x8*)(kp);      kf[1]=*(const __attribute__((address_space(3))) bf16x8*)(kp+512);
  kf[2]=*(const __attribute__((address_space(3))) bf16x8*)(kp+2048); kf[3]=*(const __attribute__((address_space(3))) bf16x8*)(kp+2560);
  kf[4]=*(const __attribute__((address_space(3))) bf16x8*)(kp+4096); kf[5]=*(const __attribute__((address_space(3))) bf16x8*)(kp+4608);
  kf[6]=*(const __attribute__((address_space(3))) bf16x8*)(kp+6144); kf[7]=*(const __attribute__((address_space(3))) bf16x8*)(kp+6656);
}
__device__ __forceinline__ void kload2(bf16x8*kf,lds_cptr kp,int j){ kf[2*j]=*(const __attribute__((address_space(3))) bf16x8*)(kp+j*2048); kf[2*j+1]=*(const __attribute__((address_space(3))) bf16x8*)(kp+j*2048+512); }
__device__ __forceinline__ s16x4 vtr(lds_cptr p){ return __builtin_bit_cast(s16x4,__builtin_amdgcn_ds_read_tr16_b64_v4i16((__attribute__((address_space(3))) v4i16_t*)p)); }
__device__ __forceinline__ float rowmax(const f32x16&p0,const f32x16&p1){
  float a=max3f(p0[0],p0[1],p1[0]),b=max3f(p0[2],p0[3],p1[1]);a=max3f(a,p1[2],p1[3]);
  #pragma unroll
  for(int r=4;r<16;r+=4){a=max3f(a,p0[r],p0[r+1]);b=max3f(b,p0[r+2],p0[r+3]);a=max3f(a,p1[r],p1[r+1]);b=max3f(b,p1[r+2],p1[r+3]);}
  const float m=max2f(a,b);
  auto rr=__builtin_amdgcn_permlane32_swap(__float_as_uint(m),__float_as_uint(m),false,false);
  return max2f(__uint_as_float(rr[0]),__uint_as_float(rr[1]));
}
__device__ __forceinline__ void pv(f32x16*o,int vb,bf16x8 pa0,bf16x8 pa1,bf16x8 pa2,bf16x8 pa3){
  #pragma unroll
  for(int d0=0;d0<2;++d0){s16x4 lo[4],hi[4];
    #pragma unroll
    for(int ks=0;ks<4;++ks){
      asm volatile("ds_read_b64_tr_b16 %0,%1 offset:%c2":"=&v"(lo[ks]):"v"(vb),"i"(d0*4096+ks*1024):"memory");
      asm volatile("ds_read_b64_tr_b16 %0,%1 offset:%c2":"=&v"(hi[ks]):"v"(vb),"i"(d0*4096+ks*1024+512):"memory");}
    asm volatile("s_waitcnt lgkmcnt(0)":::"memory");SBAR();
    #define PK(k) (bf16x8){lo[k][0],lo[k][1],lo[k][2],lo[k][3],hi[k][0],hi[k][1],hi[k][2],hi[k][3]}
    o[d0]=__builtin_amdgcn_mfma_f32_32x32x16_bf16(pa0,PK(0),o[d0],0,0,0);
    o[d0]=__builtin_amdgcn_mfma_f32_32x32x16_bf16(pa1,PK(1),o[d0],0,0,0);
    o[d0]=__builtin_amdgcn_mfma_f32_32x32x16_bf16(pa2,PK(2),o[d0],0,0,0);
    o[d0]=__builtin_amdgcn_mfma_f32_32x32x16_bf16(pa3,PK(3),o[d0],0,0,0);
    #undef PK
  }
}

#ifndef ATTN_STORE16
#define ATTN_STORE16(p,v) (*(u32x4*)(p)=(v))
#endif
template<int THRL> __device__ __forceinline__ void attn_unit(int qcol,int vcol,int ocol,int hb,int qb,const bf16*Q,const bf16*K,const bf16*V,bf16*O,const float*biasd,char*shm){
  int tid_=threadIdx.x; asm volatile("":"+v"(tid_)); const int tid=tid_,lane=tid&63,r32=lane&31,hi=lane>>5; const int wid=__builtin_amdgcn_readfirstlane(tid>>6);
  const long rowbase=0; const int q0=qb*QB;
  const bf16*Qw=Q+(rowbase+q0+wid*QBLK)*DM+qcol;
  const bf16*Kh=K+rowbase*DM+qcol,*Vh=V+rowbase*DM+vcol;
  { __attribute__((address_space(3))) float* btw=(__attribute__((address_space(3))) float*)(lds_cptr)shm+LDS_BT/4; if(tid<128)btw[tid]=biasd[hb*128+tid]; }
  const lds_cfptr btab=(lds_cfptr)((lds_cptr)shm+LDS_BT);
  const unsigned lds0=(unsigned)(uintptr_t)shm;
  float*wsf=(float*)(shm+LDS_WS)+wid*64;
  const bf16*ksrc=Kh+(long)lane*DM+wid*8;
  const bf16*vsrc=Vh+(long)(16*(wid&3)+(lane>>2))*DM+(wid>>2)*32+(lane&3)*8;
  const unsigned kdst=lds0+LDS_K+wid*1024, vdst=lds0+LDS_V+wid*1024;
  #define DMA_K(t,slot) glds16(ksrc+(long)(t)*KVBLK*DM,(unsigned)__builtin_amdgcn_readfirstlane(kdst+(slot)))
  #define DMA_V(t,slot) glds16(vsrc+(long)(t)*KVBLK*DM,(unsigned)__builtin_amdgcn_readfirstlane(vdst+(slot)))
  const int vb0=(int)(lds0+LDS_V)+((lane>>4)&1)*32+(lane&3)*8+(4*hi+((lane&15)>>2))*64;
  const char*Kbase=shm+LDS_K; bf16x8 kf[8];
  const lds_cptr shm3=(lds_cptr)shm; const lds_cptr kp0=shm3+LDS_K+hi*1024+r32*16; const lds_cptr vp0=shm3+LDS_V+((lane>>4)&1)*32+(lane&3)*8+(4*hi+((lane&15)>>2))*64;
  const int NT=(q0+QB)/KVBLK;
  DMA_K(0,0);DMA_V(0,0);DMA_K(1,SLOTB);
  bf16x8 qr[4];
  #pragma unroll
  for(int d0=0;d0<4;++d0)qr[d0]=*reinterpret_cast<const bf16x8*>(&Qw[(long)r32*DM+d0*16+hi*8]);
  float mhat=0.f,l_reg=0.f;f32x16 o[2];o[0]=f32x16{};o[1]=f32x16{};f32x16 negm=f32x16{};asm volatile("":"+v"(negm));
  const int qrel=wid*QBLK+r32;
  #define CMASK(P0,P1,t) do{int jb_=(t)-(NT-4); if(jb_>=-2)cmask(P0,P1,jb_,qrel,hi,btab);}while(0)
  bool resc=false;
  #define START(P0,P1) do{ const float rm=rowmax(P0,P1); resc=false; \
    { const float dl=rm; mhat=fadd_s(mhat,dl); \
      _Pragma("unroll") for(int r=0;r<16;++r){P0[r]=fsub_s(P0[r],dl);P1[r]=fsub_s(P1[r],dl);} \
      _Pragma("unroll") for(int r=0;r<16;++r)negm[r]=-mhat; asm volatile("":"+v"(negm)); } \
    _Pragma("unroll") for(int r=0;r<16;++r)P0[r]=__builtin_amdgcn_exp2f(P0[r]); }while(0)
  #define RESC() do{ if(resc){ asm volatile("s_waitcnt lgkmcnt(0)":::"memory"); \
      _Pragma("unroll") for(int d_=0;d_<2;++d_) _Pragma("unroll") for(int r=0;r<16;++r)o[d_][r]*=wsf[crow(r,hi)]; } }while(0)
  f32x16 pA0,pA1,pB0,pB1;
  int sl_prev=0,sl_cur=0,sl_next=SLOTB;
  #define ROT() do{sl_prev=sl_cur;sl_cur=sl_next;sl_next=(sl_next==(NSLOT-1)*SLOTB)?0:sl_next+SLOTB;}while(0)
  DMA_K(2,2*SLOTB);
  WAIT_BAR(3);
  qkt(pA0,pA1,Kbase,qr,negm,r32,hi);asm volatile("s_nop 15\n\ts_nop 7":"+v"(pA0),"+v"(pA1));CMASK(pA0,pA1,0);
  START(pA0,pA1);
  _Pragma("unroll") for(int r=0;r<16;++r)pA1[r]=__builtin_amdgcn_exp2f(pA1[r]);
  WAIT_BAR(0);
  DMA_K(3,0);DMA_V(1,SLOTB);
  ROT();
  kload8(kf,kp0+sl_cur);
  WAIT_BAR(2);
  s16x4 vlo[8],vhi[8]; u32x4 pw0,pw1,pw2,pw3;
  #define PKW(P,B) cvtpk_s(P[B],P[B+1])
  #define PAF(k) __builtin_bit_cast(bf16x8,pw##k)
  #define VFR(i) (bf16x8){vlo[i][0],vlo[i][1],vlo[i][2],vlo[i][3],vhi[i][0],vhi[i][1],vhi[i][2],vhi[i][3]}
  #define PIN(x) asm volatile("":"+v"(x))
  #define MX3(a,b,c) __builtin_fmaxf(__builtin_fmaxf((a),(b)),(c))
  #define GAPA(MF,A0,A1,A2,A3,W0,W1,PW) do{ MF; sacc+=A0; sacc+=A1; sacc+=A2; sacc+=A3; PIN(sacc); W0; W1; PIN(PW); SBAR(); }while(0)
  #define EX(v) __builtin_amdgcn_exp2f(v)
  #define GAPB(MF,X,B) do{ MF; X[B]=EX(X[B]); X[B+1]=EX(X[B+1]); X[B+2]=EX(X[B+2]); X[B+3]=EX(X[B+3]); PIN(X); SBAR(); }while(0)
  #define VRD(i) do{ vlo[i]=vtr(vp_+(((i)>>2)*4096+((i)&3)*1024)); vhi[i]=vtr(vp_+(((i)>>2)*4096+((i)&3)*1024+512)); }while(0)
  #define KRD(G,j) do{ if(G){ kload2(kf,kp0+sl_next,j); SBAR(); } }while(0)
  #define STEP(C0,C1,P0,P1,t,GK,GV,GL) do{ SBAR(); \
    const lds_cptr vp_=vp0+sl_prev; \
    VRD(0); SBAR(); float sacc=(P0[0]+P0[1]); \
    GAPA(C0=__builtin_amdgcn_mfma_f32_32x32x16_bf16(kf[0],qr[0],negm,0,0,0), P0[2],P0[3],P0[4],P0[5],     pw0[0]=PKW(P0,0), pw0[1]=PKW(P0,2), pw0); \
    VRD(4); SBAR(); GAPA(C1=__builtin_amdgcn_mfma_f32_32x32x16_bf16(kf[1],qr[0],negm,0,0,0), P0[6],P0[7],P0[8],P0[9],     pw0[2]=PKW(P0,4), pw0[3]=PKW(P0,6), pw0); \
    VRD(1); SBAR(); GAPA(C0=__builtin_amdgcn_mfma_f32_32x32x16_bf16(kf[2],qr[1],C0,0,0,0),   P0[10],P0[11],P0[12],P0[13], pw1[0]=PKW(P0,8), pw1[1]=PKW(P0,10), pw1); \
    VRD(5); SBAR(); GAPA(C1=__builtin_amdgcn_mfma_f32_32x32x16_bf16(kf[3],qr[1],C1,0,0,0),   P0[14],P0[15],P1[0],P1[1],   pw1[2]=PKW(P0,12),pw1[3]=PKW(P0,14), pw1); \
    VRD(2); SBAR(); GAPA(C0=__builtin_amdgcn_mfma_f32_32x32x16_bf16(kf[4],qr[2],C0,0,0,0),   P1[2],P1[3],P1[4],P1[5],     pw2[0]=PKW(P1,0), pw2[1]=PKW(P1,2), pw2); \
    VRD(6); SBAR(); GAPA(C1=__builtin_amdgcn_mfma_f32_32x32x16_bf16(kf[5],qr[2],C1,0,0,0),   P1[6],P1[7],P1[8],P1[9],     pw2[2]=PKW(P1,4), pw2[3]=PKW(P1,6), pw2); \
    VRD(3); SBAR(); GAPA(C0=__builtin_amdgcn_mfma_f32_32x32x16_bf16(kf[6],qr[3],C0,0,0,0),   P1[10],P1[11],P1[12],P1[13], pw3[0]=PKW(P1,8), pw3[1]=PKW(P1,10), pw3); \
    VRD(7); SBAR(); GAPA(C1=__builtin_amdgcn_mfma_f32_32x32x16_bf16(kf[7],qr[3],C1,0,0,0),   P1[14],P1[15],0.f,0.f,       pw3[2]=PKW(P1,12),pw3[3]=PKW(P1,14), pw3); \
    l_reg+=sacc; \
    if(GK){DMA_K((t)+3,sl_cur);} if(GV){DMA_V((t)+1,sl_next);} \
    CMASK(C0,C1,t); \
    { float a=MX3(C0[0],C0[1],C1[0]),b=MX3(C0[2],C0[3],C1[1]); a=MX3(a,C1[2],C1[3]); \
      _Pragma("unroll") for(int r=4;r<16;r+=4){a=MX3(a,C0[r],C0[r+1]);b=MX3(b,C0[r+2],C0[r+3]);a=MX3(a,C1[r],C1[r+1]);b=MX3(b,C1[r+2],C1[r+3]);} \
      float rm=__builtin_fmaxf(a,b); { auto rr=__builtin_amdgcn_permlane32_swap(__float_as_uint(rm),__float_as_uint(rm),false,false); rm=__builtin_fmaxf(__uint_as_float(rr[0]),__uint_as_float(rr[1])); } \
      resc=false; \
      if(__builtin_expect(__any(rm>(float)THRL),0)){ const float dl=__builtin_fmaxf(rm,0.f); mhat+=dl; \
        _Pragma("unroll") for(int r=0;r<16;++r){C0[r]-=dl;C1[r]-=dl;} \
        _Pragma("unroll") for(int r=0;r<16;++r)negm[r]=-mhat; asm volatile("":"+v"(negm)); \
        const float f=__builtin_amdgcn_exp2f(-dl); l_reg*=f; if(hi==0)wsf[r32]=f; resc=true; } } \
    SBAR(); \
    GAPB(o[0]=__builtin_amdgcn_mfma_f32_32x32x16_bf16(PAF(0),VFR(0),o[0],0,0,0), C0,0); \
    GAPB(o[1]=__builtin_amdgcn_mfma_f32_32x32x16_bf16(PAF(0),VFR(4),o[1],0,0,0), C0,4); \
    KRD(GL,0); GAPB(o[0]=__builtin_amdgcn_mfma_f32_32x32x16_bf16(PAF(1),VFR(1),o[0],0,0,0), C0,8); \
    KRD(GL,1); GAPB(o[1]=__builtin_amdgcn_mfma_f32_32x32x16_bf16(PAF(1),VFR(5),o[1],0,0,0), C0,12); \
    KRD(GL,2); GAPB(o[0]=__builtin_amdgcn_mfma_f32_32x32x16_bf16(PAF(2),VFR(2),o[0],0,0,0), C1,0); \
    KRD(GL,3); GAPB(o[1]=__builtin_amdgcn_mfma_f32_32x32x16_bf16(PAF(2),VFR(6),o[1],0,0,0), C1,4); \
    GAPB(o[0]=__builtin_amdgcn_mfma_f32_32x32x16_bf16(PAF(3),VFR(3),o[0],0,0,0), C1,8); \
    GAPB(o[1]=__builtin_amdgcn_mfma_f32_32x32x16_bf16(PAF(3),VFR(7),o[1],0,0,0), C1,12); \
    }while(0)
  int t=1;
  #undef CMASK
  #define CMASK(P0,P1,t) do{}while(0)
  for(;t+7<NT;t+=2){
    STEP(pB0,pB1,pA0,pA1,t,true,true,true);     WAIT_BAR(2); RESC(); ROT();
    STEP(pA0,pA1,pB0,pB1,t+1,true,true,true);   WAIT_BAR(2); RESC(); ROT();
  }
  #undef CMASK
  #define CMASK(P0,P1,t) do{int jb_=(t)-(NT-4); if(jb_>=-2)cmask(P0,P1,jb_,qrel,hi,btab);}while(0)
  #define ENDW(tt) do{ if((tt)+3<NT){WAIT_BAR(2);} else if((tt)+2<NT){WAIT_BAR(1);} else {WAIT_BAR(0);} }while(0)
  for(;t+1<NT;t+=2){
    STEP(pB0,pB1,pA0,pA1,t,(t+3<NT),(t+1<NT),(t+1<NT));       ENDW(t);   RESC(); ROT();
    STEP(pA0,pA1,pB0,pB1,t+1,(t+4<NT),(t+2<NT),(t+2<NT));     ENDW(t+1); RESC(); ROT();
  }
  STEP(pB0,pB1,pA0,pA1,NT-1,false,false,false); RESC();
  { float sacc=pB0[0]+pB0[1]; _Pragma("unroll") for(int r=2;r<16;++r)sacc+=pB0[r]; _Pragma("unroll") for(int r=0;r<16;++r)sacc+=pB1[r]; l_reg+=sacc;
    pw0=(u32x4){PKW(pB0,0),PKW(pB0,2),PKW(pB0,4),PKW(pB0,6)};pw1=(u32x4){PKW(pB0,8),PKW(pB0,10),PKW(pB0,12),PKW(pB0,14)};pw2=(u32x4){PKW(pB1,0),PKW(pB1,2),PKW(pB1,4),PKW(pB1,6)};pw3=(u32x4){PKW(pB1,8),PKW(pB1,10),PKW(pB1,12),PKW(pB1,14)};
    SBAR(); pv(o,vb0+sl_cur,PAF(0),PAF(1),PAF(2),PAF(3)); }
  #undef PKW
  #undef PAF
  #undef VFR
  #undef PIN
  #undef MX3
  #undef GAPA
  #undef GAPB
  #undef EX
  #undef VRD
  #undef KRD
  #undef STEP
  #undef ENDW
  {auto rr=__builtin_amdgcn_permlane32_swap(__float_as_uint(l_reg),__float_as_uint(l_reg),false,false);l_reg=__uint_as_float(rr[0])+__uint_as_float(rr[1]);}
  if(hi==0)wsf[32+r32]=l_reg;asm volatile("s_waitcnt lgkmcnt(0)":::"memory");
  float rli[16];
  #pragma unroll
  for(int r=0;r<16;++r)rli[r]=__builtin_amdgcn_rcpf(wsf[32+crow(r,hi)]);
  bf16*Ow=O+(rowbase+q0+wid*QBLK)*OPITCH+ocol;
  { bf16*stg=(bf16*)(shm+LDS_OST)+wid*2048;
    #pragma unroll
    for(int r=0;r<16;++r){const int orow=crow(r,hi);
      #pragma unroll
      for(int d0=0;d0<2;++d0)stg[orow*64+d0*32+r32]=__float2bfloat16(o[d0][r]*rli[r]);}
    asm volatile("s_waitcnt lgkmcnt(0)":::"memory");
    #pragma unroll
    for(int i=0;i<4;++i){const int row=i*8+(lane>>3),ch=lane&7; const u32x4 v=*(const u32x4*)(stg+row*64+ch*8); ATTN_STORE16(Ow+(long)row*OPITCH+ch*8,v);} }
  asm volatile("s_waitcnt lgkmcnt(0)\n\ts_barrier":::"memory");
  #undef DMA_K
  #undef DMA_V
  #undef CMASK
  #undef START
  #undef RESC
  #undef ROT
}
constexpr int ATTN_LDS_BYTES=LDS_BYTES;
struct AttnTensors { const bf16* Q; const bf16* K; const bf16* V; bf16* O; const float* biasd; };
template<int THRL=8> __device__ __forceinline__ void attn_phase(char*lds,const AttnTensors&T,int vcu){
  const int inst=vcu>>3, s=vcu&7;
  for(int i=0;i<4;++i){ const int qb=(i==0)?s:(i==1)?15-s:(i==2)?16+s:31-s;
    attn_unit<THRL>((inst>>1)*64,(inst>>2)*128+(inst&1)*64,inst*64,inst>>2,qb,T.Q,T.K,T.V,T.O,T.biasd,lds); }
}
#undef SBAR
#undef WAIT_BAR
}
constexpr int NWAVES = 8;
constexpr int SEQ = 8192, DM = 2048, DFF = 5632, INW = 4096, AW = 1024, SW = 1024, NCOND = 9, DEPTH = 2;
constexpr int NG = 64, NP = 64, HC = 16;
constexpr int SCHUNK = 256, NCHUNK = SEQ / SCHUNK;
constexpr float LOG2E = 1.4426950408889634f;
constexpr size_t MiB = 1u << 20;
constexpr size_t WS_CTL = 0, CTL_ZERO_BYTES = 1 * MiB;
constexpr size_t WS_BIASD = 1 * MiB;
constexpr size_t WS_XEND = 2 * MiB;
constexpr size_t WS_WGU = 8 * MiB;
constexpr size_t WS_WD = WS_WGU + 4 * 44 * MiB;
constexpr size_t WS_WIN = WS_WD + 4 * 22 * MiB;
constexpr size_t WS_WOUT = WS_WIN + 2 * 16 * MiB;
constexpr size_t WS_WGLU = WS_WOUT + 2 * 8 * MiB;
constexpr size_t WS_H = WS_WGLU + 2 * 2 * MiB;
constexpr size_t WS_ACT = WS_H + 32 * MiB;
constexpr size_t WS_Q = WS_ACT + 88 * MiB;
constexpr size_t WS_K = WS_Q + 16 * MiB, WS_V = WS_K + 16 * MiB, WS_U = WS_V + 16 * MiB;
constexpr size_t WS_OP = WS_U + 16 * MiB;
constexpr size_t WS_CAT = WS_OP + 32 * MiB;
constexpr size_t WS_YG = WS_CAT + 32 * MiB;
constexpr size_t WS_END = WS_YG + 16 * MiB;
constexpr int RING_BYTES = 131072, LDS_BYTES = 147456;

#define LAS __attribute__((address_space(3)))
typedef unsigned short bf16;
typedef unsigned v4u __attribute__((ext_vector_type(4)));
typedef unsigned v2u __attribute__((ext_vector_type(2)));
typedef float f32x4 __attribute__((ext_vector_type(4)));
typedef float f32x2v __attribute__((ext_vector_type(2)));
typedef short bf16x8 __attribute__((ext_vector_type(8)));
#define LDS_WAIT() asm volatile("s_waitcnt lgkmcnt(0)" ::: "memory")
__device__ __forceinline__ unsigned pk2(float lo, float hi) { return pg8::cvt_pk_bf16(lo, hi); }
__device__ __forceinline__ float wave_sum(float v) {
#pragma unroll
    for (int o = 1; o < 64; o <<= 1) v += __shfl_xor(v, o);
    return v;
}

#define RLX_AGENT __ATOMIC_RELAXED, __HIP_MEMORY_SCOPE_AGENT
constexpr int CW_BAR = 65536;
constexpr int MISC_OFF = LDS_BYTES - 64;
#define XB_TMO      128
#define XB_XCNT(j)  (256  + 64 * (j))
#define XB_XSUB(j)  (1280 + 64 * (j))
#define XB_XGEN(j)  (2304 + 64 * (j))
#define XB_TOP      3328
#define XB_TOPGEN   3392
#define XCD_BAR_WORDS 3456
#define XB_SPIN_CAP (1u << 18)

__device__ __forceinline__ unsigned xb_ld(unsigned* p)              { return __hip_atomic_load(p, __ATOMIC_RELAXED, __HIP_MEMORY_SCOPE_AGENT); }
__device__ __forceinline__ unsigned xb_add(unsigned* p, unsigned v) { return __hip_atomic_fetch_add(p, v, __ATOMIC_RELAXED, __HIP_MEMORY_SCOPE_AGENT); }
__device__ __forceinline__ unsigned xb_xcc_id() { return (unsigned)__builtin_amdgcn_s_getreg((3 << 11) | 20) & 0xFu; }
#define XB_SPIN(cond, bar) do { unsigned _sp = 0; while (cond) { __builtin_amdgcn_s_sleep(1); \
    if ((++_sp & 255u) == 0u) { if (xb_ld(&(bar)[XB_TMO])) break; if (_sp > XB_SPIN_CAP) { atomicAdd(&(bar)[XB_TMO], 1u); break; } } } } while (0)

struct XcdBarrier {
    unsigned* bar; unsigned x;
    volatile LAS unsigned* st;
};

__device__ __forceinline__ XcdBarrier xcd_barrier_post(unsigned* bar, volatile LAS unsigned* st) {
    XcdBarrier b; b.bar = bar; b.x = xb_xcc_id(); b.st = st;
    if (threadIdx.x == 0) (void)xb_add(&bar[XB_XCNT(b.x)], 1u);
    return b;
}
__device__ __forceinline__ void xcd_barrier_complete(unsigned* bar, unsigned x, unsigned& nloc, unsigned& nx) {
    const unsigned G = gridDim.x * gridDim.y * gridDim.z;
    unsigned sum, cnt, mine, sp = 0u;
    for (;;) {
        sum = 0u; cnt = 0u; mine = 0u;
#pragma unroll
        for (unsigned j = 0; j < 16; ++j) { const unsigned c = xb_ld(&bar[XB_XCNT(j)]); sum += c; cnt += (c > 0u) ? 1u : 0u; mine = (j == x) ? c : mine; }
        if (sum == G) break;
        __builtin_amdgcn_s_sleep(1);
        if ((++sp & 255u) == 0u) { if (xb_ld(&bar[XB_TMO])) break; if (sp > XB_SPIN_CAP) { atomicAdd(&bar[XB_TMO], 1u); break; } }
    }
    nloc = mine > 0u ? mine : 1u; nx = cnt > 0u ? cnt : 1u;
}

__device__ __forceinline__ void xcd_barrier(const XcdBarrier& b) {
    asm volatile("s_waitcnt vmcnt(0)" ::: "memory");
    __syncthreads();
    if (threadIdx.x == 0) {
        unsigned* bar = b.bar;
        __builtin_amdgcn_s_waitcnt(0);
        unsigned nloc = b.st[0], nx = b.st[1];
        if (nloc == 0u) { xcd_barrier_complete(bar, b.x, nloc, nx); b.st[0] = nloc; b.st[1] = nx; }
        const unsigned old = xb_add(&bar[XB_XSUB(b.x)], 1u);
        const unsigned gen = old / nloc;
        if (old + 1u == (gen + 1u) * nloc) {
            __builtin_amdgcn_fence(__ATOMIC_RELEASE, "agent");
            asm volatile("s_waitcnt vmcnt(0)" ::: "memory");
            const unsigned og = xb_add(&bar[XB_TOP], 1u);
            const unsigned tg = og / nx;
            if (og + 1u == (tg + 1u) * nx) xb_add(&bar[XB_TOPGEN], 1u);
            else XB_SPIN(xb_ld(&bar[XB_TOPGEN]) == tg, bar);
            __builtin_amdgcn_fence(__ATOMIC_ACQUIRE, "agent");
            xb_add(&bar[XB_XGEN(b.x)], 1u);
            asm volatile("s_waitcnt vmcnt(0)" ::: "memory");
        } else {
            XB_SPIN(xb_ld(&bar[XB_XGEN(b.x)]) == gen, bar);
            __builtin_amdgcn_fence(__ATOMIC_ACQUIRE, "agent");
            asm volatile("s_waitcnt vmcnt(0)" ::: "memory");
        }
    }
    __syncthreads();
}

struct Frame {
    LAS unsigned char* lds;
    int tid, lane, wave, vcu, G;
};
__device__ __forceinline__ Frame frame_opaque(const Frame& F0) { Frame F = F0; asm volatile("" : "+v"(F.tid)); F.lane = F.tid & 63; return F; }

__device__ __forceinline__ void p0_transpose_item(const float* W, int K, int N, bf16* WT, int k0, int n0, int drow0, LAS float* scr, int lane) {
#pragma unroll 8
    for (int i = 0; i < 32; ++i) { const int kk = 2 * i + (lane >> 5); scr[kk * 33 + (lane & 31)] = W[(size_t)(k0 + kk) * N + n0 + (lane & 31)]; }
    LDS_WAIT(); asm volatile("" ::: "memory");
    const int c = lane & 7;
#pragma unroll
    for (int j = 0; j < 4; ++j) { const int n = (lane >> 3) + 8 * j; const LAS float* s = scr + (8 * c) * 33 + n;
        v4u o; o.x = pk2(s[0 * 33], s[1 * 33]); o.y = pk2(s[2 * 33], s[3 * 33]); o.z = pk2(s[4 * 33], s[5 * 33]); o.w = pk2(s[6 * 33], s[7 * 33]);
        *(v4u*)(WT + (size_t)(drow0 + n) * K + k0 + 8 * c) = o; }
    LDS_WAIT(); asm volatile("" ::: "memory");
}
__device__ __forceinline__ void p0_matrix_item(const float* W, int K, int N, bf16* WT, int mode, int item, LAS float* scr, int lane) {
    const int nblk = N / 32, kb = item / nblk, nb = item % nblk, k0 = 64 * kb, n0 = 32 * nb;
    int drow0 = n0;
    if (mode == 1 || mode == 2) drow0 = (n0 >> 7) * 256 + (mode - 1) * 128 + (n0 & 127);
    else if (mode == 3 && n0 < 2048) { const int pn = n0 >> 8, cc = n0 & 255; drow0 = pn * 256 + ((cc >> 5) & 1) * 128 + (cc >> 6) * 32; }
    p0_transpose_item(W, K, N, WT, k0, n0, drow0, scr, lane);
}
struct In { const float* p[31]; };
__device__ __forceinline__ const float* inp(int i) { const float* const __attribute__((address_space(4)))* t = (const float* const __attribute__((address_space(4)))*)__builtin_amdgcn_kernarg_segment_ptr(); asm volatile("" : "+s"(t)); return t[i]; }
__device__ __forceinline__ int t5_bucket(int d) {
    if (d < 16) return d;
    int b = 16; b += d >= 19; b += d >= 21; b += d >= 24; b += d >= 27; b += d >= 31; b += d >= 35; b += d >= 40; b += d >= 46; b += d >= 52; b += d >= 59; b += d >= 67; b += d >= 77; b += d >= 87; b += d >= 99; b += d >= 113;
    return b;
}
__device__ __forceinline__ void p0_prologue(const Frame& F0, unsigned char* ws) { const Frame F = frame_opaque(F0);
    LAS float* scr = (LAS float*)(F.lds + F.wave * 16384);
    const int gw = F.vcu * NWAVES + F.wave, NGW = F.G * NWAVES;
    if (blockIdx.x == 0) { float* bd = (float*)(ws + WS_BIASD); const float* rb = inp(2);
        for (int i = F.tid; i < 1024; i += NWAVES * 64) { const int h = i >> 7, d = i & 127; bd[i] = (rb[t5_bucket(d) * 8 + h] - rb[31 * 8 + h]) * LOG2E; } }
    { float* mod = (float*)(ws + WS_CTL); const float* cvec = inp(1);
      for (int it = gw; it < 144 * 16; it += NGW) { const int cb = it % 144, kc = it / 144, layer = cb / 72, col = (cb % 72) * 256 + F.lane * 4;
          const float* W = inp(3) + ((size_t)layer * DM + kc * 128) * (NCOND * DM) + col;
          f32x4 acc = (f32x4){0.f, 0.f, 0.f, 0.f}; if (kc == 0) acc = *(const f32x4*)(inp(4) + layer * (NCOND * DM) + col);
#pragma unroll 8
          for (int kk = 0; kk < 128; ++kk) { const float cv = cvec[kc * 128 + kk]; const float sv = cv * pg8::sigmoid_f(cv); acc += sv * *(const f32x4*)(W + (size_t)kk * (NCOND * DM)); }
          float* dst = mod + layer * (NCOND * DM) + col; atomicAdd(dst, acc[0]); atomicAdd(dst + 1, acc[1]); atomicAdd(dst + 2, acc[2]); atomicAdd(dst + 3, acc[3]); } }
    constexpr int I_F = (DM / 64) * (DFF / 32), I_IN = (DM / 64) * (INW / 32), I_OUT = (DM / 64) * (DM / 32), I_GLU = (SW / 64) * (SW / 32);
    constexpr int PER_LAYER = 6 * I_F + I_IN + I_OUT + I_GLU;
    for (int it = gw; it < DEPTH * PER_LAYER; it += NGW) {
        const int li = it / PER_LAYER; int r = it % PER_LAYER;
        const size_t fo = (size_t)li * DM * DFF;
        bf16* wgu1 = (bf16*)(ws + WS_WGU) + (size_t)(li * 2 + 0) * 2 * DFF * DM; bf16* wgu2 = (bf16*)(ws + WS_WGU) + (size_t)(li * 2 + 1) * 2 * DFF * DM;
        bf16* wd1 = (bf16*)(ws + WS_WD) + (size_t)(li * 2 + 0) * DM * DFF; bf16* wd2 = (bf16*)(ws + WS_WD) + (size_t)(li * 2 + 1) * DM * DFF;
        if (r < I_F) { p0_matrix_item(inp(6) + fo, DM, DFF, wgu1, 1, r, scr, F.lane); continue; } r -= I_F;
        if (r < I_F) { p0_matrix_item(inp(7) + fo, DM, DFF, wgu1, 2, r, scr, F.lane); continue; } r -= I_F;
        if (r < I_F) { p0_matrix_item(inp(8) + fo, DFF, DM, wd1, 0, r, scr, F.lane); continue; } r -= I_F;
        if (r < I_F) { p0_matrix_item(inp(9) + fo, DM, DFF, wgu2, 1, r, scr, F.lane); continue; } r -= I_F;
        if (r < I_F) { p0_matrix_item(inp(10) + fo, DM, DFF, wgu2, 2, r, scr, F.lane); continue; } r -= I_F;
        if (r < I_F) { p0_matrix_item(inp(11) + fo, DFF, DM, wd2, 0, r, scr, F.lane); continue; } r -= I_F;
        if (r < I_IN) { p0_matrix_item(inp(12) + (size_t)li * DM * INW, DM, INW, (bf16*)(ws + WS_WIN) + (size_t)li * INW * DM, 3, r, scr, F.lane); continue; } r -= I_IN;
        if (r < I_OUT) { p0_matrix_item(inp(13) + (size_t)li * DM * DM, DM, DM, (bf16*)(ws + WS_WOUT) + (size_t)li * DM * DM, 0, r, scr, F.lane); continue; } r -= I_OUT;
        p0_matrix_item(inp(29) + (size_t)li * SW * SW, SW, SW, (bf16*)(ws + WS_WGLU) + (size_t)li * SW * SW, 0, r, scr, F.lane);
    }
}

__device__ __forceinline__ void norm_phase(const Frame& F0, const float* xin, const float* gnorm, const float* shift, const float* scale, bf16* H) { const Frame F = frame_opaque(F0);
    const int gw = F.vcu * NWAVES + F.wave, NGW = F.G * NWAVES;
    f32x4 gam[8], sh[8];
#pragma unroll
    for (int j = 0; j < 8; ++j) { const int idx = 4 * F.lane + 256 * j; gam[j] = *(const f32x4*)(gnorm + idx) * (1.0f + *(const f32x4*)(scale + idx)); sh[j] = *(const f32x4*)(shift + idx); }
    for (int m = gw; m < SEQ; m += NGW) {
        const f32x4* xr = (const f32x4*)(xin + (size_t)m * DM) + F.lane;
        f32x4 v[8]; float s = 0.f;
#pragma unroll
        for (int j = 0; j < 8; ++j) { v[j] = xr[64 * j]; s += (v[j].x * v[j].x + v[j].y * v[j].y) + (v[j].z * v[j].z + v[j].w * v[j].w); }
        const float rstd = __builtin_amdgcn_rsqf(wave_sum(s) * (1.0f / DM) + 1e-6f);
        v2u* o8 = (v2u*)(H + (size_t)m * DM) + F.lane;
#pragma unroll
        for (int j = 0; j < 8; ++j) { const f32x4 y = v[j] * rstd * gam[j] + sh[j]; v2u w; w.x = pk2(y.x, y.y); w.y = pk2(y.z, y.w); o8[64 * j] = w; }
    }
}

__device__ __forceinline__ void combine_phase(const Frame& F0, const bf16* OP, bf16* CAT, const float* lq1, const float* lk1, const float* lq2, const float* lk2, const float* subg, float lam_init) { const Frame F = frame_opaque(F0);
    const int gw = F.vcu * NWAVES + F.wave, NGW = F.G * NWAVES;
    const float lam = expf(wave_sum(lq1[F.lane] * lk1[F.lane])) - expf(wave_sum(lq2[F.lane] * lk2[F.lane])) + lam_init;
    const int h = F.lane >> 3, j0 = (F.lane & 7) * 16;
    float gs[16];
#pragma unroll
    for (int i = 0; i < 16; ++i) gs[i] = subg[j0 + i] * (1.0f - lam_init);
    for (int m = gw; m < SEQ; m += NGW) {
        const bf16* p1 = OP + (size_t)m * 2048 + (2 * h) * 128 + j0; const bf16* p2 = p1 + 128;
        const v4u a0 = *(const v4u*)p1, a1 = *(const v4u*)(p1 + 8), b0 = *(const v4u*)p2, b1 = *(const v4u*)(p2 + 8);
        float o[16];
#pragma unroll
        for (int i = 0; i < 4; ++i) { o[2 * i] = pg8::bf_lo(a0[i]) - lam * pg8::bf_lo(b0[i]); o[2 * i + 1] = pg8::bf_hi(a0[i]) - lam * pg8::bf_hi(b0[i]);
                                      o[8 + 2 * i] = pg8::bf_lo(a1[i]) - lam * pg8::bf_lo(b1[i]); o[8 + 2 * i + 1] = pg8::bf_hi(a1[i]) - lam * pg8::bf_hi(b1[i]); }
        float ss = 0.f;
#pragma unroll
        for (int i = 0; i < 16; ++i) ss += o[i] * o[i];
        ss += __shfl_xor(ss, 1); ss += __shfl_xor(ss, 2); ss += __shfl_xor(ss, 4);
        const float r = __builtin_amdgcn_rsqf(ss * (1.0f / 128.0f) + 1e-5f);
        v4u w0, w1;
#pragma unroll
        for (int i = 0; i < 4; ++i) { w0[i] = pk2(o[2 * i] * r * gs[2 * i], o[2 * i + 1] * r * gs[2 * i + 1]); w1[i] = pk2(o[8 + 2 * i] * r * gs[8 + 2 * i], o[8 + 2 * i + 1] * r * gs[8 + 2 * i + 1]); }
        bf16* q = CAT + (size_t)m * 2048 + h * 128 + j0; *(v4u*)q = w0; *(v4u*)(q + 8) = w1;
    }
}

struct SsmP { const float *lam_re, *lam_im, *log_step, *b_re, *b_im, *c_re, *c_im, *dv; };
__device__ __forceinline__ void cexp_s(float lr, float li, float s, float& er, float& ei) {
    const float m = expf(lr * s);
    double tr = (double)li * (double)s * 0.15915494309189535; tr -= floor(tr);
    const float a = (float)(tr * 6.283185307179586);
    float sn, cs; sincosf(a, &sn, &cs); er = m * cs; ei = m * sn;
}
__device__ __forceinline__ void ssm_lam(const SsmP& P, int g, int p, float& lr, float& li, float& step) {
    lr = fminf(P.lam_re[g * NP + p], -1e-4f); li = P.lam_im[g * NP + p]; step = expf(P.log_step[g]);
}
__device__ __forceinline__ void ssm_bfrag(const SsmP& P, int g, int lane, bf16x8 (&bfr)[8]) {
    const int q = lane >> 4, ci = lane & 15, hb = 8 * (q & 1);
#pragma unroll
    for (int pb = 0; pb < 4; ++pb) { const int p = 16 * pb + ci; float lr, li, step, ar, ai; ssm_lam(P, g, p, lr, li, step); cexp_s(lr, li, step, ar, ai);
        const float nr = ar - 1.0f, ni = ai, den = 1.0f / (lr * lr + li * li); const float cr = (nr * lr + ni * li) * den, cim = (ni * lr - nr * li) * den;
        const float* br = P.b_re + ((size_t)g * NP + p) * HC + hb; const float* bi = P.b_im + ((size_t)g * NP + p) * HC + hb;
        const f32x4 r0 = *(const f32x4*)br, r1 = *(const f32x4*)(br + 4), i0 = *(const f32x4*)bi, i1 = *(const f32x4*)(bi + 4);
        const f32x4 re0 = cr * r0 - cim * i0, re1 = cr * r1 - cim * i1, im0 = cr * i0 + cim * r0, im1 = cr * i1 + cim * r1;
        v4u wr_, wi_; wr_.x = pk2(re0[0], re0[1]); wr_.y = pk2(re0[2], re0[3]); wr_.z = pk2(re1[0], re1[1]); wr_.w = pk2(re1[2], re1[3]);
        wi_.x = pk2(im0[0], im0[1]); wi_.y = pk2(im0[2], im0[3]); wi_.z = pk2(im1[0], im1[1]); wi_.w = pk2(im1[2], im1[3]);
        if (q >= 2) { wr_ = (v4u){0u, 0u, 0u, 0u}; wi_ = (v4u){0u, 0u, 0u, 0u}; }
        bfr[pb] = __builtin_bit_cast(bf16x8, wr_); bfr[4 + pb] = __builtin_bit_cast(bf16x8, wi_); }
}
constexpr int BU_STRIDE = 132, XB_STRIDE = 136;
__device__ __forceinline__ void ssm_bu_to_lds(bf16x8 af, const bf16x8 (&bfr)[8], LAS float* bu, int lane) {
    const int q = lane >> 4, ci = lane & 15;
#pragma unroll
    for (int nb = 0; nb < 8; ++nb) { const f32x4 d = __builtin_amdgcn_mfma_f32_16x16x32_bf16(af, bfr[nb], (f32x4){0.f, 0.f, 0.f, 0.f}, 0, 0, 0);
#pragma unroll
        for (int r = 0; r < 4; ++r) bu[(4 * q + r) * BU_STRIDE + 16 * nb + ci] = d[r]; }
}
__device__ __forceinline__ bf16x8 ssm_load_u(const bf16* U, int g, int t, int q) {
    bf16x8 af = (bf16x8){0, 0, 0, 0, 0, 0, 0, 0};
    if (q < 2) af = *(const bf16x8*)(U + (size_t)t * SW + g * HC + 8 * q);
    return af;
}
__device__ __forceinline__ void ssm_pass1(const Frame& F0, const SsmP& P, const bf16* U, float* XEND) { const Frame F = frame_opaque(F0);
    const int gw = F.vcu * NWAVES + F.wave, NGW = F.G * NWAVES, lane = F.lane, q = lane >> 4, ci = lane & 15;
    LAS float* bu = (LAS float*)(F.lds + F.wave * 16384);
    for (int it = gw; it < NG * NCHUNK; it += NGW) { const int g = it / NCHUNK, c = it % NCHUNK, t0 = c * SCHUNK;
        bf16x8 bfr[8]; ssm_bfrag(P, g, lane, bfr);
        float lr, li, step, ar, ai; ssm_lam(P, g, lane, lr, li, step); cexp_s(lr, li, step, ar, ai);
        float xr = 0.f, xi = 0.f;
        bf16x8 af = ssm_load_u(U, g, t0 + ci, q);
        for (int sb = 0; sb < SCHUNK / 16; ++sb) {
            ssm_bu_to_lds(af, bfr, bu, lane);
            if (sb + 1 < SCHUNK / 16) af = ssm_load_u(U, g, t0 + (sb + 1) * 16 + ci, q);
            LDS_WAIT();
#pragma unroll
            for (int tt = 0; tt < 16; ++tt) { const float br_ = bu[tt * BU_STRIDE + lane], bi_ = bu[tt * BU_STRIDE + 64 + lane];
                const float nxr = ar * xr - ai * xi + br_, nxi = ar * xi + ai * xr + bi_; xr = nxr; xi = nxi; }
            LDS_WAIT();
        }
        *(f32x2v*)(XEND + ((size_t)it * NP + lane) * 2) = (f32x2v){xr, xi};
    }
}
__device__ __forceinline__ float gelu_tanh(float x) {
    const float z = x + 0.044715f * x * x * x;
    return x * __builtin_amdgcn_rcpf(1.0f + __builtin_amdgcn_exp2f(-2.0f * 0.7978845608028654f * LOG2E * z));
}
__device__ __forceinline__ void ssm_pass2(const Frame& F0, const SsmP& P, const bf16* U, const float* XEND, bf16* YG) { const Frame F = frame_opaque(F0);
    const int gw = F.vcu * NWAVES + F.wave, NGW = F.G * NWAVES, lane = F.lane, q = lane >> 4, ci = lane & 15;
    LAS float* bu = (LAS float*)(F.lds + F.wave * 16384);
    LAS bf16* xb = (LAS bf16*)(F.lds + F.wave * 16384 + 16 * BU_STRIDE * 4);
    for (int it = gw; it < NG * NCHUNK; it += NGW) { const int g = it / NCHUNK, c = it % NCHUNK, t0 = c * SCHUNK;
        bf16x8 bfr[8]; ssm_bfrag(P, g, lane, bfr);
        float lr, li, step, ar, ai; ssm_lam(P, g, lane, lr, li, step); cexp_s(lr, li, step, ar, ai);
        float xr = 0.f, xi = 0.f;
        { float aTr, aTi; cexp_s(lr, li, step * (float)SCHUNK, aTr, aTi);
          for (int cc = 0; cc < c; ++cc) { const f32x2v e = *(const f32x2v*)(XEND + ((size_t)(g * NCHUNK + cc) * NP + lane) * 2);
              const float nxr = aTr * xr - aTi * xi + e.x, nxi = aTr * xi + aTi * xr + e.y; xr = nxr; xi = nxi; } }
        bf16x8 cf[4];
#pragma unroll
        for (int kb = 0; kb < 4; ++kb) { const float* src = (kb < 2 ? P.c_re : P.c_im) + ((size_t)g * HC + ci) * NP + 32 * (kb & 1) + 8 * q; const float sg = kb < 2 ? 1.0f : -1.0f;
            const f32x4 a = *(const f32x4*)src * sg, b = *(const f32x4*)(src + 4) * sg;
            v4u w; w.x = pk2(a[0], a[1]); w.y = pk2(a[2], a[3]); w.z = pk2(b[0], b[1]); w.w = pk2(b[2], b[3]); cf[kb] = __builtin_bit_cast(bf16x8, w); }
        const f32x4 dv4 = *(const f32x4*)(P.dv + g * HC + 4 * q);
        bf16x8 af = ssm_load_u(U, g, t0 + ci, q);
        for (int sb = 0; sb < SCHUNK / 16; ++sb) {
            ssm_bu_to_lds(af, bfr, bu, lane);
            if (sb + 1 < SCHUNK / 16) af = ssm_load_u(U, g, t0 + (sb + 1) * 16 + ci, q);
            const int t = t0 + sb * 16 + ci;
            const v2u uu = *(const v2u*)(U + (size_t)t * SW + g * HC + 4 * q);
            LDS_WAIT();
#pragma unroll
            for (int tt = 0; tt < 16; ++tt) { const float br_ = bu[tt * BU_STRIDE + lane], bi_ = bu[tt * BU_STRIDE + 64 + lane];
                const float nxr = ar * xr - ai * xi + br_, nxi = ar * xi + ai * xr + bi_; xr = nxr; xi = nxi;
                const unsigned pk = pk2(xr, xi); xb[tt * XB_STRIDE + lane] = (bf16)(pk & 0xffffu); xb[tt * XB_STRIDE + 64 + lane] = (bf16)(pk >> 16); }
            LDS_WAIT();
            f32x4 yd = (f32x4){0.f, 0.f, 0.f, 0.f};
#pragma unroll
            for (int kb = 0; kb < 4; ++kb) { const bf16x8 xf = *(const LAS bf16x8*)(xb + ci * XB_STRIDE + 32 * kb + 8 * q); yd = __builtin_amdgcn_mfma_f32_16x16x32_bf16(cf[kb], xf, yd, 0, 0, 0); }
            const float y0 = gelu_tanh(yd[0] + dv4[0] * pg8::bf_lo(uu.x)), y1 = gelu_tanh(yd[1] + dv4[1] * pg8::bf_hi(uu.x));
            const float y2 = gelu_tanh(yd[2] + dv4[2] * pg8::bf_lo(uu.y)), y3 = gelu_tanh(yd[3] + dv4[3] * pg8::bf_hi(uu.y));
            v2u w; w.x = pk2(y0, y1); w.y = pk2(y2, y3);
            *(v2u*)(YG + (size_t)t * SW + g * HC + 4 * q) = w;
            LDS_WAIT();
        }
    }
}

struct Args { In in; float* out; unsigned char* ws; int ph_lo, ph_hi; };
constexpr int N_PHASES = 1 + 12 * DEPTH;
__global__ void __launch_bounds__(NWAVES * 64, 2) mega_fwd(Args args) {
    extern __shared__ __attribute__((aligned(16))) unsigned char lds[];
    cg::grid_group grid = cg::this_grid();
    Frame F;
    F.lds = (LAS unsigned char*)lds;
    F.tid = threadIdx.x; F.lane = F.tid & 63; F.wave = __builtin_amdgcn_readfirstlane(F.tid >> 6);
    F.G = gridDim.x; { const int bx = blockIdx.x; F.vcu = (F.G % 8 == 0) ? (bx % 8) * (F.G / 8) + bx / 8 : bx; }
    const int lo = args.ph_lo, hi = args.ph_hi;
    if (F.tid < 16) ((LAS unsigned*)(F.lds + MISC_OFF))[F.tid] = 0u;
    __syncthreads();
    XcdBarrier bar = xcd_barrier_post((unsigned*)(args.ws + WS_CTL) + CW_BAR, (volatile LAS unsigned*)(F.lds + MISC_OFF));
    int ph = 0;
#define PH_ON (ph >= lo && ph < hi)
#define PH_END do { if (ph >= lo && ph + 1 < hi) { if (ph == 0) grid.sync(); else xcd_barrier(bar); } ++ph; } while (0)
#define PH_LOCALS unsigned char* ws = args.ws; float* xout = args.out; int li = li_, f = f_; asm volatile("" : "+s"(ws), "+s"(xout), "+s"(li), "+s"(f)); \
    const float* md = (const float*)(ws + WS_CTL) + li * (NCOND * DM); const float* ng = inp(5) + (size_t)li * 3 * DM; const int sub = f == 0 ? 0 : 2; \
    const float* xcur = (li == 0 && f == 0) ? inp(0) : (const float*)xout; (void)md; (void)ng; (void)sub; (void)xcur;

    if (PH_ON) p0_prologue(F, args.ws);
    PH_END;

    for (int li_ = 0; li_ < DEPTH; ++li_) {
        for (int f_ = 0; f_ < 2; ++f_) {
            if (PH_ON) { PH_LOCALS; norm_phase(F, xcur, ng + sub * DM, md + (3 * sub) * DM, md + (3 * sub + 1) * DM, (bf16*)(ws + WS_H)); }
            PH_END;
            if (PH_ON) { PH_LOCALS; pg8::Gemm g{(const bf16*)(ws + WS_H), (const bf16*)(ws + WS_WGU) + (size_t)(li * 2 + f) * 2 * DFF * DM, SEQ, 2 * DFF, DM}; pg8::StaticOrder S; S.init(SEQ, 2 * DFF, F.G, (int)blockIdx.x);
                pg8::EpiSwiGlu E{(bf16*)(ws + WS_ACT), DFF};
                pg8::gemm_phase<pg8::EpiSwiGlu, pg8::StaticOrder, true, true>(F.lds, g, S, E); }
            PH_END;
            if (PH_ON) { PH_LOCALS; pg8::Gemm g{(const bf16*)(ws + WS_ACT), (const bf16*)(ws + WS_WD) + (size_t)(li * 2 + f) * DM * DFF, SEQ, DM, DFF}; pg8::StaticOrder S; S.init(SEQ, DM, F.G, (int)blockIdx.x);
                pg8::EpiResGate E{xcur, xout, md + (3 * sub + 2) * DM, 0.5f, DM};
                pg8::gemm_phase<pg8::EpiResGate, pg8::StaticOrder, true, true>(F.lds, g, S, E); }
            PH_END;
            if (f_ == 1) break;
            if (PH_ON) { PH_LOCALS; norm_phase(F, xout, ng + 1 * DM, md + 3 * DM, md + 4 * DM, (bf16*)(ws + WS_H)); }
            PH_END;
            if (PH_ON) { PH_LOCALS; pg8::Gemm g{(const bf16*)(ws + WS_H), (const bf16*)(ws + WS_WIN) + (size_t)li * INW * DM, SEQ, INW, DM}; pg8::StaticOrder S; S.init(SEQ, INW, F.G, (int)blockIdx.x);
                pg8::EpiWin E{(bf16*)(ws + WS_Q), (bf16*)(ws + WS_K), (bf16*)(ws + WS_V), (bf16*)(ws + WS_U), inp(14) + li * 64, inp(15) + li * 64, attn_body::C2};
                pg8::gemm_phase<pg8::EpiWin, pg8::StaticOrder, true, true>(F.lds, g, S, E); }
            PH_END;
#define SSM_PARAMS SsmP P{inp(21) + (size_t)li * NG * NP, inp(22) + (size_t)li * NG * NP, inp(23) + li * NG, inp(24) + (size_t)li * NG * NP * HC, inp(25) + (size_t)li * NG * NP * HC, \
                   inp(26) + (size_t)li * NG * HC * NP, inp(27) + (size_t)li * NG * HC * NP, inp(28) + li * NG * HC}
            if (PH_ON) { PH_LOCALS;
#ifndef NO_ATTN
                { const attn_body::AttnTensors AT{(const attn_body::bf16*)(ws + WS_Q), (const attn_body::bf16*)(ws + WS_K), (const attn_body::bf16*)(ws + WS_V), (attn_body::bf16*)(ws + WS_OP), (const float*)(ws + WS_BIASD)};
                  attn_body::attn_phase<8>((char*)lds, AT, F.vcu); }
#endif
#ifndef NO_SSM
                { SSM_PARAMS; ssm_pass1(F, P, (const bf16*)(ws + WS_U), (float*)(ws + WS_XEND)); }
#endif
                }
            PH_END;
            if (PH_ON) { PH_LOCALS; combine_phase(F, (const bf16*)(ws + WS_OP), (bf16*)(ws + WS_CAT), inp(16) + li * 64, inp(17) + li * 64, inp(18) + li * 64, inp(19) + li * 64, inp(20) + li * 128, li == 0 ? 0.2f : 0.35550906759096924f);
#ifndef NO_SSM
                { SSM_PARAMS; ssm_pass2(F, P, (const bf16*)(ws + WS_U), (const float*)(ws + WS_XEND), (bf16*)(ws + WS_YG)); }
#endif
                }
            PH_END;
            if (PH_ON) { PH_LOCALS; pg8::Gemm g{(const bf16*)(ws + WS_YG), (const bf16*)(ws + WS_WGLU) + (size_t)li * SW * SW, SEQ, SW, SW}; pg8::StaticOrder S; S.init(SEQ, SW, F.G, (int)blockIdx.x);
                pg8::EpiGlu E{(const bf16*)(ws + WS_YG), (bf16*)(ws + WS_CAT), inp(30) + li * SW};
                pg8::gemm_phase<pg8::EpiGlu, pg8::StaticOrder, true, true>(F.lds, g, S, E); }
            PH_END;
            if (PH_ON) { PH_LOCALS; pg8::Gemm g{(const bf16*)(ws + WS_CAT), (const bf16*)(ws + WS_WOUT) + (size_t)li * DM * DM, SEQ, DM, DM}; pg8::StaticOrder S; S.init(SEQ, DM, F.G, (int)blockIdx.x);
                pg8::EpiResGate E{xout, xout, md + 5 * DM, 1.0f, DM};
                pg8::gemm_phase<pg8::EpiResGate, pg8::StaticOrder, true, true>(F.lds, g, S, E); }
            PH_END;
        }
    }
#undef PH_ON
#undef PH_END
#undef PH_LOCALS
#undef SSM_PARAMS
}

extern "C" void kernel_launch(void* const* d_in, const int* in_sizes, int n_in, void* d_out, int out_size, void* d_ws, size_t ws_size, hipStream_t stream) {
    static int grid = 0;
    if (grid == 0) {
        if (n_in != 31 || in_sizes[0] != SEQ * DM || out_size != SEQ * DM || ws_size < WS_END) { fprintf(stderr, "kernel_launch: unexpected shapes (n_in %d, in0 %d, out %d, ws %zu < %zu?); nothing launched\n", n_in, n_in > 0 ? in_sizes[0] : -1, out_size, ws_size, (size_t)WS_END); grid = -1; return; }
        int dev = 0, cus = 0, per_cu = 0;
        if (hipGetDevice(&dev) != hipSuccess || hipDeviceGetAttribute(&cus, hipDeviceAttributeMultiprocessorCount, dev) != hipSuccess) { fprintf(stderr, "kernel_launch: device query failed\n"); grid = -1; return; }
        if (hipFuncSetAttribute((const void*)mega_fwd, hipFuncAttributeMaxDynamicSharedMemorySize, LDS_BYTES) != hipSuccess) { fprintf(stderr, "kernel_launch: hipFuncSetAttribute failed\n"); grid = -1; return; }
        if (hipOccupancyMaxActiveBlocksPerMultiprocessor(&per_cu, (const void*)mega_fwd, NWAVES * 64, LDS_BYTES) != hipSuccess || per_cu < 1) { fprintf(stderr, "kernel_launch: occupancy query says %d\n", per_cu); per_cu = 1; }
        (void)hipGetLastError();
        grid = cus;
        if (grid != 256) { fprintf(stderr, "kernel_launch: built for a 256-CU device, got %d\n", grid); grid = -1; return; }
    }
    if (grid < 0) return;
    if (hipMemsetAsync((char*)d_ws + WS_CTL, 0, CTL_ZERO_BYTES, stream) != hipSuccess) { fprintf(stderr, "kernel_launch: memset failed\n"); return; }
    Args a{};
    for (int i = 0; i < 31; ++i) a.in.p[i] = (const float*)d_in[i];
    a.out = (float*)d_out; a.ws = (unsigned char*)d_ws;
#if MK_ONE_LAUNCH
    a.ph_lo = 0; a.ph_hi = N_PHASES;
    void* kargs[] = {&a};
    hipError_t e = hipLaunchCooperativeKernel((const void*)mega_fwd, dim3(grid), dim3(NWAVES * 64), kargs, LDS_BYTES, stream);
    if (e != hipSuccess) fprintf(stderr, "kernel_launch: cooperative launch failed: %s\n", hipGetErrorString(e));
#else
    for (int ph = 0; ph < N_PHASES; ++ph) { a.ph_lo = ph; a.ph_hi = ph + 1;
        hipLaunchKernelGGL(mega_fwd, dim3(grid), dim3(NWAVES * 64), LDS_BYTES, stream, a);
        const hipError_t le = hipPeekAtLastError();
        if (le != hipSuccess) { fprintf(stderr, "kernel_launch: launch %d failed: %s\n", ph, hipGetErrorName(le)); break; } }
#endif
}
```

```cpp
#include <hip/hip_runtime.h>
#include <hip/hip_cooperative_groups.h>
#include <cstdio>
#include <cstdint>
namespace cg = cooperative_groups;
#ifndef MK_ONE_LAUNCH
#define MK_ONE_LAUNCH 1
#endif
#ifndef MK_TAILFILL
#define MK_TAILFILL 1
#endif
namespace pg8 {
#define PG8_LAS __attribute__((address_space(3)))
typedef unsigned short bf16_t;
typedef short bf16x8 __attribute__((ext_vector_type(8)));
typedef float f32x4 __attribute__((ext_vector_type(4)));
typedef unsigned u32x4 __attribute__((ext_vector_type(4)));
constexpr int BM = 256, BK = 64, HALF = 128, HTB = HALF * BK * 2  , STAGE_BYTES = 8 * HTB, NXCD = 8, WGM = 8;

__host__ __device__ __forceinline__ int lds_byte(int r, int c) { const int st = (r >> 4) * 2 + (c >> 5), rr = r & 15, cc = c & 31, ob = rr * 64 + cc * 2; return st * 1024 + (ob ^ (((ob >> 9) & 1) << 5)); }
__host__ __device__ __forceinline__ void stage_rc(int b, int& R, int& C) { const int st = b / 1024, sb = b % 1024, swz = sb ^ (((sb >> 9) & 1) << 5); R = (st >> 1) * 16 + swz / 64; C = (st & 1) * 32 + (swz % 64) / 2; }
__host__ __device__ __forceinline__ int perm32(int rho) { const int n = rho >> 4, i = rho & 15; return 8 * (i >> 2) + 4 * n + (i & 3); }

struct Unit { int pm, pn; };
struct Gemm { const bf16_t* A; const bf16_t* Bt; int M, N, K; };

struct StaticOrder {
    int nM, nN, nwg, G, c;
    __host__ __device__ void init(int M, int N, int G_, int c_) { nM = M / BM; nN = N / BM; nwg = nM * nN; G = G_; c = c_; }
    __host__ __device__ bool next(int i, Unit& u) const {
        const long L = (long)i * G + c; if (L >= nwg) return false;
        int wgid = (int)L; { const int q = nwg / NXCD, r = nwg % NXCD, xcd = wgid % NXCD, off = wgid / NXCD; wgid = (xcd < r ? xcd * (q + 1) : r * (q + 1) + (xcd - r) * q) + off; }
        const int nig = WGM * nN, gid = wgid / nig, fm = gid * WGM, gsz = (nM - fm) < WGM ? (nM - fm) : WGM;
        u.pm = fm + ((wgid % nig) % gsz); u.pn = (wgid % nig) / gsz; return true;
    }
    __device__ __forceinline__ void a_ready(const Unit&) const {}
    __device__ __forceinline__ void done(const Unit&) const {}
};

__device__ __forceinline__ unsigned cvt_pk_bf16(float lo, float hi) { unsigned r; asm volatile("v_cvt_pk_bf16_f32 %0, %1, %2" : "=v"(r) : "v"(lo), "v"(hi)); return r; }
typedef float f32x2 __attribute__((ext_vector_type(2)));
__device__ __forceinline__ float sigmoid_f(float v) { return __builtin_amdgcn_rcpf(1.0f + __builtin_amdgcn_exp2f(-1.4426950408889634f * v)); }
struct EpiSwiGlu {
    static constexpr bool PERM = true, AFTER_DRAIN = false;
    bf16_t* O; int ldc;
    __device__ __forceinline__ void operator()(const f32x4 (&acc)[2][2][4][2], const Unit& u, int wr, int wc, int fr, int fq) const {
        const int row0 = u.pm * BM + wr * 64 + fr, col0 = u.pn * HALF + wc * 32 + 8 * fq;
#pragma unroll
        for (int ai = 0; ai < 2; ++ai)
#pragma unroll
            for (int m = 0; m < 4; ++m) { bf16_t* rowp = O + (size_t)(row0 + ai * HALF + m * 16) * ldc + col0;
                const f32x4 g0 = acc[ai][0][m][0], g1 = acc[ai][0][m][1], u0 = acc[ai][1][m][0], u1 = acc[ai][1][m][1];
                float v[8];
#pragma unroll
                for (int i = 0; i < 4; ++i) { v[i] = g0[i] * sigmoid_f(g0[i]) * u0[i]; v[4 + i] = g1[i] * sigmoid_f(g1[i]) * u1[i]; }
                u32x4 w; w.x = cvt_pk_bf16(v[0], v[1]); w.y = cvt_pk_bf16(v[2], v[3]); w.z = cvt_pk_bf16(v[4], v[5]); w.w = cvt_pk_bf16(v[6], v[7]);
                *(u32x4*)rowp = w; }
    }
};
struct EpiResGate {
    static constexpr bool PERM = false, AFTER_DRAIN = false;
    const float* xin; float* xout; const float* gate; float coef; int ldc;
    __device__ __forceinline__ void operator()(const f32x4 (&acc)[2][2][4][2], const Unit& u, int wr, int wc, int fr, int fq) const {
        const int row0 = u.pm * BM + wr * 64 + fr, col0 = u.pn * BM + wc * 32 + 4 * fq;
        f32x4 gv[2][2];
#pragma unroll
        for (int bj = 0; bj < 2; ++bj)
#pragma unroll
            for (int n = 0; n < 2; ++n) gv[bj][n] = *(const f32x4*)(gate + col0 + bj * HALF + n * 16) * coef;
#pragma unroll
        for (int ai = 0; ai < 2; ++ai)
#pragma unroll
            for (int m = 0; m < 4; ++m) { const size_t off = (size_t)(row0 + ai * HALF + m * 16) * ldc + col0;
#pragma unroll
                for (int bj = 0; bj < 2; ++bj)
#pragma unroll
                    for (int n = 0; n < 2; ++n) { const f32x4 xi = *(const f32x4*)(xin + off + bj * HALF + n * 16);
                        *(f32x4*)(xout + off + bj * HALF + n * 16) = xi + gv[bj][n] * acc[ai][bj][m][n]; }
                if (m & 1) asm volatile("" ::: "memory"); }
    }
};
struct EpiWin {
    static constexpr bool PERM = true, AFTER_DRAIN = false;
    bf16_t *Q, *K, *V, *U; const float *qg, *kg; float qscale;
    __device__ __forceinline__ void operator()(const f32x4 (&acc)[2][2][4][2], const Unit& u, int wr, int wc, int fr, int fq) const {
        const int sec = u.pn >> 2, tile = u.pn & 3; const int row0 = u.pm * BM + wr * 64 + fr;
        if (sec < 2) {
            const float* gn = sec == 0 ? qg : kg; const float sc = sec == 0 ? qscale : 1.0f;
            bf16_t* base = sec == 0 ? Q : K;
            f32x4 gv[2][2];
#pragma unroll
            for (int bj = 0; bj < 2; ++bj)
#pragma unroll
                for (int n = 0; n < 2; ++n) gv[bj][n] = *(const f32x4*)(gn + 32 * bj + 8 * fq + 4 * n) * sc;
            const int col0 = tile * 256 + wc * 64 + 8 * fq;
#pragma unroll
            for (int ai = 0; ai < 2; ++ai)
#pragma unroll
                for (int m = 0; m < 4; ++m) {
                    float ss = 0.f;
#pragma unroll
                    for (int bj = 0; bj < 2; ++bj)
#pragma unroll
                        for (int n = 0; n < 2; ++n) { const f32x4 x = acc[ai][bj][m][n]; ss += (x[0] * x[0] + x[1] * x[1]) + (x[2] * x[2] + x[3] * x[3]); }
                    ss += __shfl_xor(ss, 16); ss += __shfl_xor(ss, 32);
                    const float r = __builtin_amdgcn_rsqf(ss * (1.0f / 64.0f) + 1e-6f);
                    bf16_t* rowp = base + (size_t)(row0 + ai * HALF + m * 16) * 1024 + col0;
#pragma unroll
                    for (int bj = 0; bj < 2; ++bj) { const f32x4 v0 = acc[ai][bj][m][0] * gv[bj][0] * r, v1 = acc[ai][bj][m][1] * gv[bj][1] * r;
                        u32x4 w; w.x = cvt_pk_bf16(v0[0], v0[1]); w.y = cvt_pk_bf16(v0[2], v0[3]); w.z = cvt_pk_bf16(v1[0], v1[1]); w.w = cvt_pk_bf16(v1[2], v1[3]);
                        *(u32x4*)(rowp + 32 * bj) = w; }
                }
        } else {
            bf16_t* base = sec == 2 ? V : U; const int col0 = tile * 256 + wc * 32 + 8 * fq;
#pragma unroll
            for (int ai = 0; ai < 2; ++ai)
#pragma unroll
                for (int m = 0; m < 4; ++m) { bf16_t* rowp = base + (size_t)(row0 + ai * HALF + m * 16) * 1024 + col0;
#pragma unroll
                    for (int bj = 0; bj < 2; ++bj) { const f32x4 v0 = acc[ai][bj][m][0], v1 = acc[ai][bj][m][1];
                        u32x4 w; w.x = cvt_pk_bf16(v0[0], v0[1]); w.y = cvt_pk_bf16(v0[2], v0[3]); w.z = cvt_pk_bf16(v1[0], v1[1]); w.w = cvt_pk_bf16(v1[2], v1[3]);
                        *(u32x4*)(rowp + HALF * bj) = w; } }
        }
    }
};
__device__ __forceinline__ float bf_lo(unsigned w) { return __uint_as_float(w << 16); }
__device__ __forceinline__ float bf_hi(unsigned w) { return __uint_as_float(w & 0xffff0000u); }
struct EpiGlu {
    static constexpr bool PERM = true, AFTER_DRAIN = false;
    const bf16_t* YG; bf16_t* CAT; const float* bias;
    __device__ __forceinline__ void operator()(const f32x4 (&acc)[2][2][4][2], const Unit& u, int wr, int wc, int fr, int fq) const {
        const int row0 = u.pm * BM + wr * 64 + fr, col0 = u.pn * BM + wc * 32 + 8 * fq;
        f32x4 bv[2][2];
#pragma unroll
        for (int bj = 0; bj < 2; ++bj)
#pragma unroll
            for (int n = 0; n < 2; ++n) bv[bj][n] = *(const f32x4*)(bias + col0 + bj * HALF + 4 * n);
#pragma unroll
        for (int ai = 0; ai < 2; ++ai)
#pragma unroll
            for (int m = 0; m < 4; ++m) { const size_t row = (size_t)(row0 + ai * HALF + m * 16);
#pragma unroll
                for (int bj = 0; bj < 2; ++bj) { const f32x4 z0 = acc[ai][bj][m][0] + bv[bj][0], z1 = acc[ai][bj][m][1] + bv[bj][1];
                    const u32x4 y = *(const u32x4*)(YG + row * 1024 + col0 + bj * HALF);
                    u32x4 w;
                    w.x = cvt_pk_bf16(bf_lo(y.x) * sigmoid_f(z0[0]), bf_hi(y.x) * sigmoid_f(z0[1])); w.y = cvt_pk_bf16(bf_lo(y.y) * sigmoid_f(z0[2]), bf_hi(y.y) * sigmoid_f(z0[3]));
                    w.z = cvt_pk_bf16(bf_lo(y.z) * sigmoid_f(z1[0]), bf_hi(y.z) * sigmoid_f(z1[1])); w.w = cvt_pk_bf16(bf_lo(y.w) * sigmoid_f(z1[2]), bf_hi(y.w) * sigmoid_f(z1[3]));
                    *(u32x4*)(CAT + row * 2048 + 1024 + col0 + bj * HALF) = w; } }
    }
};

template <class Epi, class Sched, bool ALIGN_EPI = false, bool SP2 = false>
__device__ __forceinline__ void gemm_phase(PG8_LAS unsigned char* lds, const Gemm g, const Sched& S, const Epi& E) {
    int tid_ = threadIdx.x; asm volatile("" : "+v"(tid_));
    const int tid = tid_, wid = __builtin_amdgcn_readfirstlane(tid >> 6), lane = tid & 63, wr = wid >> 2, wc = wid & 3, fr = lane & 15, fq = lane >> 4;
    const int K = g.K, nt = K / BK;
    unsigned voffA[2], voffB[2];
#pragma unroll
    for (int i = 0; i < 2; ++i) { int R, C; stage_rc(tid * 16 + i * 8192, R, C); const int Rb = Epi::PERM ? ((R & ~31) + perm32(R & 31)) : R;
        voffA[i] = (unsigned)(R * K + C) * 2u; voffB[i] = (unsigned)(Rb * K + C) * 2u; }
    const size_t kstep = (size_t)(BK * 2);
    const size_t hstep = (size_t)HALF * K * 2;
    const size_t tstep = 2 * hstep;
    const unsigned ldsw = (unsigned)wid * 1024u;
    const int aoff = lds_byte(wr * 64 + fr, fq * 8), boff = lds_byte(wc * 32 + fr, fq * 8);
#define PG8_SA(b, h) (((b) * 2 + (h)) * HTB)
#define PG8_SB(b, h) ((4 + (b) * 2 + (h)) * HTB)
#define PG8_STAGE(bufoff, gbase, voff) do { _Pragma("unroll") for (int _i = 0; _i < 2; ++_i) \
        __builtin_amdgcn_global_load_lds((const unsigned*)((const char*)(gbase) + (voff)[_i]), (PG8_LAS unsigned*)(lds + (bufoff) + ldsw + _i * 8192), 16, 0, 0); } while (0)
#define PG8_LDA(dst, b, h) do { _Pragma("unroll") for (int m = 0; m < 4; ++m) _Pragma("unroll") for (int k = 0; k < 2; ++k) dst[m][k] = *(const PG8_LAS bf16x8*)(lds + PG8_SA(b, h) + aoff + m * 2048 + k * 1024); } while (0)
#define PG8_LDB(dst, b, h) do { _Pragma("unroll") for (int n = 0; n < 2; ++n) _Pragma("unroll") for (int k = 0; k < 2; ++k) dst[n][k] = *(const PG8_LAS bf16x8*)(lds + PG8_SB(b, h) + boff + n * 2048 + k * 1024); } while (0)
#define PG8_MMA(ai, bj, At, Bt) do { __builtin_amdgcn_s_setprio(1); _Pragma("unroll") for (int m = 0; m < 4; ++m) _Pragma("unroll") for (int n = 0; n < 2; ++n) _Pragma("unroll") for (int k = 0; k < 2; ++k) \
        acc[ai][bj][m][n] = __builtin_amdgcn_mfma_f32_16x16x32_bf16(Bt[n][k], At[m][k], acc[ai][bj][m][n], 0, 0, 0); __builtin_amdgcn_s_setprio(0); } while (0)
#define PG8_WAIT_V(n) asm volatile("s_waitcnt vmcnt(" #n ")" ::: "memory")
#define PG8_WAIT_L(n) asm volatile("s_waitcnt lgkmcnt(" #n ")" ::: "memory")
#define PG8_BAR __builtin_amdgcn_s_barrier()
#define PG8_SCHED __builtin_amdgcn_sched_barrier(0)
    Unit cur, nxt; int ui = 0;
    if (!S.next(0, cur)) return;
    f32x4 acc[2][2][4][2];
#pragma unroll
    for (int a = 0; a < 2; ++a)
#pragma unroll
        for (int b = 0; b < 2; ++b)
#pragma unroll
            for (int m = 0; m < 4; ++m)
#pragma unroll
                for (int n = 0; n < 2; ++n) acc[a][b][m][n] = (f32x4){0.f, 0.f, 0.f, 0.f};
    bf16x8 At[4][2], B0[2][2], B1[2][2];
    const char* cA = (const char*)g.A + (size_t)cur.pm * tstep; const char* cB = (const char*)g.Bt + (size_t)cur.pn * tstep;
    S.a_ready(cur);
    if constexpr (SP2) {
        PG8_STAGE(PG8_SB(0, 0), cB, voffB); PG8_STAGE(PG8_SB(0, 1), cB + hstep, voffB); PG8_STAGE(PG8_SA(0, 0), cA, voffA); PG8_STAGE(PG8_SA(0, 1), cA + hstep, voffA);
        if (wr == 1) PG8_BAR;
        PG8_WAIT_V(2); PG8_BAR;
        PG8_STAGE(PG8_SB(1, 0), cB + kstep, voffB); PG8_STAGE(PG8_SA(1, 0), cA + kstep, voffA); PG8_STAGE(PG8_SB(1, 1), cB + hstep + kstep, voffB);
        PG8_WAIT_V(6); PG8_BAR;
    } else {
        PG8_STAGE(PG8_SB(0, 0), cB, voffB); PG8_STAGE(PG8_SA(0, 0), cA, voffA); PG8_STAGE(PG8_SB(0, 1), cB + hstep, voffB); PG8_STAGE(PG8_SA(0, 1), cA + hstep, voffA);
        if (wr == 1) PG8_BAR;
        PG8_WAIT_V(4); PG8_BAR;
        PG8_STAGE(PG8_SB(1, 0), cB + kstep, voffB); PG8_STAGE(PG8_SA(1, 0), cA + kstep, voffA); PG8_STAGE(PG8_SB(1, 1), cB + hstep + kstep, voffB);
        PG8_WAIT_V(6); PG8_BAR;
    }
    for (;;) {
        const bool has_next = S.next(ui + 1, nxt);
        const char* nA = has_next ? (const char*)g.A + (size_t)nxt.pm * tstep : cA; const char* nB = has_next ? (const char*)g.Bt + (size_t)nxt.pn * tstep : cB;
        for (int t = 0; t < nt; t += 2) {
            const bool last = (t == nt - 2);
            const char* a1 = cA + (size_t)(t + 1) * kstep;
            const char* a2 = last ? nA : cA + (size_t)(t + 2) * kstep; const char* b2 = last ? nB : cB + (size_t)(t + 2) * kstep;
            const char* a3 = a2 + kstep; const char* b3 = b2 + kstep;
            if (last && has_next) S.a_ready(nxt);
            if constexpr (SP2) {
            PG8_LDB(B0, 0, 0); PG8_LDB(B1, 0, 1); PG8_SCHED; PG8_LDA(At, 0, 0); PG8_STAGE(PG8_SA(1, 1), a1 + hstep, voffA);
            PG8_WAIT_V(8); PG8_WAIT_L(0); PG8_BAR; PG8_MMA(0, 0, At, B0); PG8_MMA(0, 1, At, B1); PG8_BAR; PG8_SCHED;
            PG8_LDA(At, 0, 1); PG8_STAGE(PG8_SB(0, 0), b2, voffB); PG8_STAGE(PG8_SB(0, 1), b2 + hstep, voffB); PG8_STAGE(PG8_SA(0, 0), a2, voffA);
            PG8_WAIT_V(8); PG8_WAIT_L(0); PG8_BAR; PG8_MMA(1, 0, At, B0); PG8_MMA(1, 1, At, B1); PG8_BAR; PG8_SCHED;
            PG8_LDB(B0, 1, 0); PG8_LDB(B1, 1, 1); PG8_SCHED; PG8_LDA(At, 1, 0); PG8_STAGE(PG8_SA(0, 1), a2 + hstep, voffA);
            PG8_WAIT_V(8); PG8_WAIT_L(0); PG8_BAR; PG8_MMA(0, 0, At, B0); PG8_MMA(0, 1, At, B1); PG8_BAR; PG8_SCHED;
            PG8_LDA(At, 1, 1); PG8_STAGE(PG8_SB(1, 0), b3, voffB); PG8_STAGE(PG8_SB(1, 1), b3 + hstep, voffB); PG8_STAGE(PG8_SA(1, 0), a3, voffA);
            PG8_WAIT_V(8); PG8_WAIT_L(0); PG8_BAR; PG8_MMA(1, 0, At, B0); PG8_MMA(1, 1, At, B1); PG8_BAR; PG8_SCHED;
            } else {
            PG8_LDB(B0, 0, 0); PG8_SCHED; PG8_LDA(At, 0, 0); PG8_STAGE(PG8_SA(1, 1), a1 + hstep, voffA);
            PG8_WAIT_L(8); PG8_BAR; PG8_WAIT_L(0); PG8_MMA(0, 0, At, B0); PG8_BAR; PG8_SCHED;
            PG8_LDB(B1, 0, 1); PG8_STAGE(PG8_SB(0, 0), b2, voffB);
            PG8_BAR; PG8_WAIT_L(0); PG8_MMA(0, 1, At, B1); PG8_BAR;
            PG8_LDA(At, 0, 1); PG8_STAGE(PG8_SA(0, 0), a2, voffA);
            PG8_BAR; PG8_WAIT_L(0); PG8_MMA(1, 0, At, B0); PG8_BAR; PG8_SCHED;
            PG8_STAGE(PG8_SB(0, 1), b2 + hstep, voffB);
            PG8_WAIT_V(6); PG8_BAR; PG8_MMA(1, 1, At, B1); PG8_BAR;
            PG8_LDB(B0, 1, 0); PG8_SCHED; PG8_LDA(At, 1, 0); PG8_STAGE(PG8_SA(0, 1), a2 + hstep, voffA);
            PG8_WAIT_L(8); PG8_BAR; PG8_WAIT_L(0); PG8_MMA(0, 0, At, B0); PG8_BAR; PG8_SCHED;
            PG8_LDB(B1, 1, 1); PG8_STAGE(PG8_SB(1, 0), b3, voffB);
            PG8_BAR; PG8_WAIT_L(0); PG8_MMA(0, 1, At, B1); PG8_BAR;
            PG8_LDA(At, 1, 1); PG8_STAGE(PG8_SA(1, 0), a3, voffA);
            PG8_BAR; PG8_WAIT_L(0); PG8_MMA(1, 0, At, B0); PG8_BAR; PG8_SCHED;
            PG8_STAGE(PG8_SB(1, 1), b3 + hstep, voffB);
            PG8_WAIT_V(6); PG8_BAR; PG8_MMA(1, 1, At, B1); PG8_BAR;
            }
        }
        if constexpr (ALIGN_EPI) { if (wr == 0) PG8_BAR; }
        if constexpr (!Epi::AFTER_DRAIN) { E(acc, cur, wr, wc, fr, fq); S.done(cur); }
        if (!has_next) break;
#pragma unroll
        for (int a = 0; a < 2; ++a)
#pragma unroll
            for (int b = 0; b < 2; ++b)
#pragma unroll
                for (int m = 0; m < 4; ++m)
#pragma unroll
                    for (int n = 0; n < 2; ++n) acc[a][b][m][n] = (f32x4){0.f, 0.f, 0.f, 0.f};
        cur = nxt; cA = nA; cB = nB; ++ui;
        if constexpr (ALIGN_EPI) { if (wr == 1) PG8_BAR; }
    }
    PG8_WAIT_V(0);
    if constexpr (!ALIGN_EPI) { if (wr == 0) PG8_BAR; }
    PG8_BAR;
    if constexpr (Epi::AFTER_DRAIN) { E.fused(acc, cur, wr, wc, fr, fq, lds, wid, lane); S.done(cur); }
#undef PG8_SA
#undef PG8_SB
#undef PG8_STAGE
#undef PG8_LDA
#undef PG8_LDB
#undef PG8_MMA
#undef PG8_WAIT_V
#undef PG8_WAIT_L
#undef PG8_BAR
#undef PG8_SCHED
}
}
#include <hip/hip_bf16.h>
#include <cmath>
namespace attn_body {
using bf16=__hip_bfloat16;
using bf16x8=__attribute__((ext_vector_type(8)))short;
using s16x4=__attribute__((ext_vector_type(4)))short;
using f32x16=__attribute__((ext_vector_type(16)))float;
using u32x4=__attribute__((ext_vector_type(4)))unsigned;
constexpr int SEQ=8192,D=64,DM=1024,OPITCH=2048;
constexpr int NW=8,QBLK=32,QB=QBLK*NW,KVBLK=64,NQB=SEQ/QB;
constexpr int ATTN_PITCH=DM, ATTN_UNIT_ROWS=QB;
__device__ __forceinline__ int crow(int r,int hi){return (r&3)+8*(r>>2)+4*hi;}
#define SBAR() __builtin_amdgcn_sched_barrier(0)
typedef const __attribute__((address_space(3))) float* lds_cfptr;
__device__ __forceinline__ void cmask(f32x16&p0,f32x16&p1,int jb,int qrel,int hi,lds_cfptr bt){
  const float NEG=-INFINITY; int kb=64*jb+4*hi;
  #pragma unroll
  for(int r=0;r<16;++r){int kv=kb+(r&3)+8*(r>>2); int d0=qrel-kv, d1=d0-32;
    unsigned i0=(unsigned)d0<127u?(unsigned)d0:127u, i1=(unsigned)d1<127u?(unsigned)d1:127u;
    float b0=bt[i0], b1=bt[i1];
    p0[r]=(d0<0)?NEG:p0[r]+b0; p1[r]=(d1<0)?NEG:p1[r]+b1;}
}

constexpr int NSLOT=3, SLOTB=8192;
constexpr int LDS_K=0, LDS_V=NSLOT*SLOTB, LDS_WS=2*NSLOT*SLOTB, LDS_OST=LDS_WS+NW*64*4, LDS_BT=LDS_OST+NW*4096, LDS_BYTES=LDS_BT+512;
constexpr float C2=0.125f*1.4426950408889634f;
__device__ __forceinline__ void glds16(const void*gsrc,unsigned lds_dst){unsigned keep;
  asm volatile("s_mov_b32 %0, m0\n\ts_mov_b32 m0, %2\n\ts_nop 0\n\tglobal_load_lds_dwordx4 %1, off\n\ts_mov_b32 m0, %0":"=&s"(keep):"v"(gsrc),"s"(lds_dst):"memory");}
__device__ __forceinline__ float max3f(float a,float b,float c){float r;asm("v_max3_f32 %0, %1, %2, %3":"=v"(r):"v"(a),"v"(b),"v"(c));return r;}
__device__ __forceinline__ float max2f(float a,float b){float r;asm("v_max_f32_e32 %0, %1, %2":"=v"(r):"v"(a),"v"(b));return r;}
__device__ __forceinline__ float fadd_s(float a,float b){float r;asm("v_add_f32_e32 %0, %1, %2":"=v"(r):"v"(a),"v"(b));return r;}
__device__ __forceinline__ float fsub_s(float a,float b){float r;asm("v_sub_f32_e32 %0, %1, %2":"=v"(r):"v"(a),"v"(b));return r;}
typedef float f32x2_t __attribute__((ext_vector_type(2))); typedef __bf16 bf16x2_t __attribute__((ext_vector_type(2)));
__device__ __forceinline__ unsigned cvtpk_s(float lo,float hi){f32x2_t v={lo,hi};bf16x2_t b=__builtin_convertvector(v,bf16x2_t);return __builtin_bit_cast(unsigned,b);}
#define WAIT_BAR(N) asm volatile("s_waitcnt vmcnt(" #N ") lgkmcnt(0)\n\ts_barrier":::"memory")

__device__ __forceinline__ void qkt(f32x16&p0,f32x16&p1,const char*Kslot,const bf16x8*qr,const f32x16&negm,int r32,int hi){
  const char*kb=Kslot+hi*1024+r32*16;
  #pragma unroll
  for(int d0=0;d0<4;++d0){
    const bf16x8 b0=*reinterpret_cast<const bf16x8*>(kb+d0*2048);
    const bf16x8 b1=*reinterpret_cast<const bf16x8*>(kb+d0*2048+512);
    if(d0==0){p0=__builtin_amdgcn_mfma_f32_32x32x16_bf16(b0,qr[0],negm,0,0,0);p1=__builtin_amdgcn_mfma_f32_32x32x16_bf16(b1,qr[0],negm,0,0,0);}
    else{p0=__builtin_amdgcn_mfma_f32_32x32x16_bf16(b0,qr[d0],p0,0,0,0);p1=__builtin_amdgcn_mfma_f32_32x32x16_bf16(b1,qr[d0],p1,0,0,0);}}
}
typedef __attribute__((address_space(3))) const char* lds_cptr;
typedef short v4i16_t __attribute__((ext_vector_type(4)));
__device__ __forceinline__ void kload8(bf16x8*kf,lds_cptr kp){
  kf[0]=*(const __attribute__((address_space(3))) bf16x8*)(kp);      kf[1]=*(const __attribute__((address_space(3))) bf16x8*)(kp+512);
  kf[2]=*(const __attribute__((address_space(3))) bf16x8*)(kp+2048); kf[3]=*(const __attribute__((address_space(3))) bf16x8*)(kp+2560);
  kf[4]=*(const __attribute__((address_space(3))) bf16x8*)(kp+4096); kf[5]=*(const __attribute__((address_space(3))) bf16x8*)(kp+4608);
  kf[6]=*(const __attribute__((address_space(3))) bf16x8*)(kp+6144); kf[7]=*(const __attribute__((address_space(3))) bf16x8*)(kp+6656);
}
__device__ __forceinline__ void kload2(bf16x8*kf,lds_cptr kp,int j){ kf[2*j]=*(const __attribute__((address_space(3))) bf16x8*)(kp+j*2048); kf[2*j+1]=*(const __attribute__((address_space(3))) bf16x8*)(kp+j*2048+512); }
__device__ __forceinline__ s16x4 vtr(lds_cptr p){ return __builtin_bit_cast(s16x4,__builtin_amdgcn_ds_read_tr16_b64_v4i16((__attribute__((address_space(3))) v4i16_t*)p)); }
__device__ __forceinline__ float rowmax(const f32x16&p0,const f32x16&p1){
  float a=max3f(p0[0],p0[1],p1[0]),b=max3f(p0[2],p0[3],p1[1]);a=max3f(a,p1[2],p1[3]);
  #pragma unroll
  for(int r=4;r<16;r+=4){a=max3f(a,p0[r],p0[r+1]);b=max3f(b,p0[r+2],p0[r+3]);a=max3f(a,p1[r],p1[r+1]);b=max3f(b,p1[r+2],p1[r+3]);}
  const float m=max2f(a,b);
  auto rr=__builtin_amdgcn_permlane32_swap(__float_as_uint(m),__float_as_uint(m),false,false);
  return max2f(__uint_as_float(rr[0]),__uint_as_float(rr[1]));
}
__device__ __forceinline__ void pv(f32x16*o,int vb,bf16x8 pa0,bf16x8 pa1,bf16x8 pa2,bf16x8 pa3){
  #pragma unroll
  for(int d0=0;d0<2;++d0){s16x4 lo[4],hi[4];
    #pragma unroll
    for(int ks=0;ks<4;++ks){
      asm volatile("ds_read_b64_tr_b16 %0,%1 offset:%c2":"=&v"(lo[ks]):"v"(vb),"i"(d0*4096+ks*1024):"memory");
      asm volatile("ds_read_b64_tr_b16 %0,%1 offset:%c2":"=&v"(hi[ks]):"v"(vb),"i"(d0*4096+ks*1024+512):"memory");}
    asm volatile("s_waitcnt lgkmcnt(0)":::"memory");SBAR();
    #define PK(k) (bf16x8){lo[k][0],lo[k][1],lo[k][2],lo[k][3],hi[k][0],hi[k][1],hi[k][2],hi[k][3]}
    o[d0]=__builtin_amdgcn_mfma_f32_32x32x16_bf16(pa0,PK(0),o[d0],0,0,0);
    o[d0]=__builtin_amdgcn_mfma_f32_32x32x16_bf16(pa1,PK(1),o[d0],0,0,0);
    o[d0]=__builtin_amdgcn_mfma_f32_32x32x16_bf16(pa2,PK(2),o[d0],0,0,0);
    o[d0]=__builtin_amdgcn_mfma_f32_32x32x16_bf16(pa3,PK(3),o[d0],0,0,0);
    #undef PK
  }
}

#ifndef ATTN_STORE16
#define ATTN_STORE16(p,v) (*(u32x4*)(p)=(v))
#endif
template<int THRL> __device__ __forceinline__ void attn_unit(int qcol,int vcol,int ocol,int hb,int qb,const bf16*Q,const bf16*K,const bf16*V,bf16*O,const float*biasd,char*shm){
  int tid_=threadIdx.x; asm volatile("":"+v"(tid_)); const int tid=tid_,lane=tid&63,r32=lane&31,hi=lane>>5; const int wid=__builtin_amdgcn_readfirstlane(tid>>6);
  const long rowbase=0; const int q0=qb*QB;
  const bf16*Qw=Q+(rowbase+q0+wid*QBLK)*DM+qcol;
  const bf16*Kh=K+rowbase*DM+qcol,*Vh=V+rowbase*DM+vcol;
  { __attribute__((address_space(3))) float* btw=(__attribute__((address_space(3))) float*)(lds_cptr)shm+LDS_BT/4; if(tid<128)btw[tid]=biasd[hb*128+tid]; }
  const lds_cfptr btab=(lds_cfptr)((lds_cptr)shm+LDS_BT);
  const unsigned lds0=(unsigned)(uintptr_t)shm;
  float*wsf=(float*)(shm+LDS_WS)+wid*64;
  const bf16*ksrc=Kh+(long)lane*DM+wid*8;
  const bf16*vsrc=Vh+(long)(16*(wid&3)+(lane>>2))*DM+(wid>>2)*32+(lane&3)*8;
  const unsigned kdst=lds0+LDS_K+wid*1024, vdst=lds0+LDS_V+wid*1024;
  #define DMA_K(t,slot) glds16(ksrc+(long)(t)*KVBLK*DM,(unsigned)__builtin_amdgcn_readfirstlane(kdst+(slot)))
  #define DMA_V(t,slot) glds16(vsrc+(long)(t)*KVBLK*DM,(unsigned)__builtin_amdgcn_readfirstlane(vdst+(slot)))
  const int vb0=(int)(lds0+LDS_V)+((lane>>4)&1)*32+(lane&3)*8+(4*hi+((lane&15)>>2))*64;
  const char*Kbase=shm+LDS_K; bf16x8 kf[8];
  const lds_cptr shm3=(lds_cptr)shm; const lds_cptr kp0=shm3+LDS_K+hi*1024+r32*16; const lds_cptr vp0=shm3+LDS_V+((lane>>4)&1)*32+(lane&3)*8+(4*hi+((lane&15)>>2))*64;
  const int NT=(q0+QB)/KVBLK;
  DMA_K(0,0);DMA_V(0,0);DMA_K(1,SLOTB);
  bf16x8 qr[4];
  #pragma unroll
  for(int d0=0;d0<4;++d0)qr[d0]=*reinterpret_cast<const bf16x8*>(&Qw[(long)r32*DM+d0*16+hi*8]);
  float mhat=0.f,l_reg=0.f;f32x16 o[2];o[0]=f32x16{};o[1]=f32x16{};f32x16 negm=f32x16{};asm volatile("":"+v"(negm));
  const int qrel=wid*QBLK+r32;
  #define CMASK(P0,P1,t) do{int jb_=(t)-(NT-4); if(jb_>=-2)cmask(P0,P1,jb_,qrel,hi,btab);}while(0)
  bool resc=false;
  #define START(P0,P1) do{ const float rm=rowmax(P0,P1); resc=false; \
    { const float dl=rm; mhat=fadd_s(mhat,dl); \
      _Pragma("unroll") for(int r=0;r<16;++r){P0[r]=fsub_s(P0[r],dl);P1[r]=fsub_s(P1[r],dl);} \
      _Pragma("unroll") for(int r=0;r<16;++r)negm[r]=-mhat; asm volatile("":"+v"(negm)); } \
    _Pragma("unroll") for(int r=0;r<16;++r)P0[r]=__builtin_amdgcn_exp2f(P0[r]); }while(0)
  #define RESC() do{ if(resc){ asm volatile("s_waitcnt lgkmcnt(0)":::"memory"); \
      _Pragma("unroll") for(int d_=0;d_<2;++d_) _Pragma("unroll") for(int r=0;r<16;++r)o[d_][r]*=wsf[crow(r,hi)]; } }while(0)
  f32x16 pA0,pA1,pB0,pB1;
  int sl_prev=0,sl_cur=0,sl_next=SLOTB;
  #define ROT() do{sl_prev=sl_cur;sl_cur=sl_next;sl_next=(sl_next==(NSLOT-1)*SLOTB)?0:sl_next+SLOTB;}while(0)
  DMA_K(2,2*SLOTB);
  WAIT_BAR(3);
  qkt(pA0,pA1,Kbase,qr,negm,r32,hi);asm volatile("s_nop 15\n\ts_nop 7":"+v"(pA0),"+v"(pA1));CMASK(pA0,pA1,0);
  START(pA0,pA1);
  _Pragma("unroll") for(int r=0;r<16;++r)pA1[r]=__builtin_amdgcn_exp2f(pA1[r]);
  WAIT_BAR(0);
  DMA_K(3,0);DMA_V(1,SLOTB);
  ROT();
  kload8(kf,kp0+sl_cur);
  WAIT_BAR(2);
  s16x4 vlo[8],vhi[8]; u32x4 pw0,pw1,pw2,pw3;
  #define PKW(P,B) cvtpk_s(P[B],P[B+1])
  #define PAF(k) __builtin_bit_cast(bf16x8,pw##k)
  #define VFR(i) (bf16x8){vlo[i][0],vlo[i][1],vlo[i][2],vlo[i][3],vhi[i][0],vhi[i][1],vhi[i][2],vhi[i][3]}
  #define PIN(x) asm volatile("":"+v"(x))
  #define MX3(a,b,c) __builtin_fmaxf(__builtin_fmaxf((a),(b)),(c))
  #define GAPA(MF,A0,A1,A2,A3,W0,W1,PW) do{ MF; sacc+=A0; sacc+=A1; sacc+=A2; sacc+=A3; PIN(sacc); W0; W1; PIN(PW); SBAR(); }while(0)
  #define EX(v) __builtin_amdgcn_exp2f(v)
  #define GAPB(MF,X,B) do{ MF; X[B]=EX(X[B]); X[B+1]=EX(X[B+1]); X[B+2]=EX(X[B+2]); X[B+3]=EX(X[B+3]); PIN(X); SBAR(); }while(0)
  #define VRD(i) do{ vlo[i]=vtr(vp_+(((i)>>2)*4096+((i)&3)*1024)); vhi[i]=vtr(vp_+(((i)>>2)*4096+((i)&3)*1024+512)); }while(0)
  #define KRD(G,j) do{ if(G){ kload2(kf,kp0+sl_next,j); SBAR(); } }while(0)
  #define STEP(C0,C1,P0,P1,t,GK,GV,GL) do{ SBAR(); \
    const lds_cptr vp_=vp0+sl_prev; \
    VRD(0); SBAR(); float sacc=(P0[0]+P0[1]); \
    GAPA(C0=__builtin_amdgcn_mfma_f32_32x32x16_bf16(kf[0],qr[0],negm,0,0,0), P0[2],P0[3],P0[4],P0[5],     pw0[0]=PKW(P0,0), pw0[1]=PKW(P0,2), pw0); \
    VRD(4); SBAR(); GAPA(C1=__builtin_amdgcn_mfma_f32_32x32x16_bf16(kf[1],qr[0],negm,0,0,0), P0[6],P0[7],P0[8],P0[9],     pw0[2]=PKW(P0,4), pw0[3]=PKW(P0,6), pw0); \
    VRD(1); SBAR(); GAPA(C0=__builtin_amdgcn_mfma_f32_32x32x16_bf16(kf[2],qr[1],C0,0,0,0),   P0[10],P0[11],P0[12],P0[13], pw1[0]=PKW(P0,8), pw1[1]=PKW(P0,10), pw1); \
    VRD(5); SBAR(); GAPA(C1=__builtin_amdgcn_mfma_f32_32x32x16_bf16(kf[3],qr[1],C1,0,0,0),   P0[14],P0[15],P1[0],P1[1],   pw1[2]=PKW(P0,12),pw1[3]=PKW(P0,14), pw1); \
    VRD(2); SBAR(); GAPA(C0=__builtin_amdgcn_mfma_f32_32x32x16_bf16(kf[4],qr[2],C0,0,0,0),   P1[2],P1[3],P1[4],P1[5],     pw2[0]=PKW(P1,0), pw2[1]=PKW(P1,2), pw2); \
    VRD(6); SBAR(); GAPA(C1=__builtin_amdgcn_mfma_f32_32x32x16_bf16(kf[5],qr[2],C1,0,0,0),   P1[6],P1[7],P1[8],P1[9],     pw2[2]=PKW(P1,4), pw2[3]=PKW(P1,6), pw2); \
    VRD(3); SBAR(); GAPA(C0=__builtin_amdgcn_mfma_f32_32x32x16_bf16(kf[6],qr[3],C0,0,0,0),   P1[10],P1[11],P1[12],P1[13], pw3[0]=PKW(P1,8), pw3[1]=PKW(P1,10), pw3); \
    VRD(7); SBAR(); GAPA(C1=__builtin_amdgcn_mfma_f32_32x32x16_bf16(kf[7],qr[3],C1,0,0,0),   P1[14],P1[15],0.f,0.f,       pw3[2]=PKW(P1,12),pw3[3]=PKW(P1,14), pw3); \
    l_reg+=sacc; \
    if(GK){DMA_K((t)+3,sl_cur);} if(GV){DMA_V((t)+1,sl_next);} \
    CMASK(C0,C1,t); \
    { float a=MX3(C0[0],C0[1],C1[0]),b=MX3(C0[2],C0[3],C1[1]); a=MX3(a,C1[2],C1[3]); \
      _Pragma("unroll") for(int r=4;r<16;r+=4){a=MX3(a,C0[r],C0[r+1]);b=MX3(b,C0[r+2],C0[r+3]);a=MX3(a,C1[r],C1[r+1]);b=MX3(b,C1[r+2],C1[r+3]);} \
      float rm=__builtin_fmaxf(a,b); { auto rr=__builtin_amdgcn_permlane32_swap(__float_as_uint(rm),__float_as_uint(rm),false,false); rm=__builtin_fmaxf(__uint_as_float(rr[0]),__uint_as_float(rr[1])); } \
      resc=false; \
      if(__builtin_expect(__any(rm>(float)THRL),0)){ const float dl=__builtin_fmaxf(rm,0.f); mhat+=dl; \
        _Pragma("unroll") for(int r=0;r<16;++r){C0[r]-=dl;C1[r]-=dl;} \
        _Pragma("unroll") for(int r=0;r<16;++r)negm[r]=-mhat; asm volatile("":"+v"(negm)); \
        const float f=__builtin_amdgcn_exp2f(-dl); l_reg*=f; if(hi==0)wsf[r32]=f; resc=true; } } \
    SBAR(); \
    GAPB(o[0]=__builtin_amdgcn_mfma_f32_32x32x16_bf16(PAF(0),VFR(0),o[0],0,0,0), C0,0); \
    GAPB(o[1]=__builtin_amdgcn_mfma_f32_32x32x16_bf16(PAF(0),VFR(4),o[1],0,0,0), C0,4); \
    KRD(GL,0); GAPB(o[0]=__builtin_amdgcn_mfma_f32_32x32x16_bf16(PAF(1),VFR(1),o[0],0,0,0), C0,8); \
    KRD(GL,1); GAPB(o[1]=__builtin_amdgcn_mfma_f32_32x32x16_bf16(PAF(1),VFR(5),o[1],0,0,0), C0,12); \
    KRD(GL,2); GAPB(o[0]=__builtin_amdgcn_mfma_f32_32x32x16_bf16(PAF(2),VFR(2),o[0],0,0,0), C1,0); \
    KRD(GL,3); GAPB(o[1]=__builtin_amdgcn_mfma_f32_32x32x16_bf16(PAF(2),VFR(6),o[1],0,0,0), C1,4); \
    GAPB(o[0]=__builtin_amdgcn_mfma_f32_32x32x16_bf16(PAF(3),VFR(3),o[0],0,0,0), C1,8); \
    GAPB(o[1]=__builtin_amdgcn_mfma_f32_32x32x16_bf16(PAF(3),VFR(7),o[1],0,0,0), C1,12); \
    }while(0)
  int t=1;
  #undef CMASK
  #define CMASK(P0,P1,t) do{}while(0)
  for(;t+7<NT;t+=2){
    STEP(pB0,pB1,pA0,pA1,t,true,true,true);     WAIT_BAR(2); RESC(); ROT();
    STEP(pA0,pA1,pB0,pB1,t+1,true,true,true);   WAIT_BAR(2); RESC(); ROT();
  }
  #undef CMASK
  #define CMASK(P0,P1,t) do{int jb_=(t)-(NT-4); if(jb_>=-2)cmask(P0,P1,jb_,qrel,hi,btab);}while(0)
  #define ENDW(tt) do{ if((tt)+3<NT){WAIT_BAR(2);} else if((tt)+2<NT){WAIT_BAR(1);} else {WAIT_BAR(0);} }while(0)
  for(;t+1<NT;t+=2){
    STEP(pB0,pB1,pA0,pA1,t,(t+3<NT),(t+1<NT),(t+1<NT));       ENDW(t);   RESC(); ROT();
    STEP(pA0,pA1,pB0,pB1,t+1,(t+4<NT),(t+2<NT),(t+2<NT));     ENDW(t+1); RESC(); ROT();
  }
  STEP(pB0,pB1,pA0,pA1,NT-1,false,false,false); RESC();
  { float sacc=pB0[0]+pB0[1]; _Pragma("unroll") for(int r=2;r<16;++r)sacc+=pB0[r]; _Pragma("unroll") for(int r=0;r<16;++r)sacc+=pB1[r]; l_reg+=sacc;
    pw0=(u32x4){PKW(pB0,0),PKW(pB0,2),PKW(pB0,4),PKW(pB0,6)};pw1=(u32x4){PKW(pB0,8),PKW(pB0,10),PKW(pB0,12),PKW(pB0,14)};pw2=(u32x4){PKW(pB1,0),PKW(pB1,2),PKW(pB1,4),PKW(pB1,6)};pw3=(u32x4){PKW(pB1,8),PKW(pB1,10),PKW(pB1,12),PKW(pB1,14)};
    SBAR(); pv(o,vb0+sl_cur,PAF(0),PAF(1),PAF(2),PAF(3)); }
  #undef PKW
  #undef PAF
  #undef VFR
  #undef PIN
  #undef MX3
  #undef GAPA
  #undef GAPB
  #undef EX
  #undef VRD
  #undef KRD
  #undef STEP
  #undef ENDW
  {auto rr=__builtin_amdgcn_permlane32_swap(__float_as_uint(l_reg),__float_as_uint(l_reg),false,false);l_reg=__uint_as_float(rr[0])+__uint_as_float(rr[1]);}
  if(hi==0)wsf[32+r32]=l_reg;asm volatile("s_waitcnt lgkmcnt(0)":::"memory");
  float rli[16];
  #pragma unroll
  for(int r=0;r<16;++r)rli[r]=__builtin_amdgcn_rcpf(wsf[32+crow(r,hi)]);
  bf16*Ow=O+(rowbase+q0+wid*QBLK)*OPITCH+ocol;
  { bf16*stg=(bf16*)(shm+LDS_OST)+wid*2048;
    #pragma unroll
    for(int r=0;r<16;++r){const int orow=crow(r,hi);
      #pragma unroll
      for(int d0=0;d0<2;++d0)stg[orow*64+d0*32+r32]=__float2bfloat16(o[d0][r]*rli[r]);}
    asm volatile("s_waitcnt lgkmcnt(0)":::"memory");
    #pragma unroll
    for(int i=0;i<4;++i){const int row=i*8+(lane>>3),ch=lane&7; const u32x4 v=*(const u32x4*)(stg+row*64+ch*8); ATTN_STORE16(Ow+(long)row*OPITCH+ch*8,v);} }
  asm volatile("s_waitcnt lgkmcnt(0)\n\ts_barrier":::"memory");
  #undef DMA_K
  #undef DMA_V
  #undef CMASK
  #undef START
  #undef RESC
  #undef ROT
}
constexpr int ATTN_LDS_BYTES=LDS_BYTES;
struct AttnTensors { const bf16* Q; const bf16* K; const bf16* V; bf16* O; const float* biasd; };
template<int THRL=8> __device__ __forceinline__ void attn_phase(char*lds,const AttnTensors&T,int vcu){
  const int inst=vcu>>3, s=vcu&7;
  for(int i=0;i<4;++i){ const int qb=(i==0)?s:(i==1)?15-s:(i==2)?16+s:31-s;
    attn_unit<THRL>((inst>>1)*64,(inst>>2)*128+(inst&1)*64,inst*64,inst>>2,qb,T.Q,T.K,T.V,T.O,T.biasd,lds); }
}
#undef SBAR
#undef WAIT_BAR
}
constexpr int NWAVES = 8;
constexpr int SEQ = 8192, DM = 2048, DFF = 5632, INW = 4096, AW = 1024, SW = 1024, NCOND = 9, DEPTH = 2;
constexpr int NG = 64, NP = 64, HC = 16;
constexpr int SCHUNK = 256, NCHUNK = SEQ / SCHUNK;
constexpr float LOG2E = 1.4426950408889634f;
constexpr size_t MiB = 1u << 20;
constexpr size_t WS_CTL = 0, CTL_ZERO_BYTES = 1 * MiB;
constexpr size_t WS_BIASD = 1 * MiB;
constexpr size_t WS_XEND = 2 * MiB;
constexpr size_t WS_WGU = 8 * MiB;
constexpr size_t WS_WD = WS_WGU + 4 * 44 * MiB;
constexpr size_t WS_WIN = WS_WD + 4 * 22 * MiB;
constexpr size_t WS_WOUT = WS_WIN + 2 * 16 * MiB;
constexpr size_t WS_WGLU = WS_WOUT + 2 * 8 * MiB;
constexpr size_t WS_H = WS_WGLU + 2 * 2 * MiB;
constexpr size_t WS_ACT = WS_H + 32 * MiB;
constexpr size_t WS_Q = WS_ACT + 88 * MiB;
constexpr size_t WS_K = WS_Q + 16 * MiB, WS_V = WS_K + 16 * MiB, WS_U = WS_V + 16 * MiB;
constexpr size_t WS_OP = WS_U + 16 * MiB;
constexpr size_t WS_CAT = WS_OP + 32 * MiB;
constexpr size_t WS_YG = WS_CAT + 32 * MiB;
constexpr size_t WS_END = WS_YG + 16 * MiB;
constexpr int RING_BYTES = 131072, LDS_BYTES = 147456;

#define LAS __attribute__((address_space(3)))
typedef unsigned short bf16;
typedef unsigned v4u __attribute__((ext_vector_type(4)));
typedef unsigned v2u __attribute__((ext_vector_type(2)));
typedef float f32x4 __attribute__((ext_vector_type(4)));
typedef float f32x2v __attribute__((ext_vector_type(2)));
typedef short bf16x8 __attribute__((ext_vector_type(8)));
#define LDS_WAIT() asm volatile("s_waitcnt lgkmcnt(0)" ::: "memory")
__device__ __forceinline__ unsigned pk2(float lo, float hi) { return pg8::cvt_pk_bf16(lo, hi); }
__device__ __forceinline__ float wave_sum(float v) {
#pragma unroll
    for (int o = 1; o < 64; o <<= 1) v += __shfl_xor(v, o);
    return v;
}

#define RLX_AGENT __ATOMIC_RELAXED, __HIP_MEMORY_SCOPE_AGENT
constexpr int CW_BAR = 65536;
constexpr int MISC_OFF = LDS_BYTES - 64;
#define XB_TMO      128
#define XB_XCNT(j)  (256  + 64 * (j))
#define XB_XSUB(j)  (1280 + 64 * (j))
#define XB_XGEN(j)  (2304 + 64 * (j))
#define XB_TOP      3328
#define XB_TOPGEN   3392
#define XCD_BAR_WORDS 3456
#define XB_SPIN_CAP (1u << 18)

__device__ __forceinline__ unsigned xb_ld(unsigned* p)              { return __hip_atomic_load(p, __ATOMIC_RELAXED, __HIP_MEMORY_SCOPE_AGENT); }
__device__ __forceinline__ unsigned xb_add(unsigned* p, unsigned v) { return __hip_atomic_fetch_add(p, v, __ATOMIC_RELAXED, __HIP_MEMORY_SCOPE_AGENT); }
__device__ __forceinline__ unsigned xb_xcc_id() { return (unsigned)__builtin_amdgcn_s_getreg((3 << 11) | 20) & 0xFu; }
#define XB_SPIN(cond, bar) do { unsigned _sp = 0; while (cond) { __builtin_amdgcn_s_sleep(1); \
    if ((++_sp & 255u) == 0u) { if (xb_ld(&(bar)[XB_TMO])) break; if (_sp > XB_SPIN_CAP) { atomicAdd(&(bar)[XB_TMO], 1u); break; } } } } while (0)

struct XcdBarrier {
    unsigned* bar; unsigned x;
    volatile LAS unsigned* st;
};

__device__ __forceinline__ XcdBarrier xcd_barrier_post(unsigned* bar, volatile LAS unsigned* st) {
    XcdBarrier b; b.bar = bar; b.x = xb_xcc_id(); b.st = st;
    if (threadIdx.x == 0) (void)xb_add(&bar[XB_XCNT(b.x)], 1u);
    return b;
}
__device__ __forceinline__ void xcd_barrier_complete(unsigned* bar, unsigned x, unsigned& nloc, unsigned& nx) {
    const unsigned G = gridDim.x * gridDim.y * gridDim.z;
    unsigned sum, cnt, mine, sp = 0u;
    for (;;) {
        sum = 0u; cnt = 0u; mine = 0u;
#pragma unroll
        for (unsigned j = 0; j < 16; ++j) { const unsigned c = xb_ld(&bar[XB_XCNT(j)]); sum += c; cnt += (c > 0u) ? 1u : 0u; mine = (j == x) ? c : mine; }
        if (sum == G) break;
        __builtin_amdgcn_s_sleep(1);
        if ((++sp & 255u) == 0u) { if (xb_ld(&bar[XB_TMO])) break; if (sp > XB_SPIN_CAP) { atomicAdd(&bar[XB_TMO], 1u); break; } }
    }
    nloc = mine > 0u ? mine : 1u; nx = cnt > 0u ? cnt : 1u;
}

__device__ __forceinline__ void xcd_barrier(const XcdBarrier& b) {
    asm volatile("s_waitcnt vmcnt(0)" ::: "memory");
    __syncthreads();
    if (threadIdx.x == 0) {
        unsigned* bar = b.bar;
        __builtin_amdgcn_s_waitcnt(0);
        unsigned nloc = b.st[0], nx = b.st[1];
        if (nloc == 0u) { xcd_barrier_complete(bar, b.x, nloc, nx); b.st[0] = nloc; b.st[1] = nx; }
        const unsigned old = xb_add(&bar[XB_XSUB(b.x)], 1u);
        const unsigned gen = old / nloc;
        if (old + 1u == (gen + 1u) * nloc) {
            __builtin_amdgcn_fence(__ATOMIC_RELEASE, "agent");
            asm volatile("s_waitcnt vmcnt(0)" ::: "memory");
            const unsigned og = xb_add(&bar[XB_TOP], 1u);
            const unsigned tg = og / nx;
            if (og + 1u == (tg + 1u) * nx) xb_add(&bar[XB_TOPGEN], 1u);
            else XB_SPIN(xb_ld(&bar[XB_TOPGEN]) == tg, bar);
            __builtin_amdgcn_fence(__ATOMIC_ACQUIRE, "agent");
            xb_add(&bar[XB_XGEN(b.x)], 1u);
            asm volatile("s_waitcnt vmcnt(0)" ::: "memory");
        } else {
            XB_SPIN(xb_ld(&bar[XB_XGEN(b.x)]) == gen, bar);
            __builtin_amdgcn_fence(__ATOMIC_ACQUIRE, "agent");
            asm volatile("s_waitcnt vmcnt(0)" ::: "memory");
        }
    }
    __syncthreads();
}

struct Frame {
    LAS unsigned char* lds;
    int tid, lane, wave, vcu, G;
};
__device__ __forceinline__ Frame frame_opaque(const Frame& F0) { Frame F = F0; asm volatile("" : "+v"(F.tid)); F.lane = F.tid & 63; return F; }

struct TrItem { const float* W; bf16* WT; int K, N, mode, k0, n0; };
__device__ __forceinline__ int tr_drow(int mode, int n) {
    if (mode == 1 || mode == 2) return (n >> 7) * 256 + (mode - 1) * 128 + (n & 127);
    if (mode == 3 && n < 2048) { const int pn = n >> 8, cc = n & 255; return pn * 256 + ((cc >> 5) & 1) * 128 + (cc >> 6) * 32 + (cc & 31); }
    return n;
}
__device__ __forceinline__ void tr_load(const TrItem& t, int lane, f32x4 (&v)[16]) {
    const float* src = t.W + (size_t)(t.k0 + (lane >> 4)) * t.N + t.n0 + 4 * (lane & 15);
#pragma unroll
    for (int i = 0; i < 16; ++i) v[i] = *(const f32x4*)(src + (size_t)(4 * i) * t.N);
}
__device__ __forceinline__ void tr_store(const TrItem& t, int lane, const f32x4 (&v)[16], LAS float* scr) {
    const int r = lane >> 4, c4 = lane & 15;
#pragma unroll
    for (int i = 0; i < 16; ++i) { LAS float* d = scr + (4 * i + r) * 65 + 4 * c4; d[0] = v[i][0]; d[1] = v[i][1]; d[2] = v[i][2]; d[3] = v[i][3]; }
    LDS_WAIT(); asm volatile("" ::: "memory");
    const int c = lane & 7;
#pragma unroll
    for (int j = 0; j < 8; ++j) { const int n = (lane >> 3) + 8 * j; const LAS float* s = scr + (8 * c) * 65 + n;
        v4u o; o.x = pk2(s[0 * 65], s[1 * 65]); o.y = pk2(s[2 * 65], s[3 * 65]); o.z = pk2(s[4 * 65], s[5 * 65]); o.w = pk2(s[6 * 65], s[7 * 65]);
        *(v4u*)(t.WT + (size_t)tr_drow(t.mode, t.n0 + n) * t.K + t.k0 + 8 * c) = o; }
    LDS_WAIT(); asm volatile("" ::: "memory");
}
struct In { const float* p[31]; };
__device__ __forceinline__ const float* inp(int i) { const float* const __attribute__((address_space(4)))* t = (const float* const __attribute__((address_space(4)))*)__builtin_amdgcn_kernarg_segment_ptr(); asm volatile("" : "+s"(t)); return t[i]; }
__device__ __forceinline__ int t5_bucket(int d) {
    if (d < 16) return d;
    int b = 16; b += d >= 19; b += d >= 21; b += d >= 24; b += d >= 27; b += d >= 31; b += d >= 35; b += d >= 40; b += d >= 46; b += d >= 52; b += d >= 59; b += d >= 67; b += d >= 77; b += d >= 87; b += d >= 99; b += d >= 113;
    return b;
}
constexpr int I_F = (DM / 64) * (DFF / 64), I_IN = (DM / 64) * (INW / 64), I_OUT = (DM / 64) * (DM / 64), I_GLU = (SW / 64) * (SW / 64);
constexpr int PER_LAYER = 6 * I_F + I_IN + I_OUT + I_GLU;
__device__ __forceinline__ TrItem tr_decode(unsigned char* ws, int it) {
    const int li = it / PER_LAYER; int r = it % PER_LAYER; TrItem t;
    const size_t fo = (size_t)li * DM * DFF;
    if (r < 6 * I_F) { const int w = r / I_F; r -= w * I_F; const int ffn = w / 3, kind = w % 3;
        t.W = inp(6 + w) + fo;
        if (kind < 2) { t.K = DM; t.N = DFF; t.mode = 1 + kind; t.WT = (bf16*)(ws + WS_WGU) + (size_t)(li * 2 + ffn) * 2 * DFF * DM; }
        else { t.K = DFF; t.N = DM; t.mode = 0; t.WT = (bf16*)(ws + WS_WD) + (size_t)(li * 2 + ffn) * DM * DFF; } }
    else if ((r -= 6 * I_F) < I_IN) { t.W = inp(12) + (size_t)li * DM * INW; t.K = DM; t.N = INW; t.mode = 3; t.WT = (bf16*)(ws + WS_WIN) + (size_t)li * INW * DM; }
    else if ((r -= I_IN) < I_OUT) { t.W = inp(13) + (size_t)li * DM * DM; t.K = DM; t.N = DM; t.mode = 0; t.WT = (bf16*)(ws + WS_WOUT) + (size_t)li * DM * DM; }
    else { r -= I_OUT; t.W = inp(29) + (size_t)li * SW * SW; t.K = SW; t.N = SW; t.mode = 0; t.WT = (bf16*)(ws + WS_WGLU) + (size_t)li * SW * SW; }
    const int nblk = t.N / 64; t.k0 = 64 * (r / nblk); t.n0 = 64 * (r % nblk); return t;
}
__device__ __forceinline__ void convert_job(const Frame& F0, unsigned char* ws, int a0, int a1, int b0, int b1, int c0, int c1, int gm, int rank, int nw) { const Frame F = frame_opaque(F0);
    LAS float* scr = (LAS float*)(F.lds + F.wave * 16640);
    const int na = a1 - a0, nab = na + (b1 - b0), ntot = nab + (c1 - c0);
#define CJ_IDX(j) ((j) < na ? a0 + (j) : (j) < nab ? b0 + ((j) - na) : c0 + ((j) - nab))
    { int j = rank; TrItem cur; f32x4 va[16], vb[16];
      if (j < ntot) { cur = tr_decode(ws, CJ_IDX(j)); tr_load(cur, F.lane, va); }
      while (j < ntot) { const int nx = j + nw; const bool hn = nx < ntot; TrItem nxt = cur;
          if (hn) { nxt = tr_decode(ws, CJ_IDX(nx)); tr_load(nxt, F.lane, vb); }
          tr_store(cur, F.lane, va, scr);
          if (!hn) break;
          cur = nxt; j = nx;
#pragma unroll
          for (int i = 0; i < 16; ++i) va[i] = vb[i]; } }
#undef CJ_IDX
    if (gm) { float* mod = (float*)(ws + WS_CTL); const float* cvec = inp(1); const int nl = gm == 3 ? 2 : 1, l0 = gm == 2 ? 1 : 0;
      for (int it = rank; it < nl * 72 * 32; it += nw) { const int cb = it % (nl * 72), kc = it / (nl * 72), layer = l0 + cb / 72, col = (cb % 72) * 256 + F.lane * 4;
          const float* W = inp(3) + ((size_t)layer * DM + kc * 64) * (NCOND * DM) + col;
          f32x4 acc = (f32x4){0.f, 0.f, 0.f, 0.f}; if (kc == 0) acc = *(const f32x4*)(inp(4) + layer * (NCOND * DM) + col);
#pragma unroll 16
          for (int kk = 0; kk < 64; ++kk) { const float cv = cvec[kc * 64 + kk]; const float sv = cv * pg8::sigmoid_f(cv); acc += sv * *(const f32x4*)(W + (size_t)kk * (NCOND * DM)); }
          float* dst = mod + layer * (NCOND * DM) + col; atomicAdd(dst, acc[0]); atomicAdd(dst + 1, acc[1]); atomicAdd(dst + 2, acc[2]); atomicAdd(dst + 3, acc[3]); } }
}
__device__ __forceinline__ void p0_prologue(const Frame& F, unsigned char* ws) {
    if (blockIdx.x == 0) { float* bd = (float*)(ws + WS_BIASD); const float* rb = inp(2);
        for (int i = F.tid; i < 1024; i += NWAVES * 64) { const int h = i >> 7, d = i & 127; bd[i] = (rb[t5_bucket(d) * 8 + h] - rb[31 * 8 + h]) * LOG2E; } }
#if MK_TAILFILL
    convert_job(F, ws, 0, 2 * I_F, 3 * I_F, 5 * I_F, PER_LAYER + 3 * I_F, PER_LAYER + 5 * I_F, 3, F.vcu * NWAVES + F.wave, F.G * NWAVES);
#else
    convert_job(F, ws, 0, DEPTH * PER_LAYER, 0, 0, 0, 0, 3, F.vcu * NWAVES + F.wave, F.G * NWAVES);
#endif
}
__device__ __forceinline__ void tail_job_gateup(const Frame& F, unsigned char* ws, int li, int f) {
#if MK_TAILFILL
    if (blockIdx.x < 128) return;
    const int rank = ((int)blockIdx.x - 128) * NWAVES + F.wave, nw = 128 * NWAVES, base = li * PER_LAYER;
    if (f == 0) convert_job(F, ws, base + 2 * I_F, base + 3 * I_F, base + 6 * I_F, base + PER_LAYER, 0, 0, 0, rank, nw);
    else { const int nb = (li + 1 < DEPTH) ? base + PER_LAYER : 0; convert_job(F, ws, base + 5 * I_F, base + 6 * I_F, nb, nb + (li + 1 < DEPTH ? I_F : 0), 0, 0, 0, rank, nw); }
#endif
}
__device__ __forceinline__ void tail_job_glu(const Frame& F, unsigned char* ws, int li) {
#if MK_TAILFILL
    if (blockIdx.x < 128 || li + 1 >= DEPTH) return;
    const int rank = ((int)blockIdx.x - 128) * NWAVES + F.wave, nw = 128 * NWAVES, base = (li + 1) * PER_LAYER;
    convert_job(F, ws, base + I_F, base + 2 * I_F, 0, 0, 0, 0, 0, rank, nw);
#endif
}

__device__ __forceinline__ void norm_phase(const Frame& F0, const float* xin, const float* gnorm, const float* shift, const float* scale, bf16* H) { const Frame F = frame_opaque(F0);
    const int gw = F.vcu * NWAVES + F.wave, NGW = F.G * NWAVES;
    f32x4 gam[8], sh[8];
#pragma unroll
    for (int j = 0; j < 8; ++j) { const int idx = 4 * F.lane + 256 * j; gam[j] = *(const f32x4*)(gnorm + idx) * (1.0f + *(const f32x4*)(scale + idx)); sh[j] = *(const f32x4*)(shift + idx); }
    for (int m = gw; m < SEQ; m += NGW) {
        const f32x4* xr = (const f32x4*)(xin + (size_t)m * DM) + F.lane;
        f32x4 v[8]; float s = 0.f;
#pragma unroll
        for (int j = 0; j < 8; ++j) { v[j] = xr[64 * j]; s += (v[j].x * v[j].x + v[j].y * v[j].y) + (v[j].z * v[j].z + v[j].w * v[j].w); }
        const float rstd = __builtin_amdgcn_rsqf(wave_sum(s) * (1.0f / DM) + 1e-6f);
        v2u* o8 = (v2u*)(H + (size_t)m * DM) + F.lane;
#pragma unroll
        for (int j = 0; j < 8; ++j) { const f32x4 y = v[j] * rstd * gam[j] + sh[j]; v2u w; w.x = pk2(y.x, y.y); w.y = pk2(y.z, y.w); o8[64 * j] = w; }
    }
}

__device__ __forceinline__ void combine_phase(const Frame& F0, const bf16* OP, bf16* CAT, const float* lq1, const float* lk1, const float* lq2, const float* lk2, const float* subg, float lam_init) { const Frame F = frame_opaque(F0);
    const int gw = F.vcu * NWAVES + F.wave, NGW = F.G * NWAVES;
    const float lam = expf(wave_sum(lq1[F.lane] * lk1[F.lane])) - expf(wave_sum(lq2[F.lane] * lk2[F.lane])) + lam_init;
    const int h = F.lane >> 3, j0 = (F.lane & 7) * 16;
    float gs[16];
#pragma unroll
    for (int i = 0; i < 16; ++i) gs[i] = subg[j0 + i] * (1.0f - lam_init);
    for (int m = gw; m < SEQ; m += NGW) {
        const bf16* p1 = OP + (size_t)m * 2048 + (2 * h) * 128 + j0; const bf16* p2 = p1 + 128;
        const v4u a0 = *(const v4u*)p1, a1 = *(const v4u*)(p1 + 8), b0 = *(const v4u*)p2, b1 = *(const v4u*)(p2 + 8);
        float o[16];
#pragma unroll
        for (int i = 0; i < 4; ++i) { o[2 * i] = pg8::bf_lo(a0[i]) - lam * pg8::bf_lo(b0[i]); o[2 * i + 1] = pg8::bf_hi(a0[i]) - lam * pg8::bf_hi(b0[i]);
                                      o[8 + 2 * i] = pg8::bf_lo(a1[i]) - lam * pg8::bf_lo(b1[i]); o[8 + 2 * i + 1] = pg8::bf_hi(a1[i]) - lam * pg8::bf_hi(b1[i]); }
        float ss = 0.f;
#pragma unroll
        for (int i = 0; i < 16; ++i) ss += o[i] * o[i];
        ss += __shfl_xor(ss, 1); ss += __shfl_xor(ss, 2); ss += __shfl_xor(ss, 4);
        const float r = __builtin_amdgcn_rsqf(ss * (1.0f / 128.0f) + 1e-5f);
        v4u w0, w1;
#pragma unroll
        for (int i = 0; i < 4; ++i) { w0[i] = pk2(o[2 * i] * r * gs[2 * i], o[2 * i + 1] * r * gs[2 * i + 1]); w1[i] = pk2(o[8 + 2 * i] * r * gs[8 + 2 * i], o[8 + 2 * i + 1] * r * gs[8 + 2 * i + 1]); }
        bf16* q = CAT + (size_t)m * 2048 + h * 128 + j0; *(v4u*)q = w0; *(v4u*)(q + 8) = w1;
    }
}

struct SsmP { const float *lam_re, *lam_im, *log_step, *b_re, *b_im, *c_re, *c_im, *dv; };
__device__ __forceinline__ void cexp_s(float lr, float li, float s, float& er, float& ei) {
    const float m = expf(lr * s);
    double tr = (double)li * (double)s * 0.15915494309189535; tr -= floor(tr);
    const float a = (float)(tr * 6.283185307179586);
    float sn, cs; sincosf(a, &sn, &cs); er = m * cs; ei = m * sn;
}
__device__ __forceinline__ void ssm_lam(const SsmP& P, int g, int p, float& lr, float& li, float& step) {
    lr = fminf(P.lam_re[g * NP + p], -1e-4f); li = P.lam_im[g * NP + p]; step = expf(P.log_step[g]);
}
__device__ __forceinline__ void ssm_bfrag(const SsmP& P, int g, int lane, bf16x8 (&bfr)[8]) {
    const int q = lane >> 4, ci = lane & 15, hb = 8 * (q & 1);
#pragma unroll
    for (int pb = 0; pb < 4; ++pb) { const int p = 16 * pb + ci; float lr, li, step, ar, ai; ssm_lam(P, g, p, lr, li, step); cexp_s(lr, li, step, ar, ai);
        const float nr = ar - 1.0f, ni = ai, den = 1.0f / (lr * lr + li * li); const float cr = (nr * lr + ni * li) * den, cim = (ni * lr - nr * li) * den;
        const float* br = P.b_re + ((size_t)g * NP + p) * HC + hb; const float* bi = P.b_im + ((size_t)g * NP + p) * HC + hb;
        const f32x4 r0 = *(const f32x4*)br, r1 = *(const f32x4*)(br + 4), i0 = *(const f32x4*)bi, i1 = *(const f32x4*)(bi + 4);
        const f32x4 re0 = cr * r0 - cim * i0, re1 = cr * r1 - cim * i1, im0 = cr * i0 + cim * r0, im1 = cr * i1 + cim * r1;
        v4u wr_, wi_; wr_.x = pk2(re0[0], re0[1]); wr_.y = pk2(re0[2], re0[3]); wr_.z = pk2(re1[0], re1[1]); wr_.w = pk2(re1[2], re1[3]);
        wi_.x = pk2(im0[0], im0[1]); wi_.y = pk2(im0[2], im0[3]); wi_.z = pk2(im1[0], im1[1]); wi_.w = pk2(im1[2], im1[3]);
        if (q >= 2) { wr_ = (v4u){0u, 0u, 0u, 0u}; wi_ = (v4u){0u, 0u, 0u, 0u}; }
        bfr[pb] = __builtin_bit_cast(bf16x8, wr_); bfr[4 + pb] = __builtin_bit_cast(bf16x8, wi_); }
}
constexpr int BU_STRIDE = 132, XB_STRIDE = 136;
__device__ __forceinline__ void ssm_bu_to_lds(bf16x8 af, const bf16x8 (&bfr)[8], LAS float* bu, int lane) {
    const int q = lane >> 4, ci = lane & 15;
#pragma unroll
    for (int nb = 0; nb < 8; ++nb) { const f32x4 d = __builtin_amdgcn_mfma_f32_16x16x32_bf16(af, bfr[nb], (f32x4){0.f, 0.f, 0.f, 0.f}, 0, 0, 0);
#pragma unroll
        for (int r = 0; r < 4; ++r) bu[(4 * q + r) * BU_STRIDE + 16 * nb + ci] = d[r]; }
}
__device__ __forceinline__ bf16x8 ssm_load_u(const bf16* U, int g, int t, int q) {
    bf16x8 af = (bf16x8){0, 0, 0, 0, 0, 0, 0, 0};
    if (q < 2) af = *(const bf16x8*)(U + (size_t)t * SW + g * HC + 8 * q);
    return af;
}
__device__ __forceinline__ void ssm_pass1(const Frame& F0, const SsmP& P, const bf16* U, float* XEND) { const Frame F = frame_opaque(F0);
    const int gw = F.vcu * NWAVES + F.wave, NGW = F.G * NWAVES, lane = F.lane, q = lane >> 4, ci = lane & 15;
    LAS float* bu = (LAS float*)(F.lds + F.wave * 16384);
    for (int it = gw; it < NG * NCHUNK; it += NGW) { const int g = it / NCHUNK, c = it % NCHUNK, t0 = c * SCHUNK;
        bf16x8 bfr[8]; ssm_bfrag(P, g, lane, bfr);
        float lr, li, step, ar, ai; ssm_lam(P, g, lane, lr, li, step); cexp_s(lr, li, step, ar, ai);
        float xr = 0.f, xi = 0.f;
        bf16x8 af = ssm_load_u(U, g, t0 + ci, q);
        for (int sb = 0; sb < SCHUNK / 16; ++sb) {
            ssm_bu_to_lds(af, bfr, bu, lane);
            if (sb + 1 < SCHUNK / 16) af = ssm_load_u(U, g, t0 + (sb + 1) * 16 + ci, q);
            LDS_WAIT();
#pragma unroll
            for (int tt = 0; tt < 16; ++tt) { const float br_ = bu[tt * BU_STRIDE + lane], bi_ = bu[tt * BU_STRIDE + 64 + lane];
                const float nxr = ar * xr - ai * xi + br_, nxi = ar * xi + ai * xr + bi_; xr = nxr; xi = nxi; }
            LDS_WAIT();
        }
        *(f32x2v*)(XEND + ((size_t)it * NP + lane) * 2) = (f32x2v){xr, xi};
    }
}
__device__ __forceinline__ float gelu_tanh(float x) {
    const float z = x + 0.044715f * x * x * x;
    return x * __builtin_amdgcn_rcpf(1.0f + __builtin_amdgcn_exp2f(-2.0f * 0.7978845608028654f * LOG2E * z));
}
__device__ __forceinline__ void ssm_pass2(const Frame& F0, const SsmP& P, const bf16* U, const float* XEND, bf16* YG) { const Frame F = frame_opaque(F0);
    const int gw = F.vcu * NWAVES + F.wave, NGW = F.G * NWAVES, lane = F.lane, q = lane >> 4, ci = lane & 15;
    LAS float* bu = (LAS float*)(F.lds + F.wave * 16384);
    LAS bf16* xb = (LAS bf16*)(F.lds + F.wave * 16384 + 16 * BU_STRIDE * 4);
    for (int it = gw; it < NG * NCHUNK; it += NGW) { const int g = it / NCHUNK, c = it % NCHUNK, t0 = c * SCHUNK;
        bf16x8 bfr[8]; ssm_bfrag(P, g, lane, bfr);
        float lr, li, step, ar, ai; ssm_lam(P, g, lane, lr, li, step); cexp_s(lr, li, step, ar, ai);
        float xr = 0.f, xi = 0.f;
        { float aTr, aTi; cexp_s(lr, li, step * (float)SCHUNK, aTr, aTi);
          for (int cc = 0; cc < c; ++cc) { const f32x2v e = *(const f32x2v*)(XEND + ((size_t)(g * NCHUNK + cc) * NP + lane) * 2);
              const float nxr = aTr * xr - aTi * xi + e.x, nxi = aTr * xi + aTi * xr + e.y; xr = nxr; xi = nxi; } }
        bf16x8 cf[4];
#pragma unroll
        for (int kb = 0; kb < 4; ++kb) { const float* src = (kb < 2 ? P.c_re : P.c_im) + ((size_t)g * HC + ci) * NP + 32 * (kb & 1) + 8 * q; const float sg = kb < 2 ? 1.0f : -1.0f;
            const f32x4 a = *(const f32x4*)src * sg, b = *(const f32x4*)(src + 4) * sg;
            v4u w; w.x = pk2(a[0], a[1]); w.y = pk2(a[2], a[3]); w.z = pk2(b[0], b[1]); w.w = pk2(b[2], b[3]); cf[kb] = __builtin_bit_cast(bf16x8, w); }
        const f32x4 dv4 = *(const f32x4*)(P.dv + g * HC + 4 * q);
        bf16x8 af = ssm_load_u(U, g, t0 + ci, q);
        for (int sb = 0; sb < SCHUNK / 16; ++sb) {
            ssm_bu_to_lds(af, bfr, bu, lane);
            if (sb + 1 < SCHUNK / 16) af = ssm_load_u(U, g, t0 + (sb + 1) * 16 + ci, q);
            const int t = t0 + sb * 16 + ci;
            const v2u uu = *(const v2u*)(U + (size_t)t * SW + g * HC + 4 * q);
            LDS_WAIT();
#pragma unroll
            for (int tt = 0; tt < 16; ++tt) { const float br_ = bu[tt * BU_STRIDE + lane], bi_ = bu[tt * BU_STRIDE + 64 + lane];
                const float nxr = ar * xr - ai * xi + br_, nxi = ar * xi + ai * xr + bi_; xr = nxr; xi = nxi;
                const unsigned pk = pk2(xr, xi); xb[tt * XB_STRIDE + lane] = (bf16)(pk & 0xffffu); xb[tt * XB_STRIDE + 64 + lane] = (bf16)(pk >> 16); }
            LDS_WAIT();
            f32x4 yd = (f32x4){0.f, 0.f, 0.f, 0.f};
#pragma unroll
            for (int kb = 0; kb < 4; ++kb) { const bf16x8 xf = *(const LAS bf16x8*)(xb + ci * XB_STRIDE + 32 * kb + 8 * q); yd = __builtin_amdgcn_mfma_f32_16x16x32_bf16(cf[kb], xf, yd, 0, 0, 0); }
            const float y0 = gelu_tanh(yd[0] + dv4[0] * pg8::bf_lo(uu.x)), y1 = gelu_tanh(yd[1] + dv4[1] * pg8::bf_hi(uu.x));
            const float y2 = gelu_tanh(yd[2] + dv4[2] * pg8::bf_lo(uu.y)), y3 = gelu_tanh(yd[3] + dv4[3] * pg8::bf_hi(uu.y));
            v2u w; w.x = pk2(y0, y1); w.y = pk2(y2, y3);
            *(v2u*)(YG + (size_t)t * SW + g * HC + 4 * q) = w;
            LDS_WAIT();
        }
    }
}

struct Args { In in; float* out; unsigned char* ws; int ph_lo, ph_hi; };
constexpr int N_PHASES = 1 + 12 * DEPTH;
__global__ void __launch_bounds__(NWAVES * 64, 2) mega_fwd(Args args) {
    extern __shared__ __attribute__((aligned(16))) unsigned char lds[];
    cg::grid_group grid = cg::this_grid();
    Frame F;
    F.lds = (LAS unsigned char*)lds;
    F.tid = threadIdx.x; F.lane = F.tid & 63; F.wave = __builtin_amdgcn_readfirstlane(F.tid >> 6);
    F.G = gridDim.x; { const int bx = blockIdx.x; F.vcu = (F.G % 8 == 0) ? (bx % 8) * (F.G / 8) + bx / 8 : bx; }
    const int lo = args.ph_lo, hi = args.ph_hi;
    if (F.tid < 16) ((LAS unsigned*)(F.lds + MISC_OFF))[F.tid] = 0u;
    __syncthreads();
    XcdBarrier bar = xcd_barrier_post((unsigned*)(args.ws + WS_CTL) + CW_BAR, (volatile LAS unsigned*)(F.lds + MISC_OFF));
    int ph = 0;
#define PH_ON (ph >= lo && ph < hi)
#define PH_END do { if (ph >= lo && ph + 1 < hi) { if (ph == 0) grid.sync(); else xcd_barrier(bar); } ++ph; } while (0)
#define PH_LOCALS unsigned char* ws = args.ws; float* xout = args.out; int li = li_, f = f_; asm volatile("" : "+s"(ws), "+s"(xout), "+s"(li), "+s"(f)); \
    const float* md = (const float*)(ws + WS_CTL) + li * (NCOND * DM); const float* ng = inp(5) + (size_t)li * 3 * DM; const int sub = f == 0 ? 0 : 2; \
    const float* xcur = (li == 0 && f == 0) ? inp(0) : (const float*)xout; (void)md; (void)ng; (void)sub; (void)xcur;

    if (PH_ON) p0_prologue(F, args.ws);
    PH_END;

    for (int li_ = 0; li_ < DEPTH; ++li_) {
        for (int f_ = 0; f_ < 2; ++f_) {
            if (PH_ON) { PH_LOCALS; norm_phase(F, xcur, ng + sub * DM, md + (3 * sub) * DM, md + (3 * sub + 1) * DM, (bf16*)(ws + WS_H)); }
            PH_END;
            if (PH_ON) { PH_LOCALS; pg8::Gemm g{(const bf16*)(ws + WS_H), (const bf16*)(ws + WS_WGU) + (size_t)(li * 2 + f) * 2 * DFF * DM, SEQ, 2 * DFF, DM}; pg8::StaticOrder S; S.init(SEQ, 2 * DFF, F.G, (int)blockIdx.x);
                pg8::EpiSwiGlu E{(bf16*)(ws + WS_ACT), DFF};
                pg8::gemm_phase<pg8::EpiSwiGlu, pg8::StaticOrder, true, true>(F.lds, g, S, E);
                tail_job_gateup(F, ws, li, f); }
            PH_END;
            if (PH_ON) { PH_LOCALS; pg8::Gemm g{(const bf16*)(ws + WS_ACT), (const bf16*)(ws + WS_WD) + (size_t)(li * 2 + f) * DM * DFF, SEQ, DM, DFF}; pg8::StaticOrder S; S.init(SEQ, DM, F.G, (int)blockIdx.x);
                pg8::EpiResGate E{xcur, xout, md + (3 * sub + 2) * DM, 0.5f, DM};
                pg8::gemm_phase<pg8::EpiResGate, pg8::StaticOrder, true, true>(F.lds, g, S, E); }
            PH_END;
            if (f_ == 1) break;
            if (PH_ON) { PH_LOCALS; norm_phase(F, xout, ng + 1 * DM, md + 3 * DM, md + 4 * DM, (bf16*)(ws + WS_H)); }
            PH_END;
            if (PH_ON) { PH_LOCALS; pg8::Gemm g{(const bf16*)(ws + WS_H), (const bf16*)(ws + WS_WIN) + (size_t)li * INW * DM, SEQ, INW, DM}; pg8::StaticOrder S; S.init(SEQ, INW, F.G, (int)blockIdx.x);
                pg8::EpiWin E{(bf16*)(ws + WS_Q), (bf16*)(ws + WS_K), (bf16*)(ws + WS_V), (bf16*)(ws + WS_U), inp(14) + li * 64, inp(15) + li * 64, attn_body::C2};
                pg8::gemm_phase<pg8::EpiWin, pg8::StaticOrder, true, true>(F.lds, g, S, E); }
            PH_END;
#define SSM_PARAMS SsmP P{inp(21) + (size_t)li * NG * NP, inp(22) + (size_t)li * NG * NP, inp(23) + li * NG, inp(24) + (size_t)li * NG * NP * HC, inp(25) + (size_t)li * NG * NP * HC, \
                   inp(26) + (size_t)li * NG * HC * NP, inp(27) + (size_t)li * NG * HC * NP, inp(28) + li * NG * HC}
            if (PH_ON) { PH_LOCALS;
#ifndef NO_ATTN
                { const attn_body::AttnTensors AT{(const attn_body::bf16*)(ws + WS_Q), (const attn_body::bf16*)(ws + WS_K), (const attn_body::bf16*)(ws + WS_V), (attn_body::bf16*)(ws + WS_OP), (const float*)(ws + WS_BIASD)};
                  attn_body::attn_phase<8>((char*)lds, AT, F.vcu); }
#endif
#ifndef NO_SSM
                { SSM_PARAMS; ssm_pass1(F, P, (const bf16*)(ws + WS_U), (float*)(ws + WS_XEND)); }
#endif
                }
            PH_END;
            if (PH_ON) { PH_LOCALS; combine_phase(F, (const bf16*)(ws + WS_OP), (bf16*)(ws + WS_CAT), inp(16) + li * 64, inp(17) + li * 64, inp(18) + li * 64, inp(19) + li * 64, inp(20) + li * 128, li == 0 ? 0.2f : 0.35550906759096924f);
#ifndef NO_SSM
                { SSM_PARAMS; ssm_pass2(F, P, (const bf16*)(ws + WS_U), (const float*)(ws + WS_XEND), (bf16*)(ws + WS_YG)); }
#endif
                }
            PH_END;
            if (PH_ON) { PH_LOCALS; pg8::Gemm g{(const bf16*)(ws + WS_YG), (const bf16*)(ws + WS_WGLU) + (size_t)li * SW * SW, SEQ, SW, SW}; pg8::StaticOrder S; S.init(SEQ, SW, F.G, (int)blockIdx.x);
                pg8::EpiGlu E{(const bf16*)(ws + WS_YG), (bf16*)(ws + WS_CAT), inp(30) + li * SW};
                pg8::gemm_phase<pg8::EpiGlu, pg8::StaticOrder, true, true>(F.lds, g, S, E);
                tail_job_glu(F, ws, li); }
            PH_END;
            if (PH_ON) { PH_LOCALS; pg8::Gemm g{(const bf16*)(ws + WS_CAT), (const bf16*)(ws + WS_WOUT) + (size_t)li * DM * DM, SEQ, DM, DM}; pg8::StaticOrder S; S.init(SEQ, DM, F.G, (int)blockIdx.x);
                pg8::EpiResGate E{xout, xout, md + 5 * DM, 1.0f, DM};
                pg8::gemm_phase<pg8::EpiResGate, pg8::StaticOrder, true, true>(F.lds, g, S, E); }
            PH_END;
        }
    }
#undef PH_ON
#undef PH_END
#undef PH_LOCALS
#undef SSM_PARAMS
}

extern "C" void kernel_launch(void* const* d_in, const int* in_sizes, int n_in, void* d_out, int out_size, void* d_ws, size_t ws_size, hipStream_t stream) {
    static int grid = 0;
    if (grid == 0) {
        if (n_in != 31 || in_sizes[0] != SEQ * DM || out_size != SEQ * DM || ws_size < WS_END) { fprintf(stderr, "kernel_launch: unexpected shapes (n_in %d, in0 %d, out %d, ws %zu < %zu?); nothing launched\n", n_in, n_in > 0 ? in_sizes[0] : -1, out_size, ws_size, (size_t)WS_END); grid = -1; return; }
        int dev = 0, cus = 0, per_cu = 0;
        if (hipGetDevice(&dev) != hipSuccess || hipDeviceGetAttribute(&cus, hipDeviceAttributeMultiprocessorCount, dev) != hipSuccess) { fprintf(stderr, "kernel_launch: device query failed\n"); grid = -1; return; }
        if (hipFuncSetAttribute((const void*)mega_fwd, hipFuncAttributeMaxDynamicSharedMemorySize, LDS_BYTES) != hipSuccess) { fprintf(stderr, "kernel_launch: hipFuncSetAttribute failed\n"); grid = -1; return; }
        if (hipOccupancyMaxActiveBlocksPerMultiprocessor(&per_cu, (const void*)mega_fwd, NWAVES * 64, LDS_BYTES) != hipSuccess || per_cu < 1) { fprintf(stderr, "kernel_launch: occupancy query says %d\n", per_cu); per_cu = 1; }
        (void)hipGetLastError();
        grid = cus;
        if (grid != 256) { fprintf(stderr, "kernel_launch: built for a 256-CU device, got %d\n", grid); grid = -1; return; }
    }
    if (grid < 0) return;
    if (hipMemsetAsync((char*)d_ws + WS_CTL, 0, CTL_ZERO_BYTES, stream) != hipSuccess) { fprintf(stderr, "kernel_launch: memset failed\n"); return; }
    Args a{};
    for (int i = 0; i < 31; ++i) a.in.p[i] = (const float*)d_in[i];
    a.out = (float*)d_out; a.ws = (unsigned char*)d_ws;
#if MK_ONE_LAUNCH
    a.ph_lo = 0; a.ph_hi = N_PHASES;
    void* kargs[] = {&a};
    hipError_t e = hipLaunchCooperativeKernel((const void*)mega_fwd, dim3(grid), dim3(NWAVES * 64), kargs, LDS_BYTES, stream);
    if (e != hipSuccess) fprintf(stderr, "kernel_launch: cooperative launch failed: %s\n", hipGetErrorString(e));
#else
    for (int ph = 0; ph < N_PHASES; ++ph) { a.ph_lo = ph; a.ph_hi = ph + 1;
        hipLaunchKernelGGL(mega_fwd, dim3(grid), dim3(NWAVES * 64), LDS_BYTES, stream, a);
        const hipError_t le = hipPeekAtLastError();
        if (le != hipSuccess) { fprintf(stderr, "kernel_launch: launch %d failed: %s\n", ph, hipGetErrorName(le)); break; } }
#endif
}
```

```cpp
#include <hip/hip_runtime.h>
#include <hip/hip_cooperative_groups.h>
#include <cstdio>
#include <cstdint>
namespace cg = cooperative_groups;
#ifndef MK_ONE_LAUNCH
#define MK_ONE_LAUNCH 1
#endif
#ifndef MK_TAILFILL
#define MK_TAILFILL 1
#endif
#ifndef REP_ATTN
#define REP_ATTN 1
#endif
#ifndef REP_GU
#define REP_GU 1
#endif
#ifndef REP_P0
#define REP_P0 1
#endif
#ifndef REP_SSM
#define REP_SSM 1
#endif
namespace pg8 {
#define PG8_LAS __attribute__((address_space(3)))
typedef unsigned short bf16_t;
typedef short bf16x8 __attribute__((ext_vector_type(8)));
typedef float f32x4 __attribute__((ext_vector_type(4)));
typedef unsigned u32x4 __attribute__((ext_vector_type(4)));
constexpr int BM = 256, BK = 64, HALF = 128, HTB = HALF * BK * 2  , STAGE_BYTES = 8 * HTB, NXCD = 8, WGM = 8;

__host__ __device__ __forceinline__ int lds_byte(int r, int c) { const int st = (r >> 4) * 2 + (c >> 5), rr = r & 15, cc = c & 31, ob = rr * 64 + cc * 2; return st * 1024 + (ob ^ (((ob >> 9) & 1) << 5)); }
__host__ __device__ __forceinline__ void stage_rc(int b, int& R, int& C) { const int st = b / 1024, sb = b % 1024, swz = sb ^ (((sb >> 9) & 1) << 5); R = (st >> 1) * 16 + swz / 64; C = (st & 1) * 32 + (swz % 64) / 2; }
__host__ __device__ __forceinline__ int perm32(int rho) { const int n = rho >> 4, i = rho & 15; return 8 * (i >> 2) + 4 * n + (i & 3); }

struct Unit { int pm, pn; };
struct Gemm { const bf16_t* A; const bf16_t* Bt; int M, N, K; };

struct StaticOrder {
    int nM, nN, nwg, G, c;
    __host__ __device__ void init(int M, int N, int G_, int c_) { nM = M / BM; nN = N / BM; nwg = nM * nN; G = G_; c = c_; }
    __host__ __device__ bool next(int i, Unit& u) const {
        const long L = (long)i * G + c; if (L >= nwg) return false;
        int wgid = (int)L; { const int q = nwg / NXCD, r = nwg % NXCD, xcd = wgid % NXCD, off = wgid / NXCD; wgid = (xcd < r ? xcd * (q + 1) : r * (q + 1) + (xcd - r) * q) + off; }
        const int nig = WGM * nN, gid = wgid / nig, fm = gid * WGM, gsz = (nM - fm) < WGM ? (nM - fm) : WGM;
        u.pm = fm + ((wgid % nig) % gsz); u.pn = (wgid % nig) / gsz; return true;
    }
    __device__ __forceinline__ void a_ready(const Unit&) const {}
    __device__ __forceinline__ void done(const Unit&) const {}
};

__device__ __forceinline__ unsigned cvt_pk_bf16(float lo, float hi) { unsigned r; asm volatile("v_cvt_pk_bf16_f32 %0, %1, %2" : "=v"(r) : "v"(lo), "v"(hi)); return r; }
typedef float f32x2 __attribute__((ext_vector_type(2)));
__device__ __forceinline__ float sigmoid_f(float v) { return __builtin_amdgcn_rcpf(1.0f + __builtin_amdgcn_exp2f(-1.4426950408889634f * v)); }
struct EpiSwiGlu {
    static constexpr bool PERM = true, AFTER_DRAIN = false;
    bf16_t* O; int ldc;
    __device__ __forceinline__ void operator()(const f32x4 (&acc)[2][2][4][2], const Unit& u, int wr, int wc, int fr, int fq) const {
        const int row0 = u.pm * BM + wr * 64 + fr, col0 = u.pn * HALF + wc * 32 + 8 * fq;
#pragma unroll
        for (int ai = 0; ai < 2; ++ai)
#pragma unroll
            for (int m = 0; m < 4; ++m) { bf16_t* rowp = O + (size_t)(row0 + ai * HALF + m * 16) * ldc + col0;
                const f32x4 g0 = acc[ai][0][m][0], g1 = acc[ai][0][m][1], u0 = acc[ai][1][m][0], u1 = acc[ai][1][m][1];
                float v[8];
#pragma unroll
                for (int i = 0; i < 4; ++i) { v[i] = g0[i] * sigmoid_f(g0[i]) * u0[i]; v[4 + i] = g1[i] * sigmoid_f(g1[i]) * u1[i]; }
                u32x4 w; w.x = cvt_pk_bf16(v[0], v[1]); w.y = cvt_pk_bf16(v[2], v[3]); w.z = cvt_pk_bf16(v[4], v[5]); w.w = cvt_pk_bf16(v[6], v[7]);
                *(u32x4*)rowp = w; }
    }
};
struct EpiResGate {
    static constexpr bool PERM = false, AFTER_DRAIN = false;
    const float* xin; float* xout; const float* gate; float coef; int ldc;
    __device__ __forceinline__ void operator()(const f32x4 (&acc)[2][2][4][2], const Unit& u, int wr, int wc, int fr, int fq) const {
        const int row0 = u.pm * BM + wr * 64 + fr, col0 = u.pn * BM + wc * 32 + 4 * fq;
        f32x4 gv[2][2];
#pragma unroll
        for (int bj = 0; bj < 2; ++bj)
#pragma unroll
            for (int n = 0; n < 2; ++n) gv[bj][n] = *(const f32x4*)(gate + col0 + bj * HALF + n * 16) * coef;
#pragma unroll
        for (int ai = 0; ai < 2; ++ai)
#pragma unroll
            for (int m = 0; m < 4; ++m) { const size_t off = (size_t)(row0 + ai * HALF + m * 16) * ldc + col0;
#pragma unroll
                for (int bj = 0; bj < 2; ++bj)
#pragma unroll
                    for (int n = 0; n < 2; ++n) { const f32x4 xi = *(const f32x4*)(xin + off + bj * HALF + n * 16);
                        *(f32x4*)(xout + off + bj * HALF + n * 16) = xi + gv[bj][n] * acc[ai][bj][m][n]; }
                if (m & 1) asm volatile("" ::: "memory"); }
    }
};
struct EpiWin {
    static constexpr bool PERM = true, AFTER_DRAIN = false;
    bf16_t *Q, *K, *V, *U; const float *qg, *kg; float qscale;
    __device__ __forceinline__ void operator()(const f32x4 (&acc)[2][2][4][2], const Unit& u, int wr, int wc, int fr, int fq) const {
        const int sec = u.pn >> 2, tile = u.pn & 3; const int row0 = u.pm * BM + wr * 64 + fr;
        if (sec < 2) {
            const float* gn = sec == 0 ? qg : kg; const float sc = sec == 0 ? qscale : 1.0f;
            bf16_t* base = sec == 0 ? Q : K;
            f32x4 gv[2][2];
#pragma unroll
            for (int bj = 0; bj < 2; ++bj)
#pragma unroll
                for (int n = 0; n < 2; ++n) gv[bj][n] = *(const f32x4*)(gn + 32 * bj + 8 * fq + 4 * n) * sc;
            const int col0 = tile * 256 + wc * 64 + 8 * fq;
#pragma unroll
            for (int ai = 0; ai < 2; ++ai)
#pragma unroll
                for (int m = 0; m < 4; ++m) {
                    float ss = 0.f;
#pragma unroll
                    for (int bj = 0; bj < 2; ++bj)
#pragma unroll
                        for (int n = 0; n < 2; ++n) { const f32x4 x = acc[ai][bj][m][n]; ss += (x[0] * x[0] + x[1] * x[1]) + (x[2] * x[2] + x[3] * x[3]); }
                    ss += __shfl_xor(ss, 16); ss += __shfl_xor(ss, 32);
                    const float r = __builtin_amdgcn_rsqf(ss * (1.0f / 64.0f) + 1e-6f);
                    bf16_t* rowp = base + (size_t)(row0 + ai * HALF + m * 16) * 1024 + col0;
#pragma unroll
                    for (int bj = 0; bj < 2; ++bj) { const f32x4 v0 = acc[ai][bj][m][0] * gv[bj][0] * r, v1 = acc[ai][bj][m][1] * gv[bj][1] * r;
                        u32x4 w; w.x = cvt_pk_bf16(v0[0], v0[1]); w.y = cvt_pk_bf16(v0[2], v0[3]); w.z = cvt_pk_bf16(v1[0], v1[1]); w.w = cvt_pk_bf16(v1[2], v1[3]);
                        *(u32x4*)(rowp + 32 * bj) = w; }
                }
        } else {
            bf16_t* base = sec == 2 ? V : U; const int col0 = tile * 256 + wc * 32 + 8 * fq;
#pragma unroll
            for (int ai = 0; ai < 2; ++ai)
#pragma unroll
                for (int m = 0; m < 4; ++m) { bf16_t* rowp = base + (size_t)(row0 + ai * HALF + m * 16) * 1024 + col0;
#pragma unroll
                    for (int bj = 0; bj < 2; ++bj) { const f32x4 v0 = acc[ai][bj][m][0], v1 = acc[ai][bj][m][1];
                        u32x4 w; w.x = cvt_pk_bf16(v0[0], v0[1]); w.y = cvt_pk_bf16(v0[2], v0[3]); w.z = cvt_pk_bf16(v1[0], v1[1]); w.w = cvt_pk_bf16(v1[2], v1[3]);
                        *(u32x4*)(rowp + HALF * bj) = w; } }
        }
    }
};
__device__ __forceinline__ float bf_lo(unsigned w) { return __uint_as_float(w << 16); }
__device__ __forceinline__ float bf_hi(unsigned w) { return __uint_as_float(w & 0xffff0000u); }
struct EpiGlu {
    static constexpr bool PERM = true, AFTER_DRAIN = false;
    const bf16_t* YG; bf16_t* CAT; const float* bias;
    __device__ __forceinline__ void operator()(const f32x4 (&acc)[2][2][4][2], const Unit& u, int wr, int wc, int fr, int fq) const {
        const int row0 = u.pm * BM + wr * 64 + fr, col0 = u.pn * BM + wc * 32 + 8 * fq;
        f32x4 bv[2][2];
#pragma unroll
        for (int bj = 0; bj < 2; ++bj)
#pragma unroll
            for (int n = 0; n < 2; ++n) bv[bj][n] = *(const f32x4*)(bias + col0 + bj * HALF + 4 * n);
#pragma unroll
        for (int ai = 0; ai < 2; ++ai)
#pragma unroll
            for (int m = 0; m < 4; ++m) { const size_t row = (size_t)(row0 + ai * HALF + m * 16);
#pragma unroll
                for (int bj = 0; bj < 2; ++bj) { const f32x4 z0 = acc[ai][bj][m][0] + bv[bj][0], z1 = acc[ai][bj][m][1] + bv[bj][1];
                    const u32x4 y = *(const u32x4*)(YG + row * 1024 + col0 + bj * HALF);
                    u32x4 w;
                    w.x = cvt_pk_bf16(bf_lo(y.x) * sigmoid_f(z0[0]), bf_hi(y.x) * sigmoid_f(z0[1])); w.y = cvt_pk_bf16(bf_lo(y.y) * sigmoid_f(z0[2]), bf_hi(y.y) * sigmoid_f(z0[3]));
                    w.z = cvt_pk_bf16(bf_lo(y.z) * sigmoid_f(z1[0]), bf_hi(y.z) * sigmoid_f(z1[1])); w.w = cvt_pk_bf16(bf_lo(y.w) * sigmoid_f(z1[2]), bf_hi(y.w) * sigmoid_f(z1[3]));
                    *(u32x4*)(CAT + row * 2048 + 1024 + col0 + bj * HALF) = w; } }
    }
};

template <class Epi, class Sched, bool ALIGN_EPI = false, bool SP2 = false>
__device__ __forceinline__ void gemm_phase(PG8_LAS unsigned char* lds, const Gemm g, const Sched& S, const Epi& E) {
    int tid_ = threadIdx.x; asm volatile("" : "+v"(tid_));
    const int tid = tid_, wid = __builtin_amdgcn_readfirstlane(tid >> 6), lane = tid & 63, wr = wid >> 2, wc = wid & 3, fr = lane & 15, fq = lane >> 4;
    const int K = g.K, nt = K / BK;
    unsigned voffA[2], voffB[2];
#pragma unroll
    for (int i = 0; i < 2; ++i) { int R, C; stage_rc(tid * 16 + i * 8192, R, C); const int Rb = Epi::PERM ? ((R & ~31) + perm32(R & 31)) : R;
        voffA[i] = (unsigned)(R * K + C) * 2u; voffB[i] = (unsigned)(Rb * K + C) * 2u; }
    const size_t kstep = (size_t)(BK * 2);
    const size_t hstep = (size_t)HALF * K * 2;
    const size_t tstep = 2 * hstep;
    const unsigned ldsw = (unsigned)wid * 1024u;
    const int aoff = lds_byte(wr * 64 + fr, fq * 8), boff = lds_byte(wc * 32 + fr, fq * 8);
#define PG8_SA(b, h) (((b) * 2 + (h)) * HTB)
#define PG8_SB(b, h) ((4 + (b) * 2 + (h)) * HTB)
#define PG8_STAGE(bufoff, gbase, voff) do { _Pragma("unroll") for (int _i = 0; _i < 2; ++_i) \
        __builtin_amdgcn_global_load_lds((const unsigned*)((const char*)(gbase) + (voff)[_i]), (PG8_LAS unsigned*)(lds + (bufoff) + ldsw + _i * 8192), 16, 0, 0); } while (0)
#define PG8_LDA(dst, b, h) do { _Pragma("unroll") for (int m = 0; m < 4; ++m) _Pragma("unroll") for (int k = 0; k < 2; ++k) dst[m][k] = *(const PG8_LAS bf16x8*)(lds + PG8_SA(b, h) + aoff + m * 2048 + k * 1024); } while (0)
#define PG8_LDB(dst, b, h) do { _Pragma("unroll") for (int n = 0; n < 2; ++n) _Pragma("unroll") for (int k = 0; k < 2; ++k) dst[n][k] = *(const PG8_LAS bf16x8*)(lds + PG8_SB(b, h) + boff + n * 2048 + k * 1024); } while (0)
#define PG8_MMA(ai, bj, At, Bt) do { __builtin_amdgcn_s_setprio(1); _Pragma("unroll") for (int m = 0; m < 4; ++m) _Pragma("unroll") for (int n = 0; n < 2; ++n) _Pragma("unroll") for (int k = 0; k < 2; ++k) \
        acc[ai][bj][m][n] = __builtin_amdgcn_mfma_f32_16x16x32_bf16(Bt[n][k], At[m][k], acc[ai][bj][m][n], 0, 0, 0); __builtin_amdgcn_s_setprio(0); } while (0)
#define PG8_WAIT_V(n) asm volatile("s_waitcnt vmcnt(" #n ")" ::: "memory")
#define PG8_WAIT_L(n) asm volatile("s_waitcnt lgkmcnt(" #n ")" ::: "memory")
#define PG8_BAR __builtin_amdgcn_s_barrier()
#define PG8_SCHED __builtin_amdgcn_sched_barrier(0)
    Unit cur, nxt; int ui = 0;
    if (!S.next(0, cur)) return;
    f32x4 acc[2][2][4][2];
#pragma unroll
    for (int a = 0; a < 2; ++a)
#pragma unroll
        for (int b = 0; b < 2; ++b)
#pragma unroll
            for (int m = 0; m < 4; ++m)
#pragma unroll
                for (int n = 0; n < 2; ++n) acc[a][b][m][n] = (f32x4){0.f, 0.f, 0.f, 0.f};
    bf16x8 At[4][2], B0[2][2], B1[2][2];
    const char* cA = (const char*)g.A + (size_t)cur.pm * tstep; const char* cB = (const char*)g.Bt + (size_t)cur.pn * tstep;
    S.a_ready(cur);
    if constexpr (SP2) {
        PG8_STAGE(PG8_SB(0, 0), cB, voffB); PG8_STAGE(PG8_SB(0, 1), cB + hstep, voffB); PG8_STAGE(PG8_SA(0, 0), cA, voffA); PG8_STAGE(PG8_SA(0, 1), cA + hstep, voffA);
        if (wr == 1) PG8_BAR;
        PG8_WAIT_V(2); PG8_BAR;
        PG8_STAGE(PG8_SB(1, 0), cB + kstep, voffB); PG8_STAGE(PG8_SA(1, 0), cA + kstep, voffA); PG8_STAGE(PG8_SB(1, 1), cB + hstep + kstep, voffB);
        PG8_WAIT_V(6); PG8_BAR;
    } else {
        PG8_STAGE(PG8_SB(0, 0), cB, voffB); PG8_STAGE(PG8_SA(0, 0), cA, voffA); PG8_STAGE(PG8_SB(0, 1), cB + hstep, voffB); PG8_STAGE(PG8_SA(0, 1), cA + hstep, voffA);
        if (wr == 1) PG8_BAR;
        PG8_WAIT_V(4); PG8_BAR;
        PG8_STAGE(PG8_SB(1, 0), cB + kstep, voffB); PG8_STAGE(PG8_SA(1, 0), cA + kstep, voffA); PG8_STAGE(PG8_SB(1, 1), cB + hstep + kstep, voffB);
        PG8_WAIT_V(6); PG8_BAR;
    }
    for (;;) {
        const bool has_next = S.next(ui + 1, nxt);
        const char* nA = has_next ? (const char*)g.A + (size_t)nxt.pm * tstep : cA; const char* nB = has_next ? (const char*)g.Bt + (size_t)nxt.pn * tstep : cB;
        for (int t = 0; t < nt; t += 2) {
            const bool last = (t == nt - 2);
            const char* a1 = cA + (size_t)(t + 1) * kstep;
            const char* a2 = last ? nA : cA + (size_t)(t + 2) * kstep; const char* b2 = last ? nB : cB + (size_t)(t + 2) * kstep;
            const char* a3 = a2 + kstep; const char* b3 = b2 + kstep;
            if (last && has_next) S.a_ready(nxt);
            if constexpr (SP2) {
            PG8_LDB(B0, 0, 0); PG8_LDB(B1, 0, 1); PG8_SCHED; PG8_LDA(At, 0, 0); PG8_STAGE(PG8_SA(1, 1), a1 + hstep, voffA);
            PG8_WAIT_V(8); PG8_WAIT_L(0); PG8_BAR; PG8_MMA(0, 0, At, B0); PG8_MMA(0, 1, At, B1); PG8_BAR; PG8_SCHED;
            PG8_LDA(At, 0, 1); PG8_STAGE(PG8_SB(0, 0), b2, voffB); PG8_STAGE(PG8_SB(0, 1), b2 + hstep, voffB); PG8_STAGE(PG8_SA(0, 0), a2, voffA);
            PG8_WAIT_V(8); PG8_WAIT_L(0); PG8_BAR; PG8_MMA(1, 0, At, B0); PG8_MMA(1, 1, At, B1); PG8_BAR; PG8_SCHED;
            PG8_LDB(B0, 1, 0); PG8_LDB(B1, 1, 1); PG8_SCHED; PG8_LDA(At, 1, 0); PG8_STAGE(PG8_SA(0, 1), a2 + hstep, voffA);
            PG8_WAIT_V(8); PG8_WAIT_L(0); PG8_BAR; PG8_MMA(0, 0, At, B0); PG8_MMA(0, 1, At, B1); PG8_BAR; PG8_SCHED;
            PG8_LDA(At, 1, 1); PG8_STAGE(PG8_SB(1, 0), b3, voffB); PG8_STAGE(PG8_SB(1, 1), b3 + hstep, voffB); PG8_STAGE(PG8_SA(1, 0), a3, voffA);
            PG8_WAIT_V(8); PG8_WAIT_L(0); PG8_BAR; PG8_MMA(1, 0, At, B0); PG8_MMA(1, 1, At, B1); PG8_BAR; PG8_SCHED;
            } else {
            PG8_LDB(B0, 0, 0); PG8_SCHED; PG8_LDA(At, 0, 0); PG8_STAGE(PG8_SA(1, 1), a1 + hstep, voffA);
            PG8_WAIT_L(8); PG8_BAR; PG8_WAIT_L(0); PG8_MMA(0, 0, At, B0); PG8_BAR; PG8_SCHED;
            PG8_LDB(B1, 0, 1); PG8_STAGE(PG8_SB(0, 0), b2, voffB);
            PG8_BAR; PG8_WAIT_L(0); PG8_MMA(0, 1, At, B1); PG8_BAR;
            PG8_LDA(At, 0, 1); PG8_STAGE(PG8_SA(0, 0), a2, voffA);
            PG8_BAR; PG8_WAIT_L(0); PG8_MMA(1, 0, At, B0); PG8_BAR; PG8_SCHED;
            PG8_STAGE(PG8_SB(0, 1), b2 + hstep, voffB);
            PG8_WAIT_V(6); PG8_BAR; PG8_MMA(1, 1, At, B1); PG8_BAR;
            PG8_LDB(B0, 1, 0); PG8_SCHED; PG8_LDA(At, 1, 0); PG8_STAGE(PG8_SA(0, 1), a2 + hstep, voffA);
            PG8_WAIT_L(8); PG8_BAR; PG8_WAIT_L(0); PG8_MMA(0, 0, At, B0); PG8_BAR; PG8_SCHED;
            PG8_LDB(B1, 1, 1); PG8_STAGE(PG8_SB(1, 0), b3, voffB);
            PG8_BAR; PG8_WAIT_L(0); PG8_MMA(0, 1, At, B1); PG8_BAR;
            PG8_LDA(At, 1, 1); PG8_STAGE(PG8_SA(1, 0), a3, voffA);
            PG8_BAR; PG8_WAIT_L(0); PG8_MMA(1, 0, At, B0); PG8_BAR; PG8_SCHED;
            PG8_STAGE(PG8_SB(1, 1), b3 + hstep, voffB);
            PG8_WAIT_V(6); PG8_BAR; PG8_MMA(1, 1, At, B1); PG8_BAR;
            }
        }
        if constexpr (ALIGN_EPI) { if (wr == 0) PG8_BAR; }
        if constexpr (!Epi::AFTER_DRAIN) { E(acc, cur, wr, wc, fr, fq); S.done(cur); }
        if (!has_next) break;
#pragma unroll
        for (int a = 0; a < 2; ++a)
#pragma unroll
            for (int b = 0; b < 2; ++b)
#pragma unroll
                for (int m = 0; m < 4; ++m)
#pragma unroll
                    for (int n = 0; n < 2; ++n) acc[a][b][m][n] = (f32x4){0.f, 0.f, 0.f, 0.f};
        cur = nxt; cA = nA; cB = nB; ++ui;
        if constexpr (ALIGN_EPI) { if (wr == 1) PG8_BAR; }
    }
    PG8_WAIT_V(0);
    if constexpr (!ALIGN_EPI) { if (wr == 0) PG8_BAR; }
    PG8_BAR;
    if constexpr (Epi::AFTER_DRAIN) { E.fused(acc, cur, wr, wc, fr, fq, lds, wid, lane); S.done(cur); }
#undef PG8_SA
#undef PG8_SB
#undef PG8_STAGE
#undef PG8_LDA
#undef PG8_LDB
#undef PG8_MMA
#undef PG8_WAIT_V
#undef PG8_WAIT_L
#undef PG8_BAR
#undef PG8_SCHED
}
}
#include <hip/hip_bf16.h>
#include <cmath>
namespace attn_body {
using bf16=__hip_bfloat16;
using bf16x8=__attribute__((ext_vector_type(8)))short;
using s16x4=__attribute__((ext_vector_type(4)))short;
using f32x16=__attribute__((ext_vector_type(16)))float;
using u32x4=__attribute__((ext_vector_type(4)))unsigned;
constexpr int SEQ=8192,D=64,DM=1024,OPITCH=2048;
constexpr int NW=8,QBLK=32,QB=QBLK*NW,KVBLK=64,NQB=SEQ/QB;
constexpr int ATTN_PITCH=DM, ATTN_UNIT_ROWS=QB;
__device__ __forceinline__ int crow(int r,int hi){return (r&3)+8*(r>>2)+4*hi;}
#define SBAR() __builtin_amdgcn_sched_barrier(0)
typedef const __attribute__((address_space(3))) float* lds_cfptr;
__device__ __forceinline__ void cmask(f32x16&p0,f32x16&p1,int jb,int qrel,int hi,lds_cfptr bt){
  const float NEG=-INFINITY; int kb=64*jb+4*hi;
  #pragma unroll
  for(int r=0;r<16;++r){int kv=kb+(r&3)+8*(r>>2); int d0=qrel-kv, d1=d0-32;
    unsigned i0=(unsigned)d0<127u?(unsigned)d0:127u, i1=(unsigned)d1<127u?(unsigned)d1:127u;
    float b0=bt[i0], b1=bt[i1];
    p0[r]=(d0<0)?NEG:p0[r]+b0; p1[r]=(d1<0)?NEG:p1[r]+b1;}
}

constexpr int NSLOT=3, SLOTB=8192;
constexpr int LDS_K=0, LDS_V=NSLOT*SLOTB, LDS_WS=2*NSLOT*SLOTB, LDS_OST=LDS_WS+NW*64*4, LDS_BT=LDS_OST+NW*4096, LDS_BYTES=LDS_BT+512;
constexpr float C2=0.125f*1.4426950408889634f;
__device__ __forceinline__ void glds16(const void*gsrc,unsigned lds_dst){unsigned keep;
  asm volatile("s_mov_b32 %0, m0\n\ts_mov_b32 m0, %2\n\ts_nop 0\n\tglobal_load_lds_dwordx4 %1, off\n\ts_mov_b32 m0, %0":"=&s"(keep):"v"(gsrc),"s"(lds_dst):"memory");}
__device__ __forceinline__ float max3f(float a,float b,float c){float r;asm("v_max3_f32 %0, %1, %2, %3":"=v"(r):"v"(a),"v"(b),"v"(c));return r;}
__device__ __forceinline__ float max2f(float a,float b){float r;asm("v_max_f32_e32 %0, %1, %2":"=v"(r):"v"(a),"v"(b));return r;}
__device__ __forceinline__ float fadd_s(float a,float b){float r;asm("v_add_f32_e32 %0, %1, %2":"=v"(r):"v"(a),"v"(b));return r;}
__device__ __forceinline__ float fsub_s(float a,float b){float r;asm("v_sub_f32_e32 %0, %1, %2":"=v"(r):"v"(a),"v"(b));return r;}
typedef float f32x2_t __attribute__((ext_vector_type(2))); typedef __bf16 bf16x2_t __attribute__((ext_vector_type(2)));
__device__ __forceinline__ unsigned cvtpk_s(float lo,float hi){f32x2_t v={lo,hi};bf16x2_t b=__builtin_convertvector(v,bf16x2_t);return __builtin_bit_cast(unsigned,b);}
#define WAIT_BAR(N) asm volatile("s_waitcnt vmcnt(" #N ") lgkmcnt(0)\n\ts_barrier":::"memory")

__device__ __forceinline__ void qkt(f32x16&p0,f32x16&p1,const char*Kslot,const bf16x8*qr,const f32x16&negm,int r32,int hi){
  const char*kb=Kslot+hi*1024+r32*16;
  #pragma unroll
  for(int d0=0;d0<4;++d0){
    const bf16x8 b0=*reinterpret_cast<const bf16x8*>(kb+d0*2048);
    const bf16x8 b1=*reinterpret_cast<const bf16x8*>(kb+d0*2048+512);
    if(d0==0){p0=__builtin_amdgcn_mfma_f32_32x32x16_bf16(b0,qr[0],negm,0,0,0);p1=__builtin_amdgcn_mfma_f32_32x32x16_bf16(b1,qr[0],negm,0,0,0);}
    else{p0=__builtin_amdgcn_mfma_f32_32x32x16_bf16(b0,qr[d0],p0,0,0,0);p1=__builtin_amdgcn_mfma_f32_32x32x16_bf16(b1,qr[d0],p1,0,0,0);}}
}
typedef __attribute__((address_space(3))) const char* lds_cptr;
typedef short v4i16_t __attribute__((ext_vector_type(4)));
__device__ __forceinline__ void kload8(bf16x8*kf,lds_cptr kp){
  kf[0]=*(const __attribute__((address_space(3))) bf16x8*)(kp);      kf[1]=*(const __attribute__((address_space(3))) bf16x8*)(kp+512);
  kf[2]=*(const __attribute__((address_space(3))) bf16x8*)(kp+2048); kf[3]=*(const __attribute__((address_space(3))) bf16x8*)(kp+2560);
  kf[4]=*(const __attribute__((address_space(3))) bf16x8*)(kp+4096); kf[5]=*(const __attribute__((address_space(3))) bf16x8*)(kp+4608);
  kf[6]=*(const __attribute__((address_space(3))) bf16x8*)(kp+6144); kf[7]=*(const __attribute__((address_space(3))) bf16x8*)(kp+6656);
}
__device__ __forceinline__ void kload2(bf16x8*kf,lds_cptr kp,int j){ kf[2*j]=*(const __attribute__((address_space(3))) bf16x8*)(kp+j*2048); kf[2*j+1]=*(const __attribute__((address_space(3))) bf16x8*)(kp+j*2048+512); }
__device__ __forceinline__ s16x4 vtr(lds_cptr p){ return __builtin_bit_cast(s16x4,__builtin_amdgcn_ds_read_tr16_b64_v4i16((__attribute__((address_space(3))) v4i16_t*)p)); }
__device__ __forceinline__ float rowmax(const f32x16&p0,const f32x16&p1){
  float a=max3f(p0[0],p0[1],p1[0]),b=max3f(p0[2],p0[3],p1[1]);a=max3f(a,p1[2],p1[3]);
  #pragma unroll
  for(int r=4;r<16;r+=4){a=max3f(a,p0[r],p0[r+1]);b=max3f(b,p0[r+2],p0[r+3]);a=max3f(a,p1[r],p1[r+1]);b=max3f(b,p1[r+2],p1[r+3]);}
  const float m=max2f(a,b);
  auto rr=__builtin_amdgcn_permlane32_swap(__float_as_uint(m),__float_as_uint(m),false,false);
  return max2f(__uint_as_float(rr[0]),__uint_as_float(rr[1]));
}
__device__ __forceinline__ void pv(f32x16*o,int vb,bf16x8 pa0,bf16x8 pa1,bf16x8 pa2,bf16x8 pa3){
  #pragma unroll
  for(int d0=0;d0<2;++d0){s16x4 lo[4],hi[4];
    #pragma unroll
    for(int ks=0;ks<4;++ks){
      asm volatile("ds_read_b64_tr_b16 %0,%1 offset:%c2":"=&v"(lo[ks]):"v"(vb),"i"(d0*4096+ks*1024):"memory");
      asm volatile("ds_read_b64_tr_b16 %0,%1 offset:%c2":"=&v"(hi[ks]):"v"(vb),"i"(d0*4096+ks*1024+512):"memory");}
    asm volatile("s_waitcnt lgkmcnt(0)":::"memory");SBAR();
    #define PK(k) (bf16x8){lo[k][0],lo[k][1],lo[k][2],lo[k][3],hi[k][0],hi[k][1],hi[k][2],hi[k][3]}
    o[d0]=__builtin_amdgcn_mfma_f32_32x32x16_bf16(pa0,PK(0),o[d0],0,0,0);
    o[d0]=__builtin_amdgcn_mfma_f32_32x32x16_bf16(pa1,PK(1),o[d0],0,0,0);
    o[d0]=__builtin_amdgcn_mfma_f32_32x32x16_bf16(pa2,PK(2),o[d0],0,0,0);
    o[d0]=__builtin_amdgcn_mfma_f32_32x32x16_bf16(pa3,PK(3),o[d0],0,0,0);
    #undef PK
  }
}

#ifndef ATTN_STORE16
#define ATTN_STORE16(p,v) (*(u32x4*)(p)=(v))
#endif
template<int THRL> __device__ __forceinline__ void attn_unit(int qcol,int vcol,int ocol,int hb,int qb,const bf16*Q,const bf16*K,const bf16*V,bf16*O,const float*biasd,char*shm){
  int tid_=threadIdx.x; asm volatile("":"+v"(tid_)); const int tid=tid_,lane=tid&63,r32=lane&31,hi=lane>>5; const int wid=__builtin_amdgcn_readfirstlane(tid>>6);
  const long rowbase=0; const int q0=qb*QB;
  const bf16*Qw=Q+(rowbase+q0+wid*QBLK)*DM+qcol;
  const bf16*Kh=K+rowbase*DM+qcol,*Vh=V+rowbase*DM+vcol;
  { __attribute__((address_space(3))) float* btw=(__attribute__((address_space(3))) float*)(lds_cptr)shm+LDS_BT/4; if(tid<128)btw[tid]=biasd[hb*128+tid]; }
  const lds_cfptr btab=(lds_cfptr)((lds_cptr)shm+LDS_BT);
  const unsigned lds0=(unsigned)(uintptr_t)shm;
  float*wsf=(float*)(shm+LDS_WS)+wid*64;
  const bf16*ksrc=Kh+(long)lane*DM+wid*8;
  const bf16*vsrc=Vh+(long)(16*(wid&3)+(lane>>2))*DM+(wid>>2)*32+(lane&3)*8;
  const unsigned kdst=lds0+LDS_K+wid*1024, vdst=lds0+LDS_V+wid*1024;
  #define DMA_K(t,slot) glds16(ksrc+(long)(t)*KVBLK*DM,(unsigned)__builtin_amdgcn_readfirstlane(kdst+(slot)))
  #define DMA_V(t,slot) glds16(vsrc+(long)(t)*KVBLK*DM,(unsigned)__builtin_amdgcn_readfirstlane(vdst+(slot)))
  const int vb0=(int)(lds0+LDS_V)+((lane>>4)&1)*32+(lane&3)*8+(4*hi+((lane&15)>>2))*64;
  const char*Kbase=shm+LDS_K; bf16x8 kf[8];
  const lds_cptr shm3=(lds_cptr)shm; const lds_cptr kp0=shm3+LDS_K+hi*1024+r32*16; const lds_cptr vp0=shm3+LDS_V+((lane>>4)&1)*32+(lane&3)*8+(4*hi+((lane&15)>>2))*64;
  const int NT=(q0+QB)/KVBLK;
  DMA_K(0,0);DMA_V(0,0);DMA_K(1,SLOTB);
  bf16x8 qr[4];
  #pragma unroll
  for(int d0=0;d0<4;++d0)qr[d0]=*reinterpret_cast<const bf16x8*>(&Qw[(long)r32*DM+d0*16+hi*8]);
  float mhat=0.f,l_reg=0.f;f32x16 o[2];o[0]=f32x16{};o[1]=f32x16{};f32x16 negm=f32x16{};asm volatile("":"+v"(negm));
  const int qrel=wid*QBLK+r32;
  #define CMASK(P0,P1,t) do{int jb_=(t)-(NT-4); if(jb_>=-2)cmask(P0,P1,jb_,qrel,hi,btab);}while(0)
  bool resc=false;
  #define START(P0,P1) do{ const float rm=rowmax(P0,P1); resc=false; \
    { const float dl=rm; mhat=fadd_s(mhat,dl); \
      _Pragma("unroll") for(int r=0;r<16;++r){P0[r]=fsub_s(P0[r],dl);P1[r]=fsub_s(P1[r],dl);} \
      _Pragma("unroll") for(int r=0;r<16;++r)negm[r]=-mhat; asm volatile("":"+v"(negm)); } \
    _Pragma("unroll") for(int r=0;r<16;++r)P0[r]=__builtin_amdgcn_exp2f(P0[r]); }while(0)
  #define RESC() do{ if(resc){ asm volatile("s_waitcnt lgkmcnt(0)":::"memory"); \
      _Pragma("unroll") for(int d_=0;d_<2;++d_) _Pragma("unroll") for(int r=0;r<16;++r)o[d_][r]*=wsf[crow(r,hi)]; } }while(0)
  f32x16 pA0,pA1,pB0,pB1;
  int sl_prev=0,sl_cur=0,sl_next=SLOTB;
  #define ROT() do{sl_prev=sl_cur;sl_cur=sl_next;sl_next=(sl_next==(NSLOT-1)*SLOTB)?0:sl_next+SLOTB;}while(0)
  DMA_K(2,2*SLOTB);
  WAIT_BAR(3);
  qkt(pA0,pA1,Kbase,qr,negm,r32,hi);asm volatile("s_nop 15\n\ts_nop 7":"+v"(pA0),"+v"(pA1));CMASK(pA0,pA1,0);
  START(pA0,pA1);
  _Pragma("unroll") for(int r=0;r<16;++r)pA1[r]=__builtin_amdgcn_exp2f(pA1[r]);
  WAIT_BAR(0);
  DMA_K(3,0);DMA_V(1,SLOTB);
  ROT();
  kload8(kf,kp0+sl_cur);
  WAIT_BAR(2);
  s16x4 vlo[8],vhi[8]; u32x4 pw0,pw1,pw2,pw3;
  #define PKW(P,B) cvtpk_s(P[B],P[B+1])
  #define PAF(k) __builtin_bit_cast(bf16x8,pw##k)
  #define VFR(i) (bf16x8){vlo[i][0],vlo[i][1],vlo[i][2],vlo[i][3],vhi[i][0],vhi[i][1],vhi[i][2],vhi[i][3]}
  #define PIN(x) asm volatile("":"+v"(x))
  #define MX3(a,b,c) __builtin_fmaxf(__builtin_fmaxf((a),(b)),(c))
  #define GAPA(MF,A0,A1,A2,A3,W0,W1,PW) do{ MF; sacc+=A0; sacc+=A1; sacc+=A2; sacc+=A3; PIN(sacc); W0; W1; PIN(PW); SBAR(); }while(0)
  #define EX(v) __builtin_amdgcn_exp2f(v)
  #define GAPB(MF,X,B) do{ MF; X[B]=EX(X[B]); X[B+1]=EX(X[B+1]); X[B+2]=EX(X[B+2]); X[B+3]=EX(X[B+3]); PIN(X); SBAR(); }while(0)
  #define VRD(i) do{ vlo[i]=vtr(vp_+(((i)>>2)*4096+((i)&3)*1024)); vhi[i]=vtr(vp_+(((i)>>2)*4096+((i)&3)*1024+512)); }while(0)
  #define KRD(G,j) do{ if(G){ kload2(kf,kp0+sl_next,j); SBAR(); } }while(0)
  #define STEP(C0,C1,P0,P1,t,GK,GV,GL) do{ SBAR(); \
    const lds_cptr vp_=vp0+sl_prev; \
    VRD(0); SBAR(); float sacc=(P0[0]+P0[1]); \
    GAPA(C0=__builtin_amdgcn_mfma_f32_32x32x16_bf16(kf[0],qr[0],negm,0,0,0), P0[2],P0[3],P0[4],P0[5],     pw0[0]=PKW(P0,0), pw0[1]=PKW(P0,2), pw0); \
    VRD(4); SBAR(); GAPA(C1=__builtin_amdgcn_mfma_f32_32x32x16_bf16(kf[1],qr[0],negm,0,0,0), P0[6],P0[7],P0[8],P0[9],     pw0[2]=PKW(P0,4), pw0[3]=PKW(P0,6), pw0); \
    VRD(1); SBAR(); GAPA(C0=__builtin_amdgcn_mfma_f32_32x32x16_bf16(kf[2],qr[1],C0,0,0,0),   P0[10],P0[11],P0[12],P0[13], pw1[0]=PKW(P0,8), pw1[1]=PKW(P0,10), pw1); \
    VRD(5); SBAR(); GAPA(C1=__builtin_amdgcn_mfma_f32_32x32x16_bf16(kf[3],qr[1],C1,0,0,0),   P0[14],P0[15],P1[0],P1[1],   pw1[2]=PKW(P0,12),pw1[3]=PKW(P0,14), pw1); \
    VRD(2); SBAR(); GAPA(C0=__builtin_amdgcn_mfma_f32_32x32x16_bf16(kf[4],qr[2],C0,0,0,0),   P1[2],P1[3],P1[4],P1[5],     pw2[0]=PKW(P1,0), pw2[1]=PKW(P1,2), pw2); \
    VRD(6); SBAR(); GAPA(C1=__builtin_amdgcn_mfma_f32_32x32x16_bf16(kf[5],qr[2],C1,0,0,0),   P1[6],P1[7],P1[8],P1[9],     pw2[2]=PKW(P1,4), pw2[3]=PKW(P1,6), pw2); \
    VRD(3); SBAR(); GAPA(C0=__builtin_amdgcn_mfma_f32_32x32x16_bf16(kf[6],qr[3],C0,0,0,0),   P1[10],P1[11],P1[12],P1[13], pw3[0]=PKW(P1,8), pw3[1]=PKW(P1,10), pw3); \
    VRD(7); SBAR(); GAPA(C1=__builtin_amdgcn_mfma_f32_32x32x16_bf16(kf[7],qr[3],C1,0,0,0),   P1[14],P1[15],0.f,0.f,       pw3[2]=PKW(P1,12),pw3[3]=PKW(P1,14), pw3); \
    l_reg+=sacc; \
    if(GK){DMA_K((t)+3,sl_cur);} if(GV){DMA_V((t)+1,sl_next);} \
    CMASK(C0,C1,t); \
    { float a=MX3(C0[0],C0[1],C1[0]),b=MX3(C0[2],C0[3],C1[1]); a=MX3(a,C1[2],C1[3]); \
      _Pragma("unroll") for(int r=4;r<16;r+=4){a=MX3(a,C0[r],C0[r+1]);b=MX3(b,C0[r+2],C0[r+3]);a=MX3(a,C1[r],C1[r+1]);b=MX3(b,C1[r+2],C1[r+3]);} \
      float rm=__builtin_fmaxf(a,b); { auto rr=__builtin_amdgcn_permlane32_swap(__float_as_uint(rm),__float_as_uint(rm),false,false); rm=__builtin_fmaxf(__uint_as_float(rr[0]),__uint_as_float(rr[1])); } \
      resc=false; \
      if(__builtin_expect(__any(rm>(float)THRL),0)){ const float dl=__builtin_fmaxf(rm,0.f); mhat+=dl; \
        _Pragma("unroll") for(int r=0;r<16;++r){C0[r]-=dl;C1[r]-=dl;} \
        _Pragma("unroll") for(int r=0;r<16;++r)negm[r]=-mhat; asm volatile("":"+v"(negm)); \
        const float f=__builtin_amdgcn_exp2f(-dl); l_reg*=f; if(hi==0)wsf[r32]=f; resc=true; } } \
    SBAR(); \
    GAPB(o[0]=__builtin_amdgcn_mfma_f32_32x32x16_bf16(PAF(0),VFR(0),o[0],0,0,0), C0,0); \
    GAPB(o[1]=__builtin_amdgcn_mfma_f32_32x32x16_bf16(PAF(0),VFR(4),o[1],0,0,0), C0,4); \
    KRD(GL,0); GAPB(o[0]=__builtin_amdgcn_mfma_f32_32x32x16_bf16(PAF(1),VFR(1),o[0],0,0,0), C0,8); \
    KRD(GL,1); GAPB(o[1]=__builtin_amdgcn_mfma_f32_32x32x16_bf16(PAF(1),VFR(5),o[1],0,0,0), C0,12); \
    KRD(GL,2); GAPB(o[0]=__builtin_amdgcn_mfma_f32_32x32x16_bf16(PAF(2),VFR(2),o[0],0,0,0), C1,0); \
    KRD(GL,3); GAPB(o[1]=__builtin_amdgcn_mfma_f32_32x32x16_bf16(PAF(2),VFR(6),o[1],0,0,0), C1,4); \
    GAPB(o[0]=__builtin_amdgcn_mfma_f32_32x32x16_bf16(PAF(3),VFR(3),o[0],0,0,0), C1,8); \
    GAPB(o[1]=__builtin_amdgcn_mfma_f32_32x32x16_bf16(PAF(3),VFR(7),o[1],0,0,0), C1,12); \
    }while(0)
  int t=1;
  #undef CMASK
  #define CMASK(P0,P1,t) do{}while(0)
  for(;t+7<NT;t+=2){
    STEP(pB0,pB1,pA0,pA1,t,true,true,true);     WAIT_BAR(2); RESC(); ROT();
    STEP(pA0,pA1,pB0,pB1,t+1,true,true,true);   WAIT_BAR(2); RESC(); ROT();
  }
  #undef CMASK
  #define CMASK(P0,P1,t) do{int jb_=(t)-(NT-4); if(jb_>=-2)cmask(P0,P1,jb_,qrel,hi,btab);}while(0)
  #define ENDW(tt) do{ if((tt)+3<NT){WAIT_BAR(2);} else if((tt)+2<NT){WAIT_BAR(1);} else {WAIT_BAR(0);} }while(0)
  for(;t+1<NT;t+=2){
    STEP(pB0,pB1,pA0,pA1,t,(t+3<NT),(t+1<NT),(t+1<NT));       ENDW(t);   RESC(); ROT();
    STEP(pA0,pA1,pB0,pB1,t+1,(t+4<NT),(t+2<NT),(t+2<NT));     ENDW(t+1); RESC(); ROT();
  }
  STEP(pB0,pB1,pA0,pA1,NT-1,false,false,false); RESC();
  { float sacc=pB0[0]+pB0[1]; _Pragma("unroll") for(int r=2;r<16;++r)sacc+=pB0[r]; _Pragma("unroll") for(int r=0;r<16;++r)sacc+=pB1[r]; l_reg+=sacc;
    pw0=(u32x4){PKW(pB0,0),PKW(pB0,2),PKW(pB0,4),PKW(pB0,6)};pw1=(u32x4){PKW(pB0,8),PKW(pB0,10),PKW(pB0,12),PKW(pB0,14)};pw2=(u32x4){PKW(pB1,0),PKW(pB1,2),PKW(pB1,4),PKW(pB1,6)};pw3=(u32x4){PKW(pB1,8),PKW(pB1,10),PKW(pB1,12),PKW(pB1,14)};
    SBAR(); pv(o,vb0+sl_cur,PAF(0),PAF(1),PAF(2),PAF(3)); }
  #undef PKW
  #undef PAF
  #undef VFR
  #undef PIN
  #undef MX3
  #undef GAPA
  #undef GAPB
  #undef EX
  #undef VRD
  #undef KRD
  #undef STEP
  #undef ENDW
  {auto rr=__builtin_amdgcn_permlane32_swap(__float_as_uint(l_reg),__float_as_uint(l_reg),false,false);l_reg=__uint_as_float(rr[0])+__uint_as_float(rr[1]);}
  if(hi==0)wsf[32+r32]=l_reg;asm volatile("s_waitcnt lgkmcnt(0)":::"memory");
  float rli[16];
  #pragma unroll
  for(int r=0;r<16;++r)rli[r]=__builtin_amdgcn_rcpf(wsf[32+crow(r,hi)]);
  bf16*Ow=O+(rowbase+q0+wid*QBLK)*OPITCH+ocol;
  { bf16*stg=(bf16*)(shm+LDS_OST)+wid*2048;
    #pragma unroll
    for(int r=0;r<16;++r){const int orow=crow(r,hi);
      #pragma unroll
      for(int d0=0;d0<2;++d0)stg[orow*64+d0*32+r32]=__float2bfloat16(o[d0][r]*rli[r]);}
    asm volatile("s_waitcnt lgkmcnt(0)":::"memory");
    #pragma unroll
    for(int i=0;i<4;++i){const int row=i*8+(lane>>3),ch=lane&7; const u32x4 v=*(const u32x4*)(stg+row*64+ch*8); ATTN_STORE16(Ow+(long)row*OPITCH+ch*8,v);} }
  asm volatile("s_waitcnt lgkmcnt(0)\n\ts_barrier":::"memory");
  #undef DMA_K
  #undef DMA_V
  #undef CMASK
  #undef START
  #undef RESC
  #undef ROT
}
constexpr int ATTN_LDS_BYTES=LDS_BYTES;
struct AttnTensors { const bf16* Q; const bf16* K; const bf16* V; bf16* O; const float* biasd; };
template<int THRL=8> __device__ __forceinline__ void attn_phase(char*lds,const AttnTensors&T,int vcu){
  const int inst=vcu>>3, s=vcu&7;
  for(int i=0;i<4;++i){ const int qb=(i==0)?s:(i==1)?15-s:(i==2)?16+s:31-s;
    attn_unit<THRL>((inst>>1)*64,(inst>>2)*128+(inst&1)*64,inst*64,inst>>2,qb,T.Q,T.K,T.V,T.O,T.biasd,lds); }
}
#undef SBAR
#undef WAIT_BAR
}
constexpr int NWAVES = 8;
constexpr int SEQ = 8192, DM = 2048, DFF = 5632, INW = 4096, AW = 1024, SW = 1024, NCOND = 9, DEPTH = 2;
constexpr int NG = 64, NP = 64, HC = 16;
constexpr int SCHUNK = 256, NCHUNK = SEQ / SCHUNK;
constexpr float LOG2E = 1.4426950408889634f;
constexpr size_t MiB = 1u << 20;
constexpr size_t WS_CTL = 0, CTL_ZERO_BYTES = 1 * MiB;
constexpr size_t WS_BIASD = 1 * MiB;
constexpr size_t WS_XEND = 2 * MiB;
constexpr size_t WS_WGU = 8 * MiB;
constexpr size_t WS_WD = WS_WGU + 4 * 44 * MiB;
constexpr size_t WS_WIN = WS_WD + 4 * 22 * MiB;
constexpr size_t WS_WOUT = WS_WIN + 2 * 16 * MiB;
constexpr size_t WS_WGLU = WS_WOUT + 2 * 8 * MiB;
constexpr size_t WS_H = WS_WGLU + 2 * 2 * MiB;
constexpr size_t WS_ACT = WS_H + 32 * MiB;
constexpr size_t WS_Q = WS_ACT + 88 * MiB;
constexpr size_t WS_K = WS_Q + 16 * MiB, WS_V = WS_K + 16 * MiB, WS_U = WS_V + 16 * MiB;
constexpr size_t WS_OP = WS_U + 16 * MiB;
constexpr size_t WS_CAT = WS_OP + 32 * MiB;
constexpr size_t WS_YG = WS_CAT + 32 * MiB;
constexpr size_t WS_END = WS_YG + 16 * MiB;
constexpr int RING_BYTES = 131072, LDS_BYTES = 147456;

#define LAS __attribute__((address_space(3)))
typedef unsigned short bf16;
typedef unsigned v4u __attribute__((ext_vector_type(4)));
typedef unsigned v2u __attribute__((ext_vector_type(2)));
typedef float f32x4 __attribute__((ext_vector_type(4)));
typedef float f32x2v __attribute__((ext_vector_type(2)));
typedef short bf16x8 __attribute__((ext_vector_type(8)));
#define LDS_WAIT() asm volatile("s_waitcnt lgkmcnt(0)" ::: "memory")
__device__ __forceinline__ unsigned pk2(float lo, float hi) { return pg8::cvt_pk_bf16(lo, hi); }
__device__ __forceinline__ float wave_sum(float v) {
#pragma unroll
    for (int o = 1; o < 64; o <<= 1) v += __shfl_xor(v, o);
    return v;
}

#define RLX_AGENT __ATOMIC_RELAXED, __HIP_MEMORY_SCOPE_AGENT
constexpr int CW_BAR = 65536;
constexpr int MISC_OFF = LDS_BYTES - 64;
#define XB_TMO      128
#define XB_XCNT(j)  (256  + 64 * (j))
#define XB_XSUB(j)  (1280 + 64 * (j))
#define XB_XGEN(j)  (2304 + 64 * (j))
#define XB_TOP      3328
#define XB_TOPGEN   3392
#define XCD_BAR_WORDS 3456
#define XB_SPIN_CAP (1u << 18)

__device__ __forceinline__ unsigned xb_ld(unsigned* p)              { return __hip_atomic_load(p, __ATOMIC_RELAXED, __HIP_MEMORY_SCOPE_AGENT); }
__device__ __forceinline__ unsigned xb_add(unsigned* p, unsigned v) { return __hip_atomic_fetch_add(p, v, __ATOMIC_RELAXED, __HIP_MEMORY_SCOPE_AGENT); }
__device__ __forceinline__ unsigned xb_xcc_id() { return (unsigned)__builtin_amdgcn_s_getreg((3 << 11) | 20) & 0xFu; }
#define XB_SPIN(cond, bar) do { unsigned _sp = 0; while (cond) { __builtin_amdgcn_s_sleep(1); \
    if ((++_sp & 255u) == 0u) { if (xb_ld(&(bar)[XB_TMO])) break; if (_sp > XB_SPIN_CAP) { atomicAdd(&(bar)[XB_TMO], 1u); break; } } } } while (0)

struct XcdBarrier {
    unsigned* bar; unsigned x;
    volatile LAS unsigned* st;
};

__device__ __forceinline__ XcdBarrier xcd_barrier_post(unsigned* bar, volatile LAS unsigned* st) {
    XcdBarrier b; b.bar = bar; b.x = xb_xcc_id(); b.st = st;
    if (threadIdx.x == 0) (void)xb_add(&bar[XB_XCNT(b.x)], 1u);
    return b;
}
__device__ __forceinline__ void xcd_barrier_complete(unsigned* bar, unsigned x, unsigned& nloc, unsigned& nx) {
    const unsigned G = gridDim.x * gridDim.y * gridDim.z;
    unsigned sum, cnt, mine, sp = 0u;
    for (;;) {
        sum = 0u; cnt = 0u; mine = 0u;
#pragma unroll
        for (unsigned j = 0; j < 16; ++j) { const unsigned c = xb_ld(&bar[XB_XCNT(j)]); sum += c; cnt += (c > 0u) ? 1u : 0u; mine = (j == x) ? c : mine; }
        if (sum == G) break;
        __builtin_amdgcn_s_sleep(1);
        if ((++sp & 255u) == 0u) { if (xb_ld(&bar[XB_TMO])) break; if (sp > XB_SPIN_CAP) { atomicAdd(&bar[XB_TMO], 1u); break; } }
    }
    nloc = mine > 0u ? mine : 1u; nx = cnt > 0u ? cnt : 1u;
}

__device__ __forceinline__ void xcd_barrier(const XcdBarrier& b) {
    asm volatile("s_waitcnt vmcnt(0)" ::: "memory");
    __syncthreads();
    if (threadIdx.x == 0) {
        unsigned* bar = b.bar;
        __builtin_amdgcn_s_waitcnt(0);
        unsigned nloc = b.st[0], nx = b.st[1];
        if (nloc == 0u) { xcd_barrier_complete(bar, b.x, nloc, nx); b.st[0] = nloc; b.st[1] = nx; }
        const unsigned old = xb_add(&bar[XB_XSUB(b.x)], 1u);
        const unsigned gen = old / nloc;
        if (old + 1u == (gen + 1u) * nloc) {
            __builtin_amdgcn_fence(__ATOMIC_RELEASE, "agent");
            asm volatile("s_waitcnt vmcnt(0)" ::: "memory");
            const unsigned og = xb_add(&bar[XB_TOP], 1u);
            const unsigned tg = og / nx;
            if (og + 1u == (tg + 1u) * nx) xb_add(&bar[XB_TOPGEN], 1u);
            else XB_SPIN(xb_ld(&bar[XB_TOPGEN]) == tg, bar);
            __builtin_amdgcn_fence(__ATOMIC_ACQUIRE, "agent");
            xb_add(&bar[XB_XGEN(b.x)], 1u);
            asm volatile("s_waitcnt vmcnt(0)" ::: "memory");
        } else {
            XB_SPIN(xb_ld(&bar[XB_XGEN(b.x)]) == gen, bar);
            __builtin_amdgcn_fence(__ATOMIC_ACQUIRE, "agent");
            asm volatile("s_waitcnt vmcnt(0)" ::: "memory");
        }
    }
    __syncthreads();
}

struct Frame {
    LAS unsigned char* lds;
    int tid, lane, wave, vcu, G;
};
__device__ __forceinline__ Frame frame_opaque(const Frame& F0) { Frame F = F0; asm volatile("" : "+v"(F.tid)); F.lane = F.tid & 63; return F; }

struct TrItem { const float* W; bf16* WT; int K, N, mode, k0, n0; };
__device__ __forceinline__ int tr_drow(int mode, int n) {
    if (mode == 1 || mode == 2) return (n >> 7) * 256 + (mode - 1) * 128 + (n & 127);
    if (mode == 3 && n < 2048) { const int pn = n >> 8, cc = n & 255; return pn * 256 + ((cc >> 5) & 1) * 128 + (cc >> 6) * 32 + (cc & 31); }
    return n;
}
__device__ __forceinline__ void tr_load(const TrItem& t, int lane, f32x4 (&v)[16]) {
    const float* src = t.W + (size_t)(t.k0 + (lane >> 4)) * t.N + t.n0 + 4 * (lane & 15);
#pragma unroll
    for (int i = 0; i < 16; ++i) v[i] = *(const f32x4*)(src + (size_t)(4 * i) * t.N);
}
__device__ __forceinline__ void tr_store(const TrItem& t, int lane, const f32x4 (&v)[16], LAS float* scr) {
    const int r = lane >> 4, c4 = lane & 15;
#pragma unroll
    for (int i = 0; i < 16; ++i) { LAS float* d = scr + (4 * i + r) * 65 + 4 * c4; d[0] = v[i][0]; d[1] = v[i][1]; d[2] = v[i][2]; d[3] = v[i][3]; }
    LDS_WAIT(); asm volatile("" ::: "memory");
    const int c = lane & 7;
#pragma unroll
    for (int j = 0; j < 8; ++j) { const int n = (lane >> 3) + 8 * j; const LAS float* s = scr + (8 * c) * 65 + n;
        v4u o; o.x = pk2(s[0 * 65], s[1 * 65]); o.y = pk2(s[2 * 65], s[3 * 65]); o.z = pk2(s[4 * 65], s[5 * 65]); o.w = pk2(s[6 * 65], s[7 * 65]);
        *(v4u*)(t.WT + (size_t)tr_drow(t.mode, t.n0 + n) * t.K + t.k0 + 8 * c) = o; }
    LDS_WAIT(); asm volatile("" ::: "memory");
}
struct In { const float* p[31]; };
__device__ __forceinline__ const float* inp(int i) { const float* const __attribute__((address_space(4)))* t = (const float* const __attribute__((address_space(4)))*)__builtin_amdgcn_kernarg_segment_ptr(); asm volatile("" : "+s"(t)); return t[i]; }
__device__ __forceinline__ int t5_bucket(int d) {
    if (d < 16) return d;
    int b = 16; b += d >= 19; b += d >= 21; b += d >= 24; b += d >= 27; b += d >= 31; b += d >= 35; b += d >= 40; b += d >= 46; b += d >= 52; b += d >= 59; b += d >= 67; b += d >= 77; b += d >= 87; b += d >= 99; b += d >= 113;
    return b;
}
constexpr int I_F = (DM / 64) * (DFF / 64), I_IN = (DM / 64) * (INW / 64), I_OUT = (DM / 64) * (DM / 64), I_GLU = (SW / 64) * (SW / 64);
constexpr int PER_LAYER = 6 * I_F + I_IN + I_OUT + I_GLU;
__device__ __forceinline__ TrItem tr_decode(unsigned char* ws, int it) {
    const int li = it / PER_LAYER; int r = it % PER_LAYER; TrItem t;
    const size_t fo = (size_t)li * DM * DFF;
    if (r < 6 * I_F) { const int w = r / I_F; r -= w * I_F; const int ffn = w / 3, kind = w % 3;
        t.W = inp(6 + w) + fo;
        if (kind < 2) { t.K = DM; t.N = DFF; t.mode = 1 + kind; t.WT = (bf16*)(ws + WS_WGU) + (size_t)(li * 2 + ffn) * 2 * DFF * DM; }
        else { t.K = DFF; t.N = DM; t.mode = 0; t.WT = (bf16*)(ws + WS_WD) + (size_t)(li * 2 + ffn) * DM * DFF; } }
    else if ((r -= 6 * I_F) < I_IN) { t.W = inp(12) + (size_t)li * DM * INW; t.K = DM; t.N = INW; t.mode = 3; t.WT = (bf16*)(ws + WS_WIN) + (size_t)li * INW * DM; }
    else if ((r -= I_IN) < I_OUT) { t.W = inp(13) + (size_t)li * DM * DM; t.K = DM; t.N = DM; t.mode = 0; t.WT = (bf16*)(ws + WS_WOUT) + (size_t)li * DM * DM; }
    else { r -= I_OUT; t.W = inp(29) + (size_t)li * SW * SW; t.K = SW; t.N = SW; t.mode = 0; t.WT = (bf16*)(ws + WS_WGLU) + (size_t)li * SW * SW; }
    const int nblk = t.N / 64; t.k0 = 64 * (r / nblk); t.n0 = 64 * (r % nblk); return t;
}
__device__ __forceinline__ void convert_job(const Frame& F0, unsigned char* ws, int a0, int a1, int b0, int b1, int c0, int c1, int gm, int rank, int nw) { const Frame F = frame_opaque(F0);
    LAS float* scr = (LAS float*)(F.lds + F.wave * 16640);
    const int na = a1 - a0, nab = na + (b1 - b0), ntot = nab + (c1 - c0);
#define CJ_IDX(j) ((j) < na ? a0 + (j) : (j) < nab ? b0 + ((j) - na) : c0 + ((j) - nab))
    { int j = rank; TrItem cur; f32x4 va[16], vb[16];
      if (j < ntot) { cur = tr_decode(ws, CJ_IDX(j)); tr_load(cur, F.lane, va); }
      while (j < ntot) { const int nx = j + nw; const bool hn = nx < ntot; TrItem nxt = cur;
          if (hn) { nxt = tr_decode(ws, CJ_IDX(nx)); tr_load(nxt, F.lane, vb); }
          tr_store(cur, F.lane, va, scr);
          if (!hn) break;
          cur = nxt; j = nx;
#pragma unroll
          for (int i = 0; i < 16; ++i) va[i] = vb[i]; } }
#undef CJ_IDX
    if (gm) { float* mod = (float*)(ws + WS_CTL); const float* cvec = inp(1); const int nl = gm == 3 ? 2 : 1, l0 = gm == 2 ? 1 : 0;
      for (int it = rank; it < nl * 72 * 32; it += nw) { const int cb = it % (nl * 72), kc = it / (nl * 72), layer = l0 + cb / 72, col = (cb % 72) * 256 + F.lane * 4;
          const float* W = inp(3) + ((size_t)layer * DM + kc * 64) * (NCOND * DM) + col;
          f32x4 acc = (f32x4){0.f, 0.f, 0.f, 0.f}; if (kc == 0) acc = *(const f32x4*)(inp(4) + layer * (NCOND * DM) + col);
#pragma unroll 16
          for (int kk = 0; kk < 64; ++kk) { const float cv = cvec[kc * 64 + kk]; const float sv = cv * pg8::sigmoid_f(cv); acc += sv * *(const f32x4*)(W + (size_t)kk * (NCOND * DM)); }
          float* dst = mod + layer * (NCOND * DM) + col; atomicAdd(dst, acc[0]); atomicAdd(dst + 1, acc[1]); atomicAdd(dst + 2, acc[2]); atomicAdd(dst + 3, acc[3]); } }
}
__device__ __forceinline__ void p0_prologue(const Frame& F, unsigned char* ws) {
    if (blockIdx.x == 0) { float* bd = (float*)(ws + WS_BIASD); const float* rb = inp(2);
        for (int i = F.tid; i < 1024; i += NWAVES * 64) { const int h = i >> 7, d = i & 127; bd[i] = (rb[t5_bucket(d) * 8 + h] - rb[31 * 8 + h]) * LOG2E; } }
#if MK_TAILFILL
    for (int rep = 1; rep < REP_P0; ++rep) convert_job(F, ws, 0, 2 * I_F, 3 * I_F, 5 * I_F, PER_LAYER + 3 * I_F, PER_LAYER + 5 * I_F, 0, F.vcu * NWAVES + F.wave, F.G * NWAVES);
    convert_job(F, ws, 0, 2 * I_F, 3 * I_F, 5 * I_F, PER_LAYER + 3 * I_F, PER_LAYER + 5 * I_F, 3, F.vcu * NWAVES + F.wave, F.G * NWAVES);
#else
    convert_job(F, ws, 0, DEPTH * PER_LAYER, 0, 0, 0, 0, 3, F.vcu * NWAVES + F.wave, F.G * NWAVES);
#endif
}
__device__ __forceinline__ void tail_job_gateup(const Frame& F, unsigned char* ws, int li, int f) {
#if MK_TAILFILL
    if (blockIdx.x < 128) return;
    const int rank = ((int)blockIdx.x - 128) * NWAVES + F.wave, nw = 128 * NWAVES, base = li * PER_LAYER;
    if (f == 0) convert_job(F, ws, base + 2 * I_F, base + 3 * I_F, base + 6 * I_F, base + PER_LAYER, 0, 0, 0, rank, nw);
    else { const int nb = (li + 1 < DEPTH) ? base + PER_LAYER : 0; convert_job(F, ws, base + 5 * I_F, base + 6 * I_F, nb, nb + (li + 1 < DEPTH ? I_F : 0), 0, 0, 0, rank, nw); }
#endif
}
__device__ __forceinline__ void tail_job_glu(const Frame& F, unsigned char* ws, int li) {
#if MK_TAILFILL
    if (blockIdx.x < 128 || li + 1 >= DEPTH) return;
    const int rank = ((int)blockIdx.x - 128) * NWAVES + F.wave, nw = 128 * NWAVES, base = (li + 1) * PER_LAYER;
    convert_job(F, ws, base + I_F, base + 2 * I_F, 0, 0, 0, 0, 0, rank, nw);
#endif
}

__device__ __forceinline__ void norm_phase(const Frame& F0, const float* xin, const float* gnorm, const float* shift, const float* scale, bf16* H) { const Frame F = frame_opaque(F0);
    const int gw = F.vcu * NWAVES + F.wave, NGW = F.G * NWAVES;
    f32x4 gam[8], sh[8];
#pragma unroll
    for (int j = 0; j < 8; ++j) { const int idx = 4 * F.lane + 256 * j; gam[j] = *(const f32x4*)(gnorm + idx) * (1.0f + *(const f32x4*)(scale + idx)); sh[j] = *(const f32x4*)(shift + idx); }
    for (int m = gw; m < SEQ; m += NGW) {
        const f32x4* xr = (const f32x4*)(xin + (size_t)m * DM) + F.lane;
        f32x4 v[8]; float s = 0.f;
#pragma unroll
        for (int j = 0; j < 8; ++j) { v[j] = xr[64 * j]; s += (v[j].x * v[j].x + v[j].y * v[j].y) + (v[j].z * v[j].z + v[j].w * v[j].w); }
        const float rstd = __builtin_amdgcn_rsqf(wave_sum(s) * (1.0f / DM) + 1e-6f);
        v2u* o8 = (v2u*)(H + (size_t)m * DM) + F.lane;
#pragma unroll
        for (int j = 0; j < 8; ++j) { const f32x4 y = v[j] * rstd * gam[j] + sh[j]; v2u w; w.x = pk2(y.x, y.y); w.y = pk2(y.z, y.w); o8[64 * j] = w; }
    }
}

__device__ __forceinline__ void combine_phase(const Frame& F0, const bf16* OP, bf16* CAT, const float* lq1, const float* lk1, const float* lq2, const float* lk2, const float* subg, float lam_init) { const Frame F = frame_opaque(F0);
    const int gw = F.vcu * NWAVES + F.wave, NGW = F.G * NWAVES;
    const float lam = expf(wave_sum(lq1[F.lane] * lk1[F.lane])) - expf(wave_sum(lq2[F.lane] * lk2[F.lane])) + lam_init;
    const int h = F.lane >> 3, j0 = (F.lane & 7) * 16;
    float gs[16];
#pragma unroll
    for (int i = 0; i < 16; ++i) gs[i] = subg[j0 + i] * (1.0f - lam_init);
    for (int m = gw; m < SEQ; m += NGW) {
        const bf16* p1 = OP + (size_t)m * 2048 + (2 * h) * 128 + j0; const bf16* p2 = p1 + 128;
        const v4u a0 = *(const v4u*)p1, a1 = *(const v4u*)(p1 + 8), b0 = *(const v4u*)p2, b1 = *(const v4u*)(p2 + 8);
        float o[16];
#pragma unroll
        for (int i = 0; i < 4; ++i) { o[2 * i] = pg8::bf_lo(a0[i]) - lam * pg8::bf_lo(b0[i]); o[2 * i + 1] = pg8::bf_hi(a0[i]) - lam * pg8::bf_hi(b0[i]);
                                      o[8 + 2 * i] = pg8::bf_lo(a1[i]) - lam * pg8::bf_lo(b1[i]); o[8 + 2 * i + 1] = pg8::bf_hi(a1[i]) - lam * pg8::bf_hi(b1[i]); }
        float ss = 0.f;
#pragma unroll
        for (int i = 0; i < 16; ++i) ss += o[i] * o[i];
        ss += __shfl_xor(ss, 1); ss += __shfl_xor(ss, 2); ss += __shfl_xor(ss, 4);
        const float r = __builtin_amdgcn_rsqf(ss * (1.0f / 128.0f) + 1e-5f);
        v4u w0, w1;
#pragma unroll
        for (int i = 0; i < 4; ++i) { w0[i] = pk2(o[2 * i] * r * gs[2 * i], o[2 * i + 1] * r * gs[2 * i + 1]); w1[i] = pk2(o[8 + 2 * i] * r * gs[8 + 2 * i], o[8 + 2 * i + 1] * r * gs[8 + 2 * i + 1]); }
        bf16* q = CAT + (size_t)m * 2048 + h * 128 + j0; *(v4u*)q = w0; *(v4u*)(q + 8) = w1;
    }
}

struct SsmP { const float *lam_re, *lam_im, *log_step, *b_re, *b_im, *c_re, *c_im, *dv; };
__device__ __forceinline__ void cexp_s(float lr, float li, float s, float& er, float& ei) {
    const float m = expf(lr * s);
    double tr = (double)li * (double)s * 0.15915494309189535; tr -= floor(tr);
    const float a = (float)(tr * 6.283185307179586);
    float sn, cs; sincosf(a, &sn, &cs); er = m * cs; ei = m * sn;
}
__device__ __forceinline__ void ssm_lam(const SsmP& P, int g, int p, float& lr, float& li, float& step) {
    lr = fminf(P.lam_re[g * NP + p], -1e-4f); li = P.lam_im[g * NP + p]; step = expf(P.log_step[g]);
}
__device__ __forceinline__ void ssm_bfrag(const SsmP& P, int g, int lane, bf16x8 (&bfr)[8]) {
    const int q = lane >> 4, ci = lane & 15, hb = 8 * (q & 1);
#pragma unroll
    for (int pb = 0; pb < 4; ++pb) { const int p = 16 * pb + ci; float lr, li, step, ar, ai; ssm_lam(P, g, p, lr, li, step); cexp_s(lr, li, step, ar, ai);
        const float nr = ar - 1.0f, ni = ai, den = 1.0f / (lr * lr + li * li); const float cr = (nr * lr + ni * li) * den, cim = (ni * lr - nr * li) * den;
        const float* br = P.b_re + ((size_t)g * NP + p) * HC + hb; const float* bi = P.b_im + ((size_t)g * NP + p) * HC + hb;
        const f32x4 r0 = *(const f32x4*)br, r1 = *(const f32x4*)(br + 4), i0 = *(const f32x4*)bi, i1 = *(const f32x4*)(bi + 4);
        const f32x4 re0 = cr * r0 - cim * i0, re1 = cr * r1 - cim * i1, im0 = cr * i0 + cim * r0, im1 = cr * i1 + cim * r1;
        v4u wr_, wi_; wr_.x = pk2(re0[0], re0[1]); wr_.y = pk2(re0[2], re0[3]); wr_.z = pk2(re1[0], re1[1]); wr_.w = pk2(re1[2], re1[3]);
        wi_.x = pk2(im0[0], im0[1]); wi_.y = pk2(im0[2], im0[3]); wi_.z = pk2(im1[0], im1[1]); wi_.w = pk2(im1[2], im1[3]);
        if (q >= 2) { wr_ = (v4u){0u, 0u, 0u, 0u}; wi_ = (v4u){0u, 0u, 0u, 0u}; }
        bfr[pb] = __builtin_bit_cast(bf16x8, wr_); bfr[4 + pb] = __builtin_bit_cast(bf16x8, wi_); }
}
constexpr int BU_STRIDE = 132, XB_STRIDE = 136;
__device__ __forceinline__ void ssm_bu_to_lds(bf16x8 af, const bf16x8 (&bfr)[8], LAS float* bu, int lane) {
    const int q = lane >> 4, ci = lane & 15;
#pragma unroll
    for (int nb = 0; nb < 8; ++nb) { const f32x4 d = __builtin_amdgcn_mfma_f32_16x16x32_bf16(af, bfr[nb], (f32x4){0.f, 0.f, 0.f, 0.f}, 0, 0, 0);
#pragma unroll
        for (int r = 0; r < 4; ++r) bu[(4 * q + r) * BU_STRIDE + 16 * nb + ci] = d[r]; }
}
__device__ __forceinline__ bf16x8 ssm_load_u(const bf16* U, int g, int t, int q) {
    bf16x8 af = (bf16x8){0, 0, 0, 0, 0, 0, 0, 0};
    if (q < 2) af = *(const bf16x8*)(U + (size_t)t * SW + g * HC + 8 * q);
    return af;
}
__device__ __forceinline__ void ssm_pass1(const Frame& F0, const SsmP& P, const bf16* U, float* XEND) { const Frame F = frame_opaque(F0);
    const int gw = F.vcu * NWAVES + F.wave, NGW = F.G * NWAVES, lane = F.lane, q = lane >> 4, ci = lane & 15;
    LAS float* bu = (LAS float*)(F.lds + F.wave * 16384);
    for (int it = gw; it < NG * NCHUNK; it += NGW) { const int g = it / NCHUNK, c = it % NCHUNK, t0 = c * SCHUNK;
        bf16x8 bfr[8]; ssm_bfrag(P, g, lane, bfr);
        float lr, li, step, ar, ai; ssm_lam(P, g, lane, lr, li, step); cexp_s(lr, li, step, ar, ai);
        float xr = 0.f, xi = 0.f;
        bf16x8 af = ssm_load_u(U, g, t0 + ci, q);
        for (int sb = 0; sb < SCHUNK / 16; ++sb) {
            ssm_bu_to_lds(af, bfr, bu, lane);
            if (sb + 1 < SCHUNK / 16) af = ssm_load_u(U, g, t0 + (sb + 1) * 16 + ci, q);
            LDS_WAIT();
#pragma unroll
            for (int tt = 0; tt < 16; ++tt) { const float br_ = bu[tt * BU_STRIDE + lane], bi_ = bu[tt * BU_STRIDE + 64 + lane];
                const float nxr = ar * xr - ai * xi + br_, nxi = ar * xi + ai * xr + bi_; xr = nxr; xi = nxi; }
            LDS_WAIT();
        }
        *(f32x2v*)(XEND + ((size_t)it * NP + lane) * 2) = (f32x2v){xr, xi};
    }
}
__device__ __forceinline__ float gelu_tanh(float x) {
    const float z = x + 0.044715f * x * x * x;
    return x * __builtin_amdgcn_rcpf(1.0f + __builtin_amdgcn_exp2f(-2.0f * 0.7978845608028654f * LOG2E * z));
}
__device__ __forceinline__ void ssm_pass2(const Frame& F0, const SsmP& P, const bf16* U, const float* XEND, bf16* YG) { const Frame F = frame_opaque(F0);
    const int gw = F.vcu * NWAVES + F.wave, NGW = F.G * NWAVES, lane = F.lane, q = lane >> 4, ci = lane & 15;
    LAS float* bu = (LAS float*)(F.lds + F.wave * 16384);
    LAS bf16* xb = (LAS bf16*)(F.lds + F.wave * 16384 + 16 * BU_STRIDE * 4);
    for (int it = gw; it < NG * NCHUNK; it += NGW) { const int g = it / NCHUNK, c = it % NCHUNK, t0 = c * SCHUNK;
        bf16x8 bfr[8]; ssm_bfrag(P, g, lane, bfr);
        float lr, li, step, ar, ai; ssm_lam(P, g, lane, lr, li, step); cexp_s(lr, li, step, ar, ai);
        float xr = 0.f, xi = 0.f;
        { float aTr, aTi; cexp_s(lr, li, step * (float)SCHUNK, aTr, aTi);
          for (int cc = 0; cc < c; ++cc) { const f32x2v e = *(const f32x2v*)(XEND + ((size_t)(g * NCHUNK + cc) * NP + lane) * 2);
              const float nxr = aTr * xr - aTi * xi + e.x, nxi = aTr * xi + aTi * xr + e.y; xr = nxr; xi = nxi; } }
        bf16x8 cf[4];
#pragma unroll
        for (int kb = 0; kb < 4; ++kb) { const float* src = (kb < 2 ? P.c_re : P.c_im) + ((size_t)g * HC + ci) * NP + 32 * (kb & 1) + 8 * q; const float sg = kb < 2 ? 1.0f : -1.0f;
            const f32x4 a = *(const f32x4*)src * sg, b = *(const f32x4*)(src + 4) * sg;
            v4u w; w.x = pk2(a[0], a[1]); w.y = pk2(a[2], a[3]); w.z = pk2(b[0], b[1]); w.w = pk2(b[2], b[3]); cf[kb] = __builtin_bit_cast(bf16x8, w); }
        const f32x4 dv4 = *(const f32x4*)(P.dv + g * HC + 4 * q);
        bf16x8 af = ssm_load_u(U, g, t0 + ci, q);
        for (int sb = 0; sb < SCHUNK / 16; ++sb) {
            ssm_bu_to_lds(af, bfr, bu, lane);
            if (sb + 1 < SCHUNK / 16) af = ssm_load_u(U, g, t0 + (sb + 1) * 16 + ci, q);
            const int t = t0 + sb * 16 + ci;
            const v2u uu = *(const v2u*)(U + (size_t)t * SW + g * HC + 4 * q);
            LDS_WAIT();
#pragma unroll
            for (int tt = 0; tt < 16; ++tt) { const float br_ = bu[tt * BU_STRIDE + lane], bi_ = bu[tt * BU_STRIDE + 64 + lane];
                const float nxr = ar * xr - ai * xi + br_, nxi = ar * xi + ai * xr + bi_; xr = nxr; xi = nxi;
                const unsigned pk = pk2(xr, xi); xb[tt * XB_STRIDE + lane] = (bf16)(pk & 0xffffu); xb[tt * XB_STRIDE + 64 + lane] = (bf16)(pk >> 16); }
            LDS_WAIT();
            f32x4 yd = (f32x4){0.f, 0.f, 0.f, 0.f};
#pragma unroll
            for (int kb = 0; kb < 4; ++kb) { const bf16x8 xf = *(const LAS bf16x8*)(xb + ci * XB_STRIDE + 32 * kb + 8 * q); yd = __builtin_amdgcn_mfma_f32_16x16x32_bf16(cf[kb], xf, yd, 0, 0, 0); }
            const float y0 = gelu_tanh(yd[0] + dv4[0] * pg8::bf_lo(uu.x)), y1 = gelu_tanh(yd[1] + dv4[1] * pg8::bf_hi(uu.x));
            const float y2 = gelu_tanh(yd[2] + dv4[2] * pg8::bf_lo(uu.y)), y3 = gelu_tanh(yd[3] + dv4[3] * pg8::bf_hi(uu.y));
            v2u w; w.x = pk2(y0, y1); w.y = pk2(y2, y3);
            *(v2u*)(YG + (size_t)t * SW + g * HC + 4 * q) = w;
            LDS_WAIT();
        }
    }
}

struct Args { In in; float* out; unsigned char* ws; int ph_lo, ph_hi; };
constexpr int N_PHASES = 1 + 12 * DEPTH;
__global__ void __launch_bounds__(NWAVES * 64, 2) mega_fwd(Args args) {
    extern __shared__ __attribute__((aligned(16))) unsigned char lds[];
    cg::grid_group grid = cg::this_grid();
    Frame F;
    F.lds = (LAS unsigned char*)lds;
    F.tid = threadIdx.x; F.lane = F.tid & 63; F.wave = __builtin_amdgcn_readfirstlane(F.tid >> 6);
    F.G = gridDim.x; { const int bx = blockIdx.x; F.vcu = (F.G % 8 == 0) ? (bx % 8) * (F.G / 8) + bx / 8 : bx; }
    const int lo = args.ph_lo, hi = args.ph_hi;
    if (F.tid < 16) ((LAS unsigned*)(F.lds + MISC_OFF))[F.tid] = 0u;
    __syncthreads();
    XcdBarrier bar = xcd_barrier_post((unsigned*)(args.ws + WS_CTL) + CW_BAR, (volatile LAS unsigned*)(F.lds + MISC_OFF));
    int ph = 0;
#define PH_ON (ph >= lo && ph < hi)
#define PH_END do { if (ph >= lo && ph + 1 < hi) { if (lo < 0) grid.sync(); else xcd_barrier(bar); } ++ph; } while (0)
#define PH_LOCALS unsigned char* ws = args.ws; float* xout = args.out; int li = li_, f = f_; asm volatile("" : "+s"(ws), "+s"(xout), "+s"(li), "+s"(f)); \
    const float* md = (const float*)(ws + WS_CTL) + li * (NCOND * DM); const float* ng = inp(5) + (size_t)li * 3 * DM; const int sub = f == 0 ? 0 : 2; \
    const float* xcur = (li == 0 && f == 0) ? inp(0) : (const float*)xout; (void)md; (void)ng; (void)sub; (void)xcur;

    if (PH_ON) p0_prologue(F, args.ws);
    PH_END;

    for (int li_ = 0; li_ < DEPTH; ++li_) {
        for (int f_ = 0; f_ < 2; ++f_) {
            if (PH_ON) { PH_LOCALS; norm_phase(F, xcur, ng + sub * DM, md + (3 * sub) * DM, md + (3 * sub + 1) * DM, (bf16*)(ws + WS_H)); }
            PH_END;
            if (PH_ON) { PH_LOCALS; pg8::Gemm g{(const bf16*)(ws + WS_H), (const bf16*)(ws + WS_WGU) + (size_t)(li * 2 + f) * 2 * DFF * DM, SEQ, 2 * DFF, DM}; pg8::StaticOrder S; S.init(SEQ, 2 * DFF, F.G, (int)blockIdx.x);
                pg8::EpiSwiGlu E{(bf16*)(ws + WS_ACT), DFF};
                for (int rep = 0; rep < REP_GU; ++rep) pg8::gemm_phase<pg8::EpiSwiGlu, pg8::StaticOrder, true, true>(F.lds, g, S, E);
                tail_job_gateup(F, ws, li, f); }
            PH_END;
            if (PH_ON) { PH_LOCALS; pg8::Gemm g{(const bf16*)(ws + WS_ACT), (const bf16*)(ws + WS_WD) + (size_t)(li * 2 + f) * DM * DFF, SEQ, DM, DFF}; pg8::StaticOrder S; S.init(SEQ, DM, F.G, (int)blockIdx.x);
                pg8::EpiResGate E{xcur, xout, md + (3 * sub + 2) * DM, 0.5f, DM};
                pg8::gemm_phase<pg8::EpiResGate, pg8::StaticOrder, true, true>(F.lds, g, S, E); }
            PH_END;
            if (f_ == 1) break;
            if (PH_ON) { PH_LOCALS; norm_phase(F, xout, ng + 1 * DM, md + 3 * DM, md + 4 * DM, (bf16*)(ws + WS_H)); }
            PH_END;
            if (PH_ON) { PH_LOCALS; pg8::Gemm g{(const bf16*)(ws + WS_H), (const bf16*)(ws + WS_WIN) + (size_t)li * INW * DM, SEQ, INW, DM}; pg8::StaticOrder S; S.init(SEQ, INW, F.G, (int)blockIdx.x);
                pg8::EpiWin E{(bf16*)(ws + WS_Q), (bf16*)(ws + WS_K), (bf16*)(ws + WS_V), (bf16*)(ws + WS_U), inp(14) + li * 64, inp(15) + li * 64, attn_body::C2};
                pg8::gemm_phase<pg8::EpiWin, pg8::StaticOrder, true, true>(F.lds, g, S, E); }
            PH_END;
#define SSM_PARAMS SsmP P{inp(21) + (size_t)li * NG * NP, inp(22) + (size_t)li * NG * NP, inp(23) + li * NG, inp(24) + (size_t)li * NG * NP * HC, inp(25) + (size_t)li * NG * NP * HC, \
                   inp(26) + (size_t)li * NG * HC * NP, inp(27) + (size_t)li * NG * HC * NP, inp(28) + li * NG * HC}
            if (PH_ON) { PH_LOCALS;
#ifndef NO_ATTN
                { const attn_body::AttnTensors AT{(const attn_body::bf16*)(ws + WS_Q), (const attn_body::bf16*)(ws + WS_K), (const attn_body::bf16*)(ws + WS_V), (attn_body::bf16*)(ws + WS_OP), (const float*)(ws + WS_BIASD)};
                  for (int rep = 0; rep < REP_ATTN; ++rep) attn_body::attn_phase<8>((char*)lds, AT, F.vcu); }
#endif
#ifndef NO_SSM
                { SSM_PARAMS; for (int rep = 0; rep < REP_SSM; ++rep) ssm_pass1(F, P, (const bf16*)(ws + WS_U), (float*)(ws + WS_XEND)); }
#endif
                }
            PH_END;
            if (PH_ON) { PH_LOCALS; combine_phase(F, (const bf16*)(ws + WS_OP), (bf16*)(ws + WS_CAT), inp(16) + li * 64, inp(17) + li * 64, inp(18) + li * 64, inp(19) + li * 64, inp(20) + li * 128, li == 0 ? 0.2f : 0.35550906759096924f);
#ifndef NO_SSM
                { SSM_PARAMS; for (int rep = 0; rep < REP_SSM; ++rep) ssm_pass2(F, P, (const bf16*)(ws + WS_U), (const float*)(ws + WS_XEND), (bf16*)(ws + WS_YG)); }
#endif
                }
            PH_END;
            if (PH_ON) { PH_LOCALS; pg8::Gemm g{(const bf16*)(ws + WS_YG), (const bf16*)(ws + WS_WGLU) + (size_t)li * SW * SW, SEQ, SW, SW}; pg8::StaticOrder S; S.init(SEQ, SW, F.G, (int)blockIdx.x);
                pg8::EpiGlu E{(const bf16*)(ws + WS_YG), (bf16*)(ws + WS_CAT), inp(30) + li * SW};
                pg8::gemm_phase<pg8::EpiGlu, pg8::StaticOrder, true, true>(F.lds, g, S, E);
                tail_job_glu(F, ws, li); }
            PH_END;
            if (PH_ON) { PH_LOCALS; pg8::Gemm g{(const bf16*)(ws + WS_CAT), (const bf16*)(ws + WS_WOUT) + (size_t)li * DM * DM, SEQ, DM, DM}; pg8::StaticOrder S; S.init(SEQ, DM, F.G, (int)blockIdx.x);
                pg8::EpiResGate E{xout, xout, md + 5 * DM, 1.0f, DM};
                pg8::gemm_phase<pg8::EpiResGate, pg8::StaticOrder, true, true>(F.lds, g, S, E); }
            PH_END;
        }
    }
#undef PH_ON
#undef PH_END
#undef PH_LOCALS
#undef SSM_PARAMS
}

extern "C" void kernel_launch(void* const* d_in, const int* in_sizes, int n_in, void* d_out, int out_size, void* d_ws, size_t ws_size, hipStream_t stream) {
    static int grid = 0;
    if (grid == 0) {
        if (n_in != 31 || in_sizes[0] != SEQ * DM || out_size != SEQ * DM || ws_size < WS_END) { fprintf(stderr, "kernel_launch: unexpected shapes (n_in %d, in0 %d, out %d, ws %zu < %zu?); nothing launched\n", n_in, n_in > 0 ? in_sizes[0] : -1, out_size, ws_size, (size_t)WS_END); grid = -1; return; }
        int dev = 0, cus = 0, per_cu = 0;
        if (hipGetDevice(&dev) != hipSuccess || hipDeviceGetAttribute(&cus, hipDeviceAttributeMultiprocessorCount, dev) != hipSuccess) { fprintf(stderr, "kernel_launch: device query failed\n"); grid = -1; return; }
        if (hipFuncSetAttribute((const void*)mega_fwd, hipFuncAttributeMaxDynamicSharedMemorySize, LDS_BYTES) != hipSuccess) { fprintf(stderr, "kernel_launch: hipFuncSetAttribute failed\n"); grid = -1; return; }
        if (hipOccupancyMaxActiveBlocksPerMultiprocessor(&per_cu, (const void*)mega_fwd, NWAVES * 64, LDS_BYTES) != hipSuccess || per_cu < 1) { fprintf(stderr, "kernel_launch: occupancy query says %d\n", per_cu); per_cu = 1; }
        (void)hipGetLastError();
        grid = cus;
        if (grid != 256) { fprintf(stderr, "kernel_launch: built for a 256-CU device, got %d\n", grid); grid = -1; return; }
    }
    if (grid < 0) return;
    if (hipMemsetAsync((char*)d_ws + WS_CTL, 0, CTL_ZERO_BYTES, stream) != hipSuccess) { fprintf(stderr, "kernel_launch: memset failed\n"); return; }
    Args a{};
    for (int i = 0; i < 31; ++i) a.in.p[i] = (const float*)d_in[i];
    a.out = (float*)d_out; a.ws = (unsigned char*)d_ws;
#if MK_ONE_LAUNCH
    a.ph_lo = 0; a.ph_hi = N_PHASES;
    void* kargs[] = {&a};
    hipError_t e = hipLaunchCooperativeKernel((const void*)mega_fwd, dim3(grid), dim3(NWAVES * 64), kargs, LDS_BYTES, stream);
    if (e != hipSuccess) fprintf(stderr, "kernel_launch: cooperative launch failed: %s\n", hipGetErrorString(e));
#else
    for (int ph = 0; ph < N_PHASES; ++ph) { a.ph_lo = ph; a.ph_hi = ph + 1;
        hipLaunchKernelGGL(mega_fwd, dim3(grid), dim3(NWAVES * 64), LDS_BYTES, stream, a);
        const hipError_t le = hipPeekAtLastError();
        if (le != hipSuccess) { fprintf(stderr, "kernel_launch: launch %d failed: %s\n", ph, hipGetErrorName(le)); break; } }
#endif
}
```
